# Optimizing an MI355X kernel written in HIP

```python
import math
import jax
import jax.numpy as jnp
from jax import lax
import numpy as np

D_MODEL = 1024
BATCH = 2
SEQ = 16384
DEPTH = 2

N_EVEN = (DEPTH + 1) // 2
N_ODD = DEPTH // 2
EPS = 1e-6
NEG = -1e30
FORCE_SCORE = 1e9
Q_BLOCK = 128

FOX_HEADS = 8
FOX_DH = 64
GDN_HEADS = 4
GDN_DH = 128
GDN_CONV = 4
GDN_CHUNK = 64
NSA_HEADS = 8
NSA_KV_HEADS = 2
NSA_GROUP = NSA_HEADS // NSA_KV_HEADS
NSA_DH = 64
CMP_LEN = 32
CMP_STRIDE = 16
CMP_HIDDEN = 256
SLC_LEN = 64
SLC_TOPK = 16
WINDOW = 512
GLA_HEADS = 4
GLA_DK = 64
GLA_DV = 128
GLA_GATE_RANK = 16
GLA_TAU = 16.0
GLA_CHUNK = 64
REL_BUCKETS = 32
REL_MAX_DIST = 128
N_EXPERTS = 64
TOP_K = 6
D_EXPERT = 256
D_SHARED = 256
N_GROUPS = 8
TOPK_GROUPS = 4
ROUTE_SCALE = 2.5
MOE_BLOCK = 128

FOX_W = FOX_HEADS * FOX_DH
GDN_W = GDN_HEADS * GDN_DH
NSA_W = NSA_HEADS * NSA_DH
NSA_KV_W = NSA_KV_HEADS * NSA_DH
GLA_KW = GLA_HEADS * GLA_DK
GLA_W = GLA_HEADS * GLA_DV
EV_SIZES = (FOX_W, FOX_W, FOX_W, FOX_HEADS, 3 * GDN_W, GDN_HEADS, GDN_HEADS, GDN_W)
OD_SIZES = (NSA_W,) + (NSA_KV_W,) * 6 + (3 * NSA_HEADS, GLA_KW, GLA_KW, GLA_W, GLA_GATE_RANK, GLA_W)
EV_IN = sum(EV_SIZES)
OD_IN = sum(OD_SIZES)
EV_OUT = FOX_W + GDN_W
OD_OUT = NSA_W + GLA_W

kernel_name = 'hybrid_fox_gdn_nsa_gla_moe_trunk'

F32 = jnp.float32


def _split(a, sizes):
    cuts = [int(s) for s in np.cumsum(sizes)[:-1]]
    return jnp.split(a, cuts, axis=-1)


def rms_norm(x, g):
    xf = x.astype(F32)
    y = xf * lax.rsqrt(jnp.mean(xf * xf, axis=-1, keepdims=True) + EPS)
    return (y * g.astype(F32)).astype(x.dtype)


def l2_norm(x):
    xf = x.astype(F32)
    return xf * lax.rsqrt(jnp.sum(xf * xf, axis=-1, keepdims=True) + EPS)


def masked_softmax(s, mask, axis=-1):
    p = jax.nn.softmax(jnp.where(mask, s, NEG), axis=axis)
    return jnp.where(mask, p, 0.0)


def t5_bucket(dist):
    n = jnp.maximum(dist, 0)
    exact = REL_BUCKETS // 2
    nf = jnp.maximum(n, 1).astype(F32)
    large = exact + (jnp.log(nf / exact) / math.log(REL_MAX_DIST / exact) * (REL_BUCKETS - exact)).astype(jnp.int32)
    large = jnp.minimum(large, REL_BUCKETS - 1)
    return jnp.where(n < exact, n, large)


def causal_depthwise_conv(x, w):
    k = w.shape[0]
    xp = jnp.pad(x, ((0, 0), (k - 1, 0), (0, 0)))
    return lax.conv_general_dilated(xp, w[:, None, :].astype(x.dtype), window_strides=(1,), padding='VALID',
                                    dimension_numbers=('NWC', 'WIO', 'NWC'), feature_group_count=x.shape[-1])


def _to_chunks(a, c):
    b, t = a.shape[:2]
    a = a.reshape(b, t // c, c, *a.shape[2:])
    return jnp.swapaxes(a, 2, 3)


def _from_chunks(o):
    n, b, h, c, d = o.shape
    return o.transpose(1, 0, 3, 2, 4).reshape(b, n * c, h, d)


def fox_attention(q, k, v, log_f):
    b, t, h, dh = q.shape
    nb = t // Q_BLOCK
    cum = jnp.cumsum(log_f, axis=1)
    cum_k = jnp.swapaxes(cum, 1, 2)
    q_blocks = q.reshape(b, nb, Q_BLOCK, h, dh).transpose(1, 0, 3, 2, 4)
    c_blocks = cum.reshape(b, nb, Q_BLOCK, h).transpose(1, 0, 3, 2)
    k_pos = jnp.arange(t)
    scale = dh ** -0.5

    def block(args):
        i, q_i, c_i = args
        q_pos = i * Q_BLOCK + jnp.arange(Q_BLOCK)
        s = jnp.einsum('bhqd,bthd->bhqt', q_i, k, preferred_element_type=F32) * scale
        s = s + c_i[..., None] - cum_k[:, :, None, :]
        p = masked_softmax(s, k_pos[None, :] <= q_pos[:, None])
        return jnp.einsum('bhqt,bthd->bqhd', p.astype(v.dtype), v)

    o = lax.map(block, (jnp.arange(nb), q_blocks, c_blocks))
    return o.transpose(1, 0, 2, 3, 4).reshape(b, t, h * dh)


def gated_delta_rule(q, k, v, g, beta):
    dk = q.shape[-1]
    dv = v.shape[-1]
    c = GDN_CHUNK
    q = _to_chunks(q.astype(F32), c) * dk ** -0.5
    k = _to_chunks(k.astype(F32), c)
    v = _to_chunks(v.astype(F32), c)
    beta = _to_chunks(beta.astype(F32), c)
    g = jnp.cumsum(_to_chunks(g.astype(F32), c), axis=-1)
    causal = jnp.tril(jnp.ones((c, c), dtype=bool))
    strict = jnp.tril(jnp.ones((c, c), dtype=bool), k=-1)
    decay = jnp.exp(jnp.where(causal, g[..., :, None] - g[..., None, :], NEG))
    kb = k * beta[..., None]
    lower = jnp.where(strict, jnp.einsum('bnhid,bnhjd->bnhij', kb, k) * decay, 0.0)
    rhs = jnp.concatenate([v * beta[..., None], kb * jnp.exp(g)[..., None]], axis=-1)
    sol = lax.linalg.triangular_solve(lower + jnp.eye(c, dtype=F32), rhs, left_side=True, lower=True,
                                      unit_diagonal=True)
    u, w = sol[..., :dv], sol[..., dv:]
    attn = jnp.where(causal, jnp.einsum('bnhid,bnhjd->bnhij', q, k) * decay, 0.0)
    q_dec = q * jnp.exp(g)[..., None]
    g_last = g[..., -1]
    k_dec = k * jnp.exp(g_last[..., None] - g)[..., None]

    def step(S, xs):
        u_n, w_n, a_n, q_n, k_n, gl_n = xs
        v_new = u_n - jnp.einsum('bhck,bhkv->bhcv', w_n, S)
        o = jnp.einsum('bhck,bhkv->bhcv', q_n, S) + jnp.einsum('bhij,bhjv->bhiv', a_n, v_new)
        S = S * jnp.exp(gl_n)[..., None, None] + jnp.einsum('bhck,bhcv->bhkv', k_n, v_new)
        return S, o

    xs = tuple(jnp.swapaxes(a, 0, 1) for a in (u, w, attn, q_dec, k_dec, g_last))
    b, _, h = q.shape[:3]
    _, o = lax.scan(step, jnp.zeros((b, h, dk, dv), F32), xs)
    return _from_chunks(o)


def gla_chunked(q, k, v, log_a):
    dk = q.shape[-1]
    dv = v.shape[-1]
    c = GLA_CHUNK
    q = _to_chunks(q.astype(F32), c) * dk ** -0.5
    k = _to_chunks(k.astype(F32), c)
    v = _to_chunks(v.astype(F32), c)
    G = jnp.cumsum(_to_chunks(log_a.astype(F32), c), axis=-2)
    q_dec = q * jnp.exp(G)
    causal = jnp.tril(jnp.ones((c, c), dtype=bool))
    attn = jnp.where(causal, jnp.einsum('bnhid,bnhjd->bnhij', q_dec, k * jnp.exp(-G)), 0.0)
    o_intra = jnp.einsum('bnhij,bnhjv->bnhiv', attn, v)
    G_last = G[..., -1, :]
    k_dec = k * jnp.exp(G_last[..., None, :] - G)

    def step(S, xs):
        q_n, k_n, v_n, gl_n = xs
        o = jnp.einsum('bhck,bhkv->bhcv', q_n, S)
        S = S * jnp.exp(gl_n)[..., None] + jnp.einsum('bhck,bhcv->bhkv', k_n, v_n)
        return S, o

    xs = tuple(jnp.swapaxes(a, 0, 1) for a in (q_dec, k_dec, v, G_last))
    b, _, h = q.shape[:3]
    _, o_inter = lax.scan(step, jnp.zeros((b, h, dk, dv), F32), xs)
    return _from_chunks(o_inter + jnp.swapaxes(o_intra, 0, 1))


def nsa_compress(kv, pos, w1, w2):
    b, t, kvh, dh = kv.shape
    n_cmp = (t - CMP_LEN) // CMP_STRIDE + 1
    idx = jnp.arange(n_cmp)[:, None] * CMP_STRIDE + jnp.arange(CMP_LEN)[None, :]
    blk = kv[:, idx] + pos[None, None, :, None, :].astype(kv.dtype)
    blk = blk.transpose(0, 1, 3, 2, 4).reshape(b, n_cmp, kvh, CMP_LEN * dh)
    out = jax.nn.silu(blk @ w1) @ w2
    return out.transpose(0, 2, 1, 3)


def nsa_attention(q, k_cmp, v_cmp, k_slc, v_slc, k_win, v_win, gate_logits, qn, kn, pos, cw1, cw2, rel_bias):
    b, t = q.shape[:2]
    kvh, grp, dh = NSA_KV_HEADS, NSA_GROUP, NSA_DH
    nb = t // Q_BLOCK
    n_cmp = (t - CMP_LEN) // CMP_STRIDE + 1
    n_slc = t // SLC_LEN
    top_n = min(SLC_TOPK, n_slc)
    scale = dh ** -0.5

    def heads(a):
        return a.reshape(b, t, kvh, dh)

    qh = rms_norm(q.reshape(b, t, NSA_HEADS, dh), qn)
    q_blocks = qh.reshape(b, nb, Q_BLOCK, kvh, grp, dh).transpose(1, 0, 3, 4, 2, 5)
    kc = rms_norm(nsa_compress(heads(k_cmp), pos[0], cw1[0], cw2[0]), kn)
    vc = nsa_compress(heads(v_cmp), pos[1], cw1[1], cw2[1])
    ks = rms_norm(heads(k_slc), kn).reshape(b, n_slc, SLC_LEN, kvh, dh).transpose(0, 3, 1, 2, 4)
    vs = heads(v_slc).reshape(b, n_slc, SLC_LEN, kvh, dh).transpose(0, 3, 1, 2, 4)
    pad = ((0, 0), (0, 0), (WINDOW, 0), (0, 0))
    kw = jnp.pad(jnp.swapaxes(rms_norm(heads(k_win), kn), 1, 2), pad)
    vw = jnp.pad(jnp.swapaxes(heads(v_win), 1, 2), pad)
    cmp_start = jnp.arange(n_cmp) * CMP_STRIDE
    cmp_end = cmp_start + CMP_LEN - 1
    slc_start = jnp.arange(n_slc) * SLC_LEN
    overlap = ((cmp_start[:, None] < slc_start[None, :] + SLC_LEN)
               & (cmp_start[:, None] + CMP_LEN > slc_start[None, :])).astype(F32)
    table_h = rel_bias.T.reshape(kvh, grp, REL_BUCKETS).astype(F32)
    table_kg = jnp.transpose(rel_bias.reshape(REL_BUCKETS, kvh, grp), (1, 0, 2)).astype(F32)
    gather_blocks = jax.vmap(jax.vmap(lambda blk, ix: blk[ix]))
    blk_id = jnp.arange(n_slc)

    def block(args):
        i, q_i = args
        q_pos = i * Q_BLOCK + jnp.arange(Q_BLOCK)
        s = jnp.einsum('bkgqd,bknd->bkgqn', q_i, kc, preferred_element_type=F32) * scale
        s = s + table_h[:, :, t5_bucket(q_pos[:, None] - cmp_end[None, :])]
        p_cmp = masked_softmax(s, cmp_end[None, :] <= q_pos[:, None])
        o_cmp = jnp.einsum('bkgqn,bknd->bkgqd', p_cmp.astype(vc.dtype), vc)
        imp = jnp.einsum('bkgqn,ns->bkqs', p_cmp, overlap)
        cur = q_pos // SLC_LEN
        forced = (blk_id[None, :] == 0) | (blk_id[None, :] == cur[:, None]) | (blk_id[None, :] == cur[:, None] - 1)
        imp = jnp.where(forced, FORCE_SCORE, jnp.where(blk_id[None, :] <= cur[:, None], imp, NEG))
        _, idx = lax.top_k(imp, top_n)
        k_sel = gather_blocks(ks, idx)
        v_sel = gather_blocks(vs, idx)
        sel_pos = idx[..., None] * SLC_LEN + jnp.arange(SLC_LEN)
        dist = q_pos[:, None, None] - sel_pos
        bias = jax.vmap(lambda tb, bk: tb[bk], in_axes=(0, 1), out_axes=1)(table_kg, t5_bucket(dist))
        s = jnp.einsum('bkgqd,bkqnld->bkgqnl', q_i, k_sel, preferred_element_type=F32) * scale
        s = s + jnp.moveaxis(bias, -1, 2)
        p_sel = masked_softmax(s, (dist >= 0)[:, :, None], axis=(-2, -1))
        o_slc = jnp.einsum('bkgqnl,bkqnld->bkgqd', p_sel.astype(v_sel.dtype), v_sel)
        k_i = lax.dynamic_slice_in_dim(kw, i * Q_BLOCK, Q_BLOCK + WINDOW, axis=2)
        v_i = lax.dynamic_slice_in_dim(vw, i * Q_BLOCK, Q_BLOCK + WINDOW, axis=2)
        w_pos = i * Q_BLOCK - WINDOW + jnp.arange(Q_BLOCK + WINDOW)
        dist_w = q_pos[:, None] - w_pos[None, :]
        s = jnp.einsum('bkgqd,bkwd->bkgqw', q_i, k_i, preferred_element_type=F32) * scale
        s = s + table_h[:, :, t5_bucket(dist_w)]
        p_win = masked_softmax(s, (dist_w >= 0) & (dist_w < WINDOW) & (w_pos[None, :] >= 0))
        o_win = jnp.einsum('bkgqw,bkwd->bkgqd', p_win.astype(v_i.dtype), v_i)
        return jnp.stack([o_cmp, o_slc, o_win], axis=-1)

    o = lax.map(block, (jnp.arange(nb), q_blocks))
    o = o.transpose(1, 0, 4, 2, 3, 5, 6).reshape(b, t, NSA_HEADS, dh, 3)
    gates = jax.nn.sigmoid(gate_logits.astype(F32)).reshape(b, t, NSA_HEADS, 1, 3)
    return jnp.sum(o.astype(F32) * gates, axis=-1).reshape(b, t, NSA_W)


def even_mixer(h, w_in, w_out, fox_fb, fox_qn, fox_kn, gdn_conv, gdn_a_log, gdn_dt_bias, gdn_on):
    b, t, _ = h.shape
    fq, fk, fv, ff, gqkv, ga, gb, gz = _split(h @ w_in, EV_SIZES)

    def heads(a, n, d):
        return a.reshape(b, t, n, d)

    log_f = jax.nn.log_sigmoid((ff + fox_fb).astype(F32))
    o_fox = fox_attention(rms_norm(heads(fq, FOX_HEADS, FOX_DH), fox_qn),
                          rms_norm(heads(fk, FOX_HEADS, FOX_DH), fox_kn),
                          heads(fv, FOX_HEADS, FOX_DH), log_f)
    gq, gk, gv = jnp.split(jax.nn.silu(causal_depthwise_conv(gqkv, gdn_conv)), 3, axis=-1)
    g = -jnp.exp(gdn_a_log.astype(F32)) * jax.nn.softplus((ga + gdn_dt_bias).astype(F32))
    beta = jax.nn.sigmoid(gb.astype(F32))
    o = gated_delta_rule(l2_norm(heads(gq, GDN_HEADS, GDN_DH)), l2_norm(heads(gk, GDN_HEADS, GDN_DH)),
                         heads(gv, GDN_HEADS, GDN_DH), g, beta)
    o_gdn = rms_norm(o, gdn_on) * jax.nn.silu(heads(gz, GDN_HEADS, GDN_DH).astype(F32))
    y = jnp.concatenate([o_fox, o_gdn.reshape(b, t, GDN_W).astype(h.dtype)], axis=-1)
    return y @ w_out


def odd_mixer(h, w_in, w_out, nsa_qn, nsa_kn, nsa_pos, nsa_cmp_w1, nsa_cmp_w2, gla_wg_up, gla_bg, gla_on, rel_bias):
    b, t, _ = h.shape
    nq, kc, vc, ks, vs, kw, vw, ng, lq, lk, lv, lg, lr = _split(h @ w_in, OD_SIZES)
    o_nsa = nsa_attention(nq, kc, vc, ks, vs, kw, vw, ng, nsa_qn, nsa_kn, nsa_pos, nsa_cmp_w1, nsa_cmp_w2, rel_bias)
    log_a = jax.nn.log_sigmoid((lg @ gla_wg_up + gla_bg).astype(F32)) / GLA_TAU
    o = gla_chunked(lq.reshape(b, t, GLA_HEADS, GLA_DK), lk.reshape(b, t, GLA_HEADS, GLA_DK),
                    lv.reshape(b, t, GLA_HEADS, GLA_DV), log_a.reshape(b, t, GLA_HEADS, GLA_DK))
    o_gla = rms_norm(o, gla_on) * jax.nn.silu(lr.reshape(b, t, GLA_HEADS, GLA_DV).astype(F32))
    y = jnp.concatenate([o_nsa.astype(h.dtype), o_gla.reshape(b, t, GLA_W).astype(h.dtype)], axis=-1)
    return y @ w_out


def swiglu(x, wg, wu, wd):
    return (jax.nn.silu(x @ wg) * (x @ wu)) @ wd


def moe_ffn(h, router, e_bias, wg, wu, wd, sg, su, sd):
    b, t, d = h.shape
    xt = h.reshape(b * t, d)
    nt = b * t
    scores = jax.nn.sigmoid((xt @ router).astype(F32))
    biased = scores + e_bias.astype(F32)
    grp_score = lax.top_k(biased.reshape(nt, N_GROUPS, N_EXPERTS // N_GROUPS), 2)[0].sum(-1)
    _, top_g = lax.top_k(grp_score, TOPK_GROUPS)
    gmask = jax.nn.one_hot(top_g, N_GROUPS, dtype=F32).sum(axis=1) > 0
    emask = jnp.repeat(gmask, N_EXPERTS // N_GROUPS, axis=1)
    _, top_e = lax.top_k(jnp.where(emask, biased, -jnp.inf), TOP_K)
    w = jnp.take_along_axis(scores, top_e, axis=1)
    w = w / jnp.sum(w, axis=-1, keepdims=True) * ROUTE_SCALE
    n_assign = nt * TOP_K
    eid = top_e.reshape(-1)
    tok = jnp.repeat(jnp.arange(nt, dtype=jnp.int32), TOP_K)
    wts = w.reshape(-1)
    order = jnp.argsort(eid)
    e_sorted = eid[order]
    counts = jnp.zeros((N_EXPERTS,), jnp.int32).at[eid].add(1)
    starts = jnp.cumsum(counts) - counts
    pcounts = (counts + MOE_BLOCK - 1) // MOE_BLOCK * MOE_BLOCK
    pends = jnp.cumsum(pcounts)
    pstarts = pends - pcounts
    dest = pstarts[e_sorted] + jnp.arange(n_assign, dtype=jnp.int32) - starts[e_sorted]
    nblk = -(-(n_assign + N_EXPERTS * (MOE_BLOCK - 1)) // MOE_BLOCK)
    rows = nblk * MOE_BLOCK
    row_tok = jnp.full((rows,), nt, jnp.int32).at[dest].set(tok[order])
    row_w = jnp.zeros((rows,), F32).at[dest].set(wts[order])
    blk_e = jnp.minimum(jnp.sum(jnp.arange(nblk)[:, None] * MOE_BLOCK >= pends[None, :], axis=1), N_EXPERTS - 1)
    x_pad = jnp.concatenate([xt, jnp.zeros((1, d), xt.dtype)], axis=0)

    def step(acc, xs):
        rt, rw, e = xs
        y = swiglu(x_pad[rt], wg[e], wu[e], wd[e])
        return acc.at[rt].add(y * rw[:, None].astype(y.dtype)), None

    acc, _ = lax.scan(step, jnp.zeros((nt + 1, d), h.dtype),
                      (row_tok.reshape(nblk, MOE_BLOCK), row_w.reshape(nblk, MOE_BLOCK), blk_e))
    out = acc[:nt] + swiglu(xt, sg, su, sd)
    return out.reshape(b, t, d)


def setup_inputs(seed: int = 0) -> dict:
    key = jax.random.key(seed)
    ks = iter(jax.random.split(key, 40))

    def nrm(shape, std):
        return std * jax.random.normal(next(ks), shape, F32)

    def gain(shape):
        return 1.0 + 0.05 * jax.random.normal(next(ks), shape, F32)

    D = D_MODEL
    dt = jnp.exp(jax.random.uniform(next(ks), (N_EVEN, GDN_HEADS), F32, math.log(1e-3), math.log(1e-1)))
    return {
        'x': nrm((BATCH, SEQ, D), 1.0),
        'c': nrm((BATCH, D), 1.0),
        'ada_w': nrm((DEPTH, D, 6 * D), 0.5 * D ** -0.5),
        'ada_b': nrm((DEPTH, 6 * D), 0.02),
        'norm_mix': gain((DEPTH, D)),
        'norm_ffn': gain((DEPTH, D)),
        'rel_bias': nrm((REL_BUCKETS, NSA_HEADS), 0.2),
        'ev_w_in': nrm((N_EVEN, D, EV_IN), D ** -0.5),
        'ev_w_out': nrm((N_EVEN, EV_OUT, D), EV_OUT ** -0.5),
        'fox_fb': 3.0 + 0.5 * jax.random.normal(next(ks), (N_EVEN, FOX_HEADS), F32),
        'fox_qn': gain((N_EVEN, FOX_DH)),
        'fox_kn': gain((N_EVEN, FOX_DH)),
        'gdn_conv': nrm((N_EVEN, GDN_CONV, 3 * GDN_W), GDN_CONV ** -0.5),
        'gdn_a_log': jnp.log(jax.random.uniform(next(ks), (N_EVEN, GDN_HEADS), F32, 1.0, 16.0)),
        'gdn_dt_bias': dt + jnp.log(-jnp.expm1(-dt)),
        'gdn_on': gain((N_EVEN, GDN_DH)),
        'od_w_in': nrm((N_ODD, D, OD_IN), D ** -0.5),
        'od_w_out': nrm((N_ODD, OD_OUT, D), OD_OUT ** -0.5),
        'nsa_qn': gain((N_ODD, NSA_DH)),
        'nsa_kn': gain((N_ODD, NSA_DH)),
        'nsa_pos': nrm((N_ODD, 2, CMP_LEN, NSA_DH), 0.1),
        'nsa_cmp_w1': nrm((N_ODD, 2, CMP_LEN * NSA_DH, CMP_HIDDEN), (CMP_LEN * NSA_DH) ** -0.5),
        'nsa_cmp_w2': nrm((N_ODD, 2, CMP_HIDDEN, NSA_DH), CMP_HIDDEN ** -0.5),
        'gla_wg_up': nrm((N_ODD, GLA_GATE_RANK, GLA_KW), GLA_GATE_RANK ** -0.5),
        'gla_bg': nrm((N_ODD, GLA_KW), 0.1),
        'gla_on': gain((N_ODD, GLA_DV)),
        'moe_router': nrm((DEPTH, D, N_EXPERTS), D ** -0.5),
        'moe_bias': nrm((DEPTH, N_EXPERTS), 0.01),
        'moe_wg': nrm((DEPTH, N_EXPERTS, D, D_EXPERT), D ** -0.5),
        'moe_wu': nrm((DEPTH, N_EXPERTS, D, D_EXPERT), D ** -0.5),
        'moe_wd': nrm((DEPTH, N_EXPERTS, D_EXPERT, D), D_EXPERT ** -0.5),
        'sh_wg': nrm((DEPTH, D, D_SHARED), D ** -0.5),
        'sh_wu': nrm((DEPTH, D, D_SHARED), D ** -0.5),
        'sh_wd': nrm((DEPTH, D_SHARED, D), D_SHARED ** -0.5),
    }


def reference(x, c, ada_w, ada_b, norm_mix, norm_ffn, rel_bias, ev_w_in, ev_w_out, fox_fb, fox_qn, fox_kn,
              gdn_conv, gdn_a_log, gdn_dt_bias, gdn_on, od_w_in, od_w_out, nsa_qn, nsa_kn, nsa_pos, nsa_cmp_w1,
              nsa_cmp_w2, gla_wg_up, gla_bg, gla_on, moe_router, moe_bias, moe_wg, moe_wu, moe_wd, sh_wg, sh_wu,
              sh_wd):
    cond = jax.nn.silu(c)
    for layer in range(DEPTH):
        mod = (cond @ ada_w[layer] + ada_b[layer])[:, None, :]
        sh1, sc1, g1, sh2, sc2, g2 = jnp.split(mod, 6, axis=-1)
        h = rms_norm(x, norm_mix[layer]) * (1.0 + sc1) + sh1
        j = layer // 2
        if layer % 2 == 0:
            y = even_mixer(h, ev_w_in[j], ev_w_out[j], fox_fb[j], fox_qn[j], fox_kn[j], gdn_conv[j],
                           gdn_a_log[j], gdn_dt_bias[j], gdn_on[j])
        else:
            y = odd_mixer(h, od_w_in[j], od_w_out[j], nsa_qn[j], nsa_kn[j], nsa_pos[j], nsa_cmp_w1[j],
                          nsa_cmp_w2[j], gla_wg_up[j], gla_bg[j], gla_on[j], rel_bias)
        x = x + g1 * y
        h = rms_norm(x, norm_ffn[layer]) * (1.0 + sc2) + sh2
        x = x + g2 * moe_ffn(h, moe_router[layer], moe_bias[layer], moe_wg[layer], moe_wu[layer],
                             moe_wd[layer], sh_wg[layer], sh_wu[layer], sh_wd[layer])
    return x
```

```cpp
#define NPHASE 26
#include <hip/hip_runtime.h>
#include <stdint.h>

typedef unsigned short bfraw;
typedef __attribute__((ext_vector_type(8))) short bf16x8;
typedef __attribute__((ext_vector_type(4))) float f32x4;
#define DEV __device__ __forceinline__
#define LAS __attribute__((address_space(3)))

constexpr int NT = 32768, TT = 16384, DM = 1024;
constexpr float EPSF = 1e-6f;
constexpr float LOG2E = 1.4426950408889634f;
constexpr int NTHR = 512;
constexpr int SMEM_BYTES = 148480;

enum { I_X = 0, I_C, I_ADAW, I_ADAB, I_NMIX, I_NFFN, I_RELB, I_EVWIN, I_EVWOUT, I_FOXFB, I_FOXQN, I_FOXKN, I_GCONV, I_GALOG,
       I_GDTB, I_GON, I_ODWIN, I_ODWOUT, I_NSAQN, I_NSAKN, I_NSAPOS, I_CW1, I_CW2, I_GLAWG, I_GLABG, I_GLAON, I_ROUTER,
       I_MBIAS, I_MWG, I_MWU, I_MWD, I_SWG, I_SWU, I_SWD, N_IN };

struct Params {
    const float* in[N_IN];
    float* out;
    char* ws;
};

constexpr size_t MiB = 1048576;
constexpr size_t O_BAR = 0;
constexpr size_t O_CNT = 16384;
constexpr size_t O_MOD = 32768;
constexpr size_t ZERO_BYTES = 262144;
constexpr int NIN0 = 3840, NIN1 = 3072;
constexpr size_t O_WIN0 = ZERO_BYTES;
constexpr size_t O_WOUT0 = O_WIN0 + (size_t)NIN0 * 1024 * 2;
constexpr size_t O_WIN1 = O_WOUT0 + (size_t)1024 * 1024 * 2;
constexpr size_t O_WOUT1 = O_WIN1 + (size_t)NIN1 * 1024 * 2;
constexpr size_t O_WRT = O_WOUT1 + (size_t)1024 * 1024 * 2;
constexpr size_t O_W1T = O_WRT + (size_t)2 * 128 * 1024 * 2;
constexpr size_t O_W2T = O_W1T + (size_t)2 * 256 * 2048 * 2;
constexpr size_t O_BIAS1 = O_W2T + (size_t)2 * 64 * 256 * 2;
constexpr size_t O_PAIRW = O_BIAS1 + 4096;
constexpr size_t O_PLIST = O_PAIRW + (size_t)NT * 6 * 4;
constexpr size_t O_HBUF = O_PLIST + (size_t)2 * 64 * 16384 * 4;
constexpr size_t O_YCAT = O_HBUF + (size_t)NT * 1024 * 2;
constexpr size_t O_R = O_YCAT + (size_t)NT * 1024 * 2;
constexpr size_t O_WGU = O_R;
constexpr size_t O_WD = O_WGU + (size_t)65 * 512 * 1024 * 2;
constexpr size_t O_R2 = O_WD + (size_t)65 * 1024 * 256 * 2;
constexpr int HROWS = 98304 + 64 * 256 + 16384;
constexpr size_t O_H = O_R2;
constexpr size_t O_Y = O_H + (size_t)HROWS * 256 * 2;
constexpr size_t O_END_MOE = O_Y + (size_t)16384 * 7 * 1024 * 2;
constexpr size_t O_QF = O_R;
constexpr size_t O_KF = O_QF + (size_t)NT * 512 * 2;
constexpr size_t O_VFT = O_KF + (size_t)NT * 512 * 2;
constexpr size_t O_G0 = O_VFT + (size_t)NT * 512 * 2;
constexpr size_t O_GZ = O_G0 + (size_t)NT * 1536 * 2;
constexpr size_t O_SM0 = O_GZ + (size_t)NT * 512 * 2;
constexpr size_t O_CUMF = O_SM0 + (size_t)NT * 16 * 4;
constexpr size_t O_MBUF = O_CUMF + (size_t)16 * TT * 4;
constexpr size_t O_NS = O_MBUF + (size_t)2048 * 128 * 128 * 2;
constexpr size_t O_SB = O_NS + (size_t)2048 * 128 * 128 * 2;
constexpr size_t O_END_L0 = O_SB + (size_t)2048 * 128 * 128 * 2;
constexpr size_t O_QEFF = O_HBUF;
constexpr size_t O_QN = O_R2;
constexpr size_t O_KCR = O_QN + (size_t)NT * 512 * 2;
constexpr size_t O_VCR = O_KCR + (size_t)NT * 128 * 2;
constexpr size_t O_KS = O_VCR + (size_t)NT * 128 * 2;
constexpr size_t O_VST = O_KS + (size_t)NT * 128 * 2;
constexpr size_t O_KW = O_VST + (size_t)NT * 128 * 2;
constexpr size_t O_VWT = O_KW + (size_t)NT * 128 * 2;
constexpr size_t O_LQ = O_VWT + (size_t)NT * 128 * 2;
constexpr size_t O_LK = O_LQ + (size_t)NT * 256 * 2;
constexpr size_t O_LV = O_LK + (size_t)NT * 256 * 2;
constexpr size_t O_LR = O_LV + (size_t)NT * 512 * 2;
constexpr size_t O_SM1 = O_LR + (size_t)NT * 512 * 2;
constexpr size_t O_KCMP = O_SM1 + (size_t)NT * 40 * 4;
constexpr size_t O_VCMPT = O_KCMP + (size_t)4 * 1024 * 64 * 2;
constexpr size_t O_QD = O_VCMPT + (size_t)4 * 1024 * 64 * 2;
constexpr size_t O_AN = O_QD + (size_t)2048 * 64 * 64 * 2;
constexpr size_t O_ST = O_AN + (size_t)2048 * 64 * 4;
constexpr size_t O_END_L1 = O_ST + (size_t)2048 * 128 * 64 * 4;
constexpr size_t WS_NEED = (O_END_MOE > O_END_L0 ? (O_END_MOE > O_END_L1 ? O_END_MOE : O_END_L1) : (O_END_L0 > O_END_L1 ? O_END_L0 : O_END_L1));
static_assert(WS_NEED < (size_t)600 * MiB, "workspace too large");

DEV int tidx() { int t = threadIdx.x; asm volatile("" : "+v"(t)); return t; }
typedef __bf16 bf2_t __attribute__((ext_vector_type(2)));
typedef float f2_t __attribute__((ext_vector_type(2)));
DEV bfraw f2bf(float f) { return __builtin_bit_cast(bfraw, (__bf16)f); }
DEV float bf2f(bfraw b) { return __uint_as_float(((uint32_t)b) << 16); }
DEV uint32_t pack2(float lo, float hi) { f2_t f = {lo, hi}; return __builtin_bit_cast(uint32_t, __builtin_convertvector(f, bf2_t)); }
DEV float lo2f(uint32_t u) { return __uint_as_float(u << 16); }
DEV float hi2f(uint32_t u) { return __uint_as_float(u & 0xffff0000u); }
DEV f32x4 mfma16(bf16x8 a, bf16x8 b, f32x4 c) { return __builtin_amdgcn_mfma_f32_16x16x32_bf16(a, b, c, 0, 0, 0); }
DEV float sigmoidf_(float x) { return 1.f / (1.f + __expf(-x)); }
DEV float siluf_(float x) { return x / (1.f + __expf(-x)); }
DEV float softplusf_(float x) { return fmaxf(x, 0.f) + log1pf(__expf(-fabsf(x))); }
DEV float logsigmoidf_(float x) { return fminf(x, 0.f) - log1pf(__expf(-fabsf(x))); }
DEV float ex2(float x) { return __builtin_amdgcn_exp2f(x); }
DEV void vm_drain() { asm volatile("s_waitcnt vmcnt(0)" ::: "memory"); }
DEV void lds_barrier() { asm volatile("s_waitcnt lgkmcnt(0)" ::: "memory"); __builtin_amdgcn_s_barrier(); asm volatile("" ::: "memory"); }
DEV void block_sync_mem() { asm volatile("s_waitcnt vmcnt(0) lgkmcnt(0)" ::: "memory"); __syncthreads(); }
union U4 { uint4 u; bf16x8 v; uint32_t w[4]; };
union U2 { uint2 u; uint32_t w[2]; };
DEV bf16x8 ld8(const bfraw* p) { U4 t; t.u = *(const uint4*)p; return t.v; }
DEV bf16x8 ld4x2(const bfraw* p0, const bfraw* p1) { U4 t; uint2 a = *(const uint2*)p0, b = *(const uint2*)p1; t.w[0] = a.x; t.w[1] = a.y; t.w[2] = b.x; t.w[3] = b.y; return t.v; }
DEV bf16x8 pack8(float a0, float a1, float a2, float a3, float a4, float a5, float a6, float a7) {
    U4 t; t.w[0] = pack2(a0, a1); t.w[1] = pack2(a2, a3); t.w[2] = pack2(a4, a5); t.w[3] = pack2(a6, a7); return t.v; }
DEV void st4bf(bfraw* p, float a, float b, float c, float d) { uint2 v; v.x = pack2(a, b); v.y = pack2(c, d); *(uint2*)p = v; }
DEV float shx(float v, int m) { const int l = tidx(); return __int_as_float(__builtin_amdgcn_ds_bpermute(((l ^ m) & 63) << 2, __float_as_int(v))); }
DEV float wave_sum(float v) { for (int m = 32; m >= 1; m >>= 1) v += shx(v, m); return v; }
DEV float wave_max(float v) { for (int m = 32; m >= 1; m >>= 1) v = fmaxf(v, shx(v, m)); return v; }
DEV float grp16_sum(float v) { v += shx(v, 1); v += shx(v, 2); v += shx(v, 4); v += shx(v, 8); return v; }
DEV float grpx_sum(float v) { v += shx(v, 16); v += shx(v, 32); return v; }

#define XB_TMO      128
#define XB_XCNT(j)  (256  + 64 * (j))
#define XB_XSUB(j)  (1280 + 64 * (j))
#define XB_XGEN(j)  (2304 + 64 * (j))
#define XB_TOP      3328
#define XB_TOPGEN   3392
#define XCD_BAR_WORDS 3456
#define XB_SPIN_CAP (1u << 27)
DEV unsigned xb_ld(unsigned* p)              { return __hip_atomic_load(p, __ATOMIC_RELAXED, __HIP_MEMORY_SCOPE_AGENT); }
DEV unsigned xb_add(unsigned* p, unsigned v) { return __hip_atomic_fetch_add(p, v, __ATOMIC_RELAXED, __HIP_MEMORY_SCOPE_AGENT); }
DEV unsigned xb_xcc_id() { return (unsigned)__builtin_amdgcn_s_getreg((3 << 11) | 20) & 0xFu; }
#define XB_SPIN(cond, bar) do { unsigned _sp = 0; while (cond) { __builtin_amdgcn_s_sleep(1); \
    if ((++_sp & 255u) == 0u) { if (xb_ld(&(bar)[XB_TMO])) break; if (_sp > XB_SPIN_CAP) { atomicAdd(&(bar)[XB_TMO], 1u); break; } } } } while (0)
struct XcdBarrier { unsigned* bar; unsigned x; volatile LAS unsigned* st; };
DEV XcdBarrier xcd_barrier_post(unsigned* bar, volatile LAS unsigned* st) {
    XcdBarrier b; b.bar = bar; b.x = xb_xcc_id(); b.st = st;
    if (tidx() == 0) (void)xb_add(&bar[XB_XCNT(b.x)], 1u);
    return b;
}
DEV void xcd_barrier_complete(unsigned* bar, unsigned x, unsigned& nloc, unsigned& nx) {
    const unsigned G = gridDim.x * gridDim.y * gridDim.z;
    unsigned sum, cnt, mine, sp = 0u;
    for (;;) {
        sum = 0u; cnt = 0u; mine = 0u;
#pragma unroll
        for (unsigned j = 0; j < 16; ++j) { const unsigned c = xb_ld(&bar[XB_XCNT(j)]); sum += c; cnt += (c > 0u) ? 1u : 0u; mine = (j == x) ? c : mine; }
        if (sum == G) break;
        __builtin_amdgcn_s_sleep(1);
        if ((++sp & 255u) == 0u) { if (xb_ld(&bar[XB_TMO])) break; if (sp > XB_SPIN_CAP) { atomicAdd(&bar[XB_TMO], 1u); break; } }
    }
    nloc = mine > 0u ? mine : 1u; nx = cnt > 0u ? cnt : 1u;
}
DEV void xcd_barrier(const XcdBarrier& b) {
    asm volatile("s_waitcnt vmcnt(0)" ::: "memory");
    __syncthreads();
    if (tidx() == 0) {
        unsigned* bar = b.bar;
        __builtin_amdgcn_s_waitcnt(0);
        unsigned nloc = b.st[0], nx = b.st[1];
        if (nloc == 0u) { xcd_barrier_complete(bar, b.x, nloc, nx); b.st[0] = nloc; b.st[1] = nx; }
        const unsigned old = xb_add(&bar[XB_XSUB(b.x)], 1u);
        const unsigned gen = old / nloc;
        if (old + 1u == (gen + 1u) * nloc) {
            __builtin_amdgcn_fence(__ATOMIC_RELEASE, "agent");
            asm volatile("s_waitcnt vmcnt(0)" ::: "memory");
            const unsigned og = xb_add(&bar[XB_TOP], 1u);
            const unsigned tg = og / nx;
            if (og + 1u == (tg + 1u) * nx) xb_add(&bar[XB_TOPGEN], 1u);
            else XB_SPIN(xb_ld(&bar[XB_TOPGEN]) == tg, bar);
            __builtin_amdgcn_fence(__ATOMIC_ACQUIRE, "agent");
            xb_add(&bar[XB_XGEN(b.x)], 1u);
            asm volatile("s_waitcnt vmcnt(0)" ::: "memory");
        } else {
            XB_SPIN(xb_ld(&bar[XB_XGEN(b.x)]) == gen, bar);
            __builtin_amdgcn_fence(__ATOMIC_ACQUIRE, "agent");
            asm volatile("s_waitcnt vmcnt(0)" ::: "memory");
        }
    }
    __syncthreads();
}

template <class AP, class BP, class EPI>
DEV void gemm_tile(char* smem, int nk, int a_kstep, AP aptr, BP bptr, EPI epi) {
    bfraw* As = (bfraw*)smem; bfraw* Bs = As + 256 * 72;
    const int tid = tidx(), lane = tid & 63, w = tid >> 6, wr = w >> 1, wc = w & 1;
    const int seg = tid & 7, r0 = tid >> 3;
    const bfraw* pa[4]; const bfraw* pb[2];
#pragma unroll
    for (int i = 0; i < 4; ++i) pa[i] = aptr(r0 + 64 * i) + seg * 8;
#pragma unroll
    for (int i = 0; i < 2; ++i) pb[i] = bptr(r0 + 64 * i) + seg * 8;
    uint4 ra0 = *(const uint4*)pa[0], ra1 = *(const uint4*)pa[1], ra2 = *(const uint4*)pa[2], ra3 = *(const uint4*)pa[3];
    uint4 rb0 = *(const uint4*)pb[0], rb1 = *(const uint4*)pb[1];
    f32x4 acc[4][4];
#pragma unroll
    for (int i = 0; i < 4; ++i)
#pragma unroll
        for (int j = 0; j < 4; ++j) acc[i][j] = f32x4{0.f, 0.f, 0.f, 0.f};
    for (int kt = 0; kt < nk; ++kt) {
        __syncthreads();
        *(uint4*)&As[(r0) * 72 + seg * 8] = ra0;
        *(uint4*)&As[(r0 + 64) * 72 + seg * 8] = ra1;
        *(uint4*)&As[(r0 + 128) * 72 + seg * 8] = ra2;
        *(uint4*)&As[(r0 + 192) * 72 + seg * 8] = ra3;
        *(uint4*)&Bs[(r0) * 72 + seg * 8] = rb0;
        *(uint4*)&Bs[(r0 + 64) * 72 + seg * 8] = rb1;
        __syncthreads();
        if (kt + 1 < nk) {
            const size_t ao = (size_t)(kt + 1) * a_kstep, bo = (size_t)(kt + 1) * 64;
            ra0 = *(const uint4*)(pa[0] + ao); ra1 = *(const uint4*)(pa[1] + ao); ra2 = *(const uint4*)(pa[2] + ao); ra3 = *(const uint4*)(pa[3] + ao);
            rb0 = *(const uint4*)(pb[0] + bo); rb1 = *(const uint4*)(pb[1] + bo);
        }
#pragma unroll
        for (int ks = 0; ks < 2; ++ks) {
            bf16x8 af[4], bfr[4];
#pragma unroll
            for (int i = 0; i < 4; ++i) af[i] = ld8(&As[(wr * 64 + i * 16 + (lane & 15)) * 72 + ks * 32 + (lane >> 4) * 8]);
#pragma unroll
            for (int j = 0; j < 4; ++j) bfr[j] = ld8(&Bs[(wc * 64 + j * 16 + (lane & 15)) * 72 + ks * 32 + (lane >> 4) * 8]);
#pragma unroll
            for (int i = 0; i < 4; ++i)
#pragma unroll
                for (int j = 0; j < 4; ++j) acc[i][j] = mfma16(af[i], bfr[j], acc[i][j]);
        }
    }
    epi(acc, wr * 64, wc * 64, lane);
}

constexpr int GLD = 72;
constexpr int GBUF = 512 * GLD;
template <bool AFFA = true, bool SGB = true, class AP, class BP, class EPI>
DEV void gemm_tile2(char* smem, int nk, int a_kstep, AP aptr, BP bptr, EPI epi) {
    bfraw* As = (bfraw*)smem;
    const int tid = tidx(), lane = tid & 63, w = tid >> 6, wr = w >> 2, wc = w & 3;
    const int seg = tid & 7, r0 = tid >> 3;
    const bfraw* pa0 = aptr(r0) + seg * 8;
    const int ast = (int)(aptr(r0 + 64) - aptr(r0));
    const bfraw* pa1 = AFFA ? pa0 + ast : aptr(r0 + 64) + seg * 8; const bfraw* pa2 = AFFA ? pa0 + 2 * ast : aptr(r0 + 128) + seg * 8; const bfraw* pa3 = AFFA ? pa0 + 3 * ast : aptr(r0 + 192) + seg * 8;
    const bfraw* pb0 = bptr(r0) + seg * 8;
    const int bst = (int)(bptr(r0 + 64) - bptr(r0));
    uint4 ra0 = *(const uint4*)pa0, ra1 = *(const uint4*)pa1, ra2 = *(const uint4*)pa2, ra3 = *(const uint4*)pa3;
    uint4 rb0 = *(const uint4*)pb0, rb1 = *(const uint4*)(pb0 + bst), rb2 = *(const uint4*)(pb0 + 2 * bst), rb3 = *(const uint4*)(pb0 + 3 * bst);
    f32x4 acc[8][4];
#pragma unroll
    for (int i = 0; i < 8; ++i)
#pragma unroll
        for (int j = 0; j < 4; ++j) acc[i][j] = f32x4{0.f, 0.f, 0.f, 0.f};
    const int so = r0 * GLD + seg * 8;
    const int fo = (lane & 15) * GLD + (lane >> 4) * 8;
    lds_barrier();
    {
        bfraw* Aw = As + so;
        *(uint4*)&Aw[0] = ra0; *(uint4*)&Aw[64 * GLD] = ra1; *(uint4*)&Aw[128 * GLD] = ra2; *(uint4*)&Aw[192 * GLD] = ra3;
        *(uint4*)&Aw[256 * GLD] = rb0; *(uint4*)&Aw[320 * GLD] = rb1; *(uint4*)&Aw[384 * GLD] = rb2; *(uint4*)&Aw[448 * GLD] = rb3;
        const size_t ao = (size_t)a_kstep, bo = 64;
        __builtin_amdgcn_sched_barrier(0);
        ra0 = *(const uint4*)(pa0 + ao); __builtin_amdgcn_sched_barrier(0); rb0 = *(const uint4*)(pb0 + bo); __builtin_amdgcn_sched_barrier(0);
        ra1 = *(const uint4*)(pa1 + ao); __builtin_amdgcn_sched_barrier(0); rb1 = *(const uint4*)(pb0 + (bst + bo)); __builtin_amdgcn_sched_barrier(0);
        ra2 = *(const uint4*)(pa2 + ao); __builtin_amdgcn_sched_barrier(0); rb2 = *(const uint4*)(pb0 + (2 * bst + bo)); __builtin_amdgcn_sched_barrier(0);
        ra3 = *(const uint4*)(pa3 + ao); __builtin_amdgcn_sched_barrier(0); rb3 = *(const uint4*)(pb0 + (3 * bst + bo)); __builtin_amdgcn_sched_barrier(0);
    }
#define GT_WL(i, W, L)                                                                                                               \
    if (W) {                                                                                                                         \
        if (i == 0) { *(uint4*)&Aw[0] = ra0; if (L) ra0 = *(const uint4*)(pa0 + ao); }                                               \
        if (i == 1) { *(uint4*)&Aw[256 * GLD] = rb0; if (L) rb0 = *(const uint4*)(pb0 + bo); }                                       \
        if (i == 2) { *(uint4*)&Aw[64 * GLD] = ra1; if (L) ra1 = *(const uint4*)(pa1 + ao); }                                        \
        if (i == 3) { *(uint4*)&Aw[320 * GLD] = rb1; if (L) rb1 = *(const uint4*)(pb0 + (bst + bo)); }                               \
        if (i == 4) { *(uint4*)&Aw[128 * GLD] = ra2; if (L) ra2 = *(const uint4*)(pa2 + ao); }                                       \
        if (i == 5) { *(uint4*)&Aw[384 * GLD] = rb2; if (L) rb2 = *(const uint4*)(pb0 + (2 * bst + bo)); }                           \
        if (i == 6) { *(uint4*)&Aw[192 * GLD] = ra3; if (L) ra3 = *(const uint4*)(pa3 + ao); }                                       \
        if (i == 7) { *(uint4*)&Aw[448 * GLD] = rb3; if (L) rb3 = *(const uint4*)(pb0 + (3 * bst + bo)); }                           \
    }
#define GT_BODY(W, L)                                                                                                                \
    {                                                                                                                                \
        lds_barrier();                                                                                                               \
        const int cur = kt & 1;                                                                                                      \
        const bfraw* Ac = As + cur * GBUF + fo;                                                                                      \
        bfraw* Aw = As + (cur ^ 1) * GBUF + so;                                                                                      \
        const size_t ao = (size_t)(kt + 2) * a_kstep, bo = (size_t)(kt + 2) * 64;                                                    \
        _Pragma("unroll") for (int ks = 0; ks < 2; ++ks) {                                                                           \
            const bfraw* Ab = Ac + (wr * 128) * GLD + ks * 32;                                                                       \
            const bfraw* Bb = Ac + (256 + wc * 64) * GLD + ks * 32;                                                                  \
            bf16x8 bfr[4], af[8];                                                                                                    \
            _Pragma("unroll") for (int j = 0; j < 4; ++j) bfr[j] = ld8(Bb + j * 16 * GLD);                                           \
            af[0] = ld8(Ab); af[1] = ld8(Ab + 16 * GLD);                                                                             \
            _Pragma("unroll") for (int i = 0; i < 8; ++i) {                                                                          \
                _Pragma("unroll") for (int j = 0; j < 4; ++j) acc[i][j] = mfma16(bfr[j], af[i], acc[i][j]);                          \
                if (i + 2 < 8) af[i + 2] = ld8(Ab + (i + 2) * 16 * GLD);                                                             \
                if (ks == 1) { GT_WL(i, W, L) }                                                                                      \
            }                                                                                                                        \
            if (SGB) {                                                                                                               \
                __builtin_amdgcn_sched_group_barrier(0x100, 6, 0);                                                                   \
                _Pragma("unroll") for (int i = 0; i < 8; ++i) {                                                                      \
                    __builtin_amdgcn_sched_group_barrier(0x008, 4, 0);                                                               \
                    if (i + 2 < 8) __builtin_amdgcn_sched_group_barrier(0x100, 1, 0);                                                \
                    if (ks == 1 && W) __builtin_amdgcn_sched_group_barrier(0x200, 1, 0);                                             \
                    if (ks == 1 && W && L) __builtin_amdgcn_sched_group_barrier(0x020, 1, 0);                                        \
                }                                                                                                                    \
            }                                                                                                                        \
        }                                                                                                                            \
    }
    int kt = 0;
    for (; kt + 2 < nk; ++kt) GT_BODY(1, 1)
    GT_BODY(1, 0)
    ++kt;
    GT_BODY(0, 0)
#undef GT_BODY
#undef GT_WL
    {
        const int t2 = tidx();
        epi(acc, (t2 >> 8) * 128, ((t2 >> 6) & 3) * 64, t2 & 63);
    }
}

DEV bool xq_next(unsigned* q, int nN, char* smem, int& mt, int& nt) {
    int* slot = (int*)(smem + 148000);
    __syncthreads();
    if (tidx() == 0) {
        const int T = 16 * nN, x0 = (int)xb_xcc_id() & 7;
        int res = -1;
        for (int k = 0; k < 8 && res < 0; ++k) {
            const int x = (x0 + k) & 7;
            if (xb_ld(&q[x]) < (unsigned)T) { const unsigned s = atomicAdd(&q[x], 1u); if (s < (unsigned)T) res = x * T + (int)s; }
        }
        *slot = res;
    }
    __syncthreads();
    const int res = *slot;
    if (res < 0) return false;
    const int T = 16 * nN, x = res / T, s = res % T, mg = s / (4 * nN), rem = s % (4 * nN);
    nt = rem >> 2; mt = x * 16 + mg * 4 + (rem & 3);
    return true;
}

DEV bool xs_tile(int nN, int rr, int& mt, int& nt) {
    const int T = 16 * nN;
    int G = (int)gridDim.x, bid = (int)blockIdx.x;
    asm volatile("" : "+s"(G), "+s"(bid));
    int gidx;
    if ((G & 7) == 0) { const int bpx = G >> 3, s = (bid >> 3) + bpx * rr; if (s >= T) return false; gidx = (bid & 7) * T + s; }
    else { gidx = bid + G * rr; if (gidx >= 8 * T) return false; }
    const int x = gidx / T, s = gidx % T, mg = s / (4 * nN), rem = s % (4 * nN);
    nt = __builtin_amdgcn_readfirstlane(rem >> 2); mt = __builtin_amdgcn_readfirstlane(x * 16 + mg * 4 + (rem & 3));
    return true;
}

template <class CM>
DEV void tr_tile_w(float* tl, const float* src, size_t ldsrc, bfraw* dst, size_t lddst, int k0, int n0, CM cmap) {
    const int lane = tidx() & 63;
    const int c4 = (lane & 15) * 4, r = lane >> 4;
    const int sc = cmap(n0 + c4);
    float4 v[16];
#pragma unroll
    for (int ps = 0; ps < 16; ++ps) v[ps] = sc >= 0 ? *(const float4*)(src + (size_t)(k0 + ps * 4 + r) * ldsrc + sc) : make_float4(0.f, 0.f, 0.f, 0.f);
#pragma unroll
    for (int ps = 0; ps < 16; ++ps) *(float4*)&tl[(ps * 4 + r) * 68 + c4] = v[ps];
    const int n = lane;
#pragma unroll
    for (int ks = 0; ks < 8; ++ks) {
        float q[8];
#pragma unroll
        for (int j = 0; j < 8; ++j) q[j] = tl[(ks * 8 + j) * 68 + n];
        uint4 o; o.x = pack2(q[0], q[1]); o.y = pack2(q[2], q[3]); o.z = pack2(q[4], q[5]); o.w = pack2(q[6], q[7]);
        *(uint4*)&dst[(size_t)(n0 + n) * lddst + k0 + ks * 8] = o;
    }
}
template <class CM>
DEV void tr_tile(char* smem, const float* src, size_t ldsrc, bfraw* dst, size_t lddst, int k0, int n0, CM cmap) {
    float* tl = (float*)smem;
    const int tid = tidx();
    {
        const int c = tid & 63, r = tid >> 6;
        const int sc = cmap(n0 + c);
#pragma unroll
        for (int ps = 0; ps < 8; ++ps) {
            const int k = ps * 8 + r;
            tl[k * 65 + c] = sc >= 0 ? src[(size_t)(k0 + k) * ldsrc + sc] : 0.f;
        }
    }
    __syncthreads();
    {
        const int n = tid >> 3, ks = tid & 7;
        float v[8];
#pragma unroll
        for (int q = 0; q < 8; ++q) v[q] = tl[(ks * 8 + q) * 65 + n];
        uint4 o; o.x = pack2(v[0], v[1]); o.y = pack2(v[2], v[3]); o.z = pack2(v[4], v[5]); o.w = pack2(v[6], v[7]);
        *(uint4*)&dst[(size_t)(n0 + n) * lddst + k0 + ks * 8] = o;
    }
    __syncthreads();
}
DEV int map_in0(int n) {
    if (n < 1536) return n;
    if (n < 3072) return 1544 + (n - 1536);
    if (n < 3584) return 3088 + (n - 3072);
    if (n < 3592) return 1536 + (n - 3584);
    if (n < 3596) return 3080 + (n - 3592);
    if (n < 3600) return 3084 + (n - 3596);
    return -1;
}
DEV int map_in1(int n) {
    if (n < 1280) return n;
    if (n < 1536) return 1304 + (n - 1280);
    if (n < 1792) return 1560 + (n - 1536);
    if (n < 2304) return 1816 + (n - 1792);
    if (n < 2816) return 2344 + (n - 2304);
    if (n < 2840) return 1280 + (n - 2816);
    if (n < 2856) return 2328 + (n - 2840);
    return -1;
}

DEV void prologue_item(const Params& p, char* smem, int item) {
    const int tid = tidx();
    {
        const int l = item / 96, nch = item % 96;
        const int n = nch * 64 + (tid & 63), kg = tid >> 6, k0 = kg * 128;
        const float* W = p.in[I_ADAW] + (size_t)l * 1024 * 6144;
        const float* c = p.in[I_C];
        float a0 = 0.f, a1 = 0.f;
        float* scl = (float*)smem + 1024;
        __syncthreads();
#pragma unroll
        for (int q = 0; q < 4; ++q) scl[q * 512 + tid] = siluf_(c[q * 512 + tid]);
        __syncthreads();
#pragma unroll
        for (int kb = 0; kb < 128; kb += 16) {
            float wv[16];
#pragma unroll
            for (int k = 0; k < 16; ++k) wv[k] = W[(size_t)(k0 + kb + k) * 6144 + n];
#pragma unroll
            for (int k = 0; k < 16; ++k) { a0 += scl[k0 + kb + k] * wv[k]; a1 += scl[1024 + k0 + kb + k] * wv[k]; }
        }
        float* red = (float*)smem;
        __syncthreads();
        red[tid] = a0; red[512 + tid] = a1;
        __syncthreads();
        if (tid < 128) {
            const int bb = tid >> 6, nn = tid & 63;
            float sacc = p.in[I_ADAB][l * 6144 + nch * 64 + nn];
#pragma unroll
            for (int q = 0; q < 8; ++q) sacc += red[bb * 512 + q * 64 + nn];
            ((float*)(p.ws + O_MOD))[(l * 2 + bb) * 6144 + nch * 64 + nn] = sacc;
        }
        __syncthreads();
    }
}
constexpr int PRO_WITEMS = 960 + 256 + 768 + 256 + 64 + 256 + 8;
DEV void prologue_witem(const Params& p, float* tl, int item) {
    if (item < 960) { tr_tile_w(tl, p.in[I_EVWIN], 3600, (bfraw*)(p.ws + O_WIN0), 1024, (item % 16) * 64, (item / 16) * 64, [](int n) { return map_in0(n); }); return; }
    item -= 960;
    if (item < 256) { tr_tile_w(tl, p.in[I_EVWOUT], 1024, (bfraw*)(p.ws + O_WOUT0), 1024, (item % 16) * 64, (item / 16) * 64, [](int n) { return n; }); return; }
    item -= 256;
    if (item < 768) { tr_tile_w(tl, p.in[I_ODWIN], 2856, (bfraw*)(p.ws + O_WIN1), 1024, (item % 16) * 64, (item / 16) * 64, [](int n) { return map_in1(n); }); return; }
    item -= 768;
    if (item < 256) { tr_tile_w(tl, p.in[I_ODWOUT], 1024, (bfraw*)(p.ws + O_WOUT1), 1024, (item % 16) * 64, (item / 16) * 64, [](int n) { return n; }); return; }
    item -= 256;
    if (item < 64) {
        const int l = item / 32, rem = item % 32;
        tr_tile_w(tl, p.in[I_ROUTER] + (size_t)l * 1024 * 64, 64, (bfraw*)(p.ws + O_WRT) + (size_t)l * 128 * 1024, 1024, (rem % 16) * 64, (rem / 16) * 64, [](int n) { return n < 64 ? n : -1; });
        return;
    }
    item -= 64;
    if (item < 256) {
        const int wh = item / 128, rem = item % 128;
        tr_tile_w(tl, p.in[I_CW1] + (size_t)wh * 2048 * 256, 256, (bfraw*)(p.ws + O_W1T) + (size_t)wh * 256 * 2048, 2048, (rem % 32) * 64, (rem / 32) * 64, [](int n) { return n; });
        return;
    }
    item -= 256;
    { const int wh = item / 4, kt = item % 4;
      tr_tile_w(tl, p.in[I_CW2] + (size_t)wh * 256 * 64, 64, (bfraw*)(p.ws + O_W2T) + (size_t)wh * 64 * 256, 256, kt * 64, 0, [](int n) { return n; }); }
}
DEV void prologue_bias1(const Params& p, char* smem, int wh) {
    const int tid = tidx();
    const float* pos = p.in[I_NSAPOS] + wh * 2048;
    const float* w1 = p.in[I_CW1] + (size_t)wh * 2048 * 256;
    const int j = tid & 255, kh = tid >> 8;
    float a = 0.f;
    for (int kk = kh * 1024; kk < kh * 1024 + 1024; ++kk) a += pos[kk] * w1[(size_t)kk * 256 + j];
    float* red = (float*)smem;
    __syncthreads();
    if (kh == 1) red[j] = a;
    __syncthreads();
    if (kh == 0) ((float*)(p.ws + O_BIAS1))[wh * 256 + j] = a + red[j];
    __syncthreads();
}
DEV void phase_prologue(const Params& p, char* smem) {
    for (int it = blockIdx.x; it < 192 + 2; it += gridDim.x) { if (it < 192) prologue_item(p, smem, it); else prologue_bias1(p, smem, it - 192); }
    const int w = tidx() >> 6;
    float* tl = (float*)smem + w * (64 * 68);
    __syncthreads();
    for (int it = blockIdx.x * 8 + w; it < PRO_WITEMS; it += gridDim.x * 8) prologue_witem(p, tl, it);
    __syncthreads();
}

constexpr int MOECVT_ITEMS = 65 * 192;
DEV void moe_convert_witem(const Params& p, float* tl, int layer, int item) {
    const int e = item / 192, s = item % 192;
    bfraw* wgu = (bfraw*)(p.ws + O_WGU) + (size_t)e * 512 * 1024;
    bfraw* wd = (bfraw*)(p.ws + O_WD) + (size_t)e * 1024 * 256;
    const size_t eo = (size_t)(layer * 64 + e) * 1024 * 256, so = (size_t)layer * 1024 * 256;
    if (s < 64) {
        const float* src = e < 64 ? p.in[I_MWG] + eo : p.in[I_SWG] + so;
        tr_tile_w(tl, src, 256, wgu, 1024, (s % 16) * 64, (s / 16) * 64, [](int n) { return n; });
    } else if (s < 128) {
        const int s2 = s - 64;
        const float* src = e < 64 ? p.in[I_MWU] + eo : p.in[I_SWU] + so;
        tr_tile_w(tl, src, 256, wgu + (size_t)256 * 1024, 1024, (s2 % 16) * 64, (s2 / 16) * 64, [](int n) { return n; });
    } else {
        const int s2 = s - 128;
        const float* src = e < 64 ? p.in[I_MWD] + eo : p.in[I_SWD] + so;
        tr_tile_w(tl, src, 1024, wd, 256, (s2 % 4) * 64, (s2 / 4) * 64, [](int n) { return n; });
    }
}
DEV void phase_moe_convert(const Params& p, char* smem, int layer) {
    const int w = tidx() >> 6;
    float* tl = (float*)smem + w * (64 * 68);
    __syncthreads();
    for (int it = blockIdx.x * 8 + w; it < MOECVT_ITEMS; it += gridDim.x * 8) moe_convert_witem(p, tl, layer, it);
    __syncthreads();
}

DEV void norm_row(const float* xrow, const float* gain, const float* sc, const float* sh, bfraw* drow, int lane) {
    float4 v[4]; float ss = 0.f;
#pragma unroll
    for (int i = 0; i < 4; ++i) { v[i] = *(const float4*)(xrow + lane * 4 + 256 * i); ss += v[i].x * v[i].x + v[i].y * v[i].y + v[i].z * v[i].z + v[i].w * v[i].w; }
    ss = wave_sum(ss);
    const float rs = rsqrtf(ss * (1.f / 1024.f) + EPSF);
#pragma unroll
    for (int i = 0; i < 4; ++i) {
        const int c = lane * 4 + 256 * i;
        const float4 g = *(const float4*)(gain + c), s1 = *(const float4*)(sc + c), s0 = *(const float4*)(sh + c);
        st4bf(drow + c, v[i].x * rs * g.x * (1.f + s1.x) + s0.x, v[i].y * rs * g.y * (1.f + s1.y) + s0.y,
                        v[i].z * rs * g.z * (1.f + s1.z) + s0.z, v[i].w * rs * g.w * (1.f + s1.w) + s0.w);
    }
}
DEV const float* modp(const Params& p, int layer, int b, int chunk) { return (const float*)(p.ws + O_MOD) + (size_t)(layer * 2 + b) * 6144 + chunk * 1024; }

DEV void phase_norm1(const Params& p, const float* xsrc, int layer) {
    const int lane = tidx() & 63, w = tidx() >> 6;
    bfraw* hb = (bfraw*)(p.ws + O_HBUF);
    for (int row = blockIdx.x * 8 + w; row < NT; row += gridDim.x * 8) {
        const int b = row >> 14;
        norm_row(xsrc + (size_t)row * 1024, p.in[I_NMIX] + layer * 1024, modp(p, layer, b, 1), modp(p, layer, b, 0), hb + (size_t)row * 1024, lane);
    }
}

template <int NI>
DEV void epi2_headnorm(const f32x4 (&acc)[NI][4], int lane, const float* gain, float mul, bfraw* dst, size_t rstride) {
    const int c = lane & 15, g = lane >> 4;
    float4 gn[4];
#pragma unroll
    for (int j = 0; j < 4; ++j) { gn[j] = *(const float4*)(gain + j * 16 + 4 * g); gn[j].x *= mul; gn[j].y *= mul; gn[j].z *= mul; gn[j].w *= mul; }
#pragma unroll
    for (int i = 0; i < NI; ++i) {
        float ss = 0.f;
#pragma unroll
        for (int j = 0; j < 4; ++j) ss += acc[i][j][0] * acc[i][j][0] + acc[i][j][1] * acc[i][j][1] + acc[i][j][2] * acc[i][j][2] + acc[i][j][3] * acc[i][j][3];
        ss = grpx_sum(ss);
        const float rs = rsqrtf(ss * (1.f / 64.f) + EPSF);
        bfraw* d = dst + (size_t)(i * 16 + c) * rstride + 4 * g;
#pragma unroll
        for (int j = 0; j < 4; ++j) st4bf(d + j * 16, acc[i][j][0] * rs * gn[j].x, acc[i][j][1] * rs * gn[j].y, acc[i][j][2] * rs * gn[j].z, acc[i][j][3] * rs * gn[j].w);
    }
}
template <int NI>
DEV void epi2_store_bf16(const f32x4 (&acc)[NI][4], int lane, bfraw* dst, size_t rstride) {
    const int c = lane & 15, g = lane >> 4;
#pragma unroll
    for (int i = 0; i < NI; ++i) {
        bfraw* d = dst + (size_t)(i * 16 + c) * rstride + 4 * g;
#pragma unroll
        for (int j = 0; j < 4; ++j) st4bf(d + j * 16, acc[i][j][0], acc[i][j][1], acc[i][j][2], acc[i][j][3]);
    }
}
template <int NI>
DEV void epi2_store_T(const f32x4 (&acc)[NI][4], int lane, bfraw* dstT, size_t cstride) {
    const int c = lane & 15, g = lane >> 4;
#pragma unroll
    for (int i = 0; i < NI; ++i)
#pragma unroll
        for (int j = 0; j < 4; ++j)
#pragma unroll
            for (int r = 0; r < 4; ++r) dstT[(size_t)(j * 16 + 4 * g + r) * cstride + i * 16 + c] = f2bf(acc[i][j][r]);
}

DEV void phase_inproj0(const Params& p, char* smem, unsigned* xq) {
    const bfraw* A = (const bfraw*)(p.ws + O_HBUF);
    const bfraw* Bt = (const bfraw*)(p.ws + O_WIN0);
    constexpr int NTL = NIN0 / 256;
    for (int rr = 0;; ++rr) {
        int mt, nt;
        if (!xs_tile(NTL, rr, mt, nt)) break;
        const int m0 = __builtin_amdgcn_readfirstlane(mt * 256), n0 = __builtin_amdgcn_readfirstlane(nt * 256);
        gemm_tile2(smem, 16, 64,
            [&](int r) { return A + (size_t)(m0 + r) * 1024; },
            [&](int r) { return Bt + (size_t)(n0 + r) * 1024; },
            [&](const f32x4 (&acc)[8][4], int rb, int cbk, int lane) {
                const int cb = n0 + cbk;
                const int tok0 = m0 + rb;
                const int b = tok0 >> 14, t0 = tok0 & (TT - 1);
                if (cb < 512) {
                    const int hh = cb >> 6;
                    epi2_headnorm<8>(acc, lane, p.in[I_FOXQN], 0.125f * LOG2E, (bfraw*)(p.ws + O_QF) + ((size_t)(b * 8 + hh) * TT + t0) * 64, 64);
                } else if (cb < 1024) {
                    const int hh = (cb - 512) >> 6;
                    epi2_headnorm<8>(acc, lane, p.in[I_FOXKN], 1.f, (bfraw*)(p.ws + O_KF) + ((size_t)(b * 8 + hh) * TT + t0) * 64, 64);
                } else if (cb < 1536) {
                    const int hh = (cb - 1024) >> 6;
                    epi2_store_T<8>(acc, lane, (bfraw*)(p.ws + O_VFT) + (size_t)(b * 8 + hh) * 64 * TT + t0, TT);
                } else if (cb < 3072) {
                    epi2_store_bf16<8>(acc, lane, (bfraw*)(p.ws + O_G0) + (size_t)tok0 * 1536 + (cb - 1536), 1536);
                } else if (cb < 3584) {
                    epi2_store_bf16<8>(acc, lane, (bfraw*)(p.ws + O_GZ) + (size_t)tok0 * 512 + (cb - 3072), 512);
                } else if (cb == 3584) {
                    const int c = lane & 15, g = lane >> 4;
                    float* sm = (float*)(p.ws + O_SM0);
#pragma unroll
                    for (int i = 0; i < 8; ++i) *(float4*)&sm[(size_t)(tok0 + i * 16 + c) * 16 + 4 * g] = make_float4(acc[i][0][0], acc[i][0][1], acc[i][0][2], acc[i][0][3]);
                }
            });
    }
}

DEV void fox_cumsum_item(const Params& p, char* smem, int item) {
    const int b = item >> 3, h = item & 7, tid = tidx();
    const float* sm = (const float*)(p.ws + O_SM0);
    const float fb = p.in[I_FOXFB][h];
    float v[32]; float run = 0.f;
    const int tb = tid * 32;
#pragma unroll
    for (int i = 0; i < 32; ++i) { run += logsigmoidf_(sm[(size_t)(b * TT + tb + i) * 16 + h] + fb) * LOG2E; v[i] = run; }
    float* red = (float*)smem;
    __syncthreads();
    red[tid] = run;
    __syncthreads();
    if (tid < 64) {
        float s[8]; float a = 0.f;
#pragma unroll
        for (int i = 0; i < 8; ++i) { a += red[tid * 8 + i]; s[i] = a; }
        float incl = a;
        for (int m = 1; m < 64; m <<= 1) { const float o = __shfl_up(incl, m); if (tid >= m) incl += o; }
        const float excl = incl - a;
#pragma unroll
        for (int i = 0; i < 8; ++i) red[512 + tid * 8 + i] = excl + s[i] - red[tid * 8 + i];
    }
    __syncthreads();
    const float off = red[512 + tid];
    float* cf = (float*)(p.ws + O_CUMF) + (size_t)item * TT + tb;
#pragma unroll
    for (int i = 0; i < 32; ++i) cf[i] = v[i] + off;
    __syncthreads();
}
DEV void fox_item(const Params& p, int bh, int qb) {
    const int lane = tidx() & 63, w = tidx() >> 6, c = lane & 15, g = lane >> 4;
    const int b = bh >> 3, h = bh & 7;
    const bfraw* Q = (const bfraw*)(p.ws + O_QF) + (size_t)bh * TT * 64;
    const bfraw* K = (const bfraw*)(p.ws + O_KF) + (size_t)bh * TT * 64;
    const bfraw* VT = (const bfraw*)(p.ws + O_VFT) + (size_t)bh * 64 * TT;
    const float* cum = (const float*)(p.ws + O_CUMF) + (size_t)bh * TT;
    const float mq = wave_max(fabsf(p.in[I_FOXQN][lane])), mk = wave_max(fabsf(p.in[I_FOXKN][lane]));
    const float Mb2 = 8.f * mq * mk * LOG2E;
    const int q0w = qb * 256 + w * 32;
    int tq[2]; float cq[2]; bf16x8 qf[2][2]; f32x4 O[2][4]; float l[2];
#pragma unroll
    for (int cg = 0; cg < 2; ++cg) {
        tq[cg] = q0w + cg * 16 + c; cq[cg] = cum[tq[cg]] - Mb2; l[cg] = 0.f;
#pragma unroll
        for (int ks = 0; ks < 2; ++ks) qf[cg][ks] = ld8(Q + (size_t)tq[cg] * 64 + ks * 32 + g * 8);
#pragma unroll
        for (int dt = 0; dt < 4; ++dt) O[cg][dt] = f32x4{0.f, 0.f, 0.f, 0.f};
    }
    for (int kb = 0; kb <= q0w; kb += 32) {
        bf16x8 kf[2][2], vf[4]; float4 ck[2];
#pragma unroll
        for (int kt = 0; kt < 2; ++kt) {
#pragma unroll
            for (int ks = 0; ks < 2; ++ks) kf[kt][ks] = ld8(K + (size_t)(kb + kt * 16 + c) * 64 + ks * 32 + g * 8);
            ck[kt] = *(const float4*)(cum + kb + kt * 16 + 4 * g);
        }
#pragma unroll
        for (int dt = 0; dt < 4; ++dt) { const bfraw* vp = VT + (size_t)(dt * 16 + c) * TT + kb + 4 * g; vf[dt] = ld4x2(vp, vp + 16); }
        const bool diag = (kb == q0w);
#pragma unroll
        for (int cg = 0; cg < 2; ++cg) {
            float pr[2][4];
#pragma unroll
            for (int kt = 0; kt < 2; ++kt) {
                f32x4 S = mfma16(kf[kt][0], qf[cg][0], f32x4{0.f, 0.f, 0.f, 0.f});
                S = mfma16(kf[kt][1], qf[cg][1], S);
                const float ckv[4] = {ck[kt].x, ck[kt].y, ck[kt].z, ck[kt].w};
#pragma unroll
                for (int r = 0; r < 4; ++r) {
                    float e = ex2(S[r] + cq[cg] - ckv[r]);
                    if (diag && (kb + kt * 16 + 4 * g + r > tq[cg])) e = 0.f;
                    pr[kt][r] = e; l[cg] += e;
                }
            }
            const bf16x8 pb = pack8(pr[0][0], pr[0][1], pr[0][2], pr[0][3], pr[1][0], pr[1][1], pr[1][2], pr[1][3]);
#pragma unroll
            for (int dt = 0; dt < 4; ++dt) O[cg][dt] = mfma16(vf[dt], pb, O[cg][dt]);
        }
    }
    bfraw* yc = (bfraw*)(p.ws + O_YCAT);
#pragma unroll
    for (int cg = 0; cg < 2; ++cg) {
        const float inv = 1.f / grpx_sum(l[cg]);
        bfraw* d = yc + (size_t)(b * TT + tq[cg]) * 1024 + h * 64 + 4 * g;
#pragma unroll
        for (int dt = 0; dt < 4; ++dt) st4bf(d + dt * 16, O[cg][dt][0] * inv, O[cg][dt][1] * inv, O[cg][dt][2] * inv, O[cg][dt][3] * inv);
    }
}

constexpr int GA_XR = 0, GA_LM = 17408, GA_KB = 36864, GA_KDT = 54272, GA_ATT = 72704, GA_SM = 81920, GA_RHS = 83968, GA_RAW = 117760;
DEV float gdn_conv_at(const bfraw* G0, const float* cw, int b, int t, int col, float& x3, float& x2, float& x1) {
    const float x = bf2f(G0[(size_t)(b * TT + t) * 1536 + col]);
    const float y = cw[0 * 1536 + col] * x3 + cw[1 * 1536 + col] * x2 + cw[2 * 1536 + col] * x1 + cw[3 * 1536 + col] * x;
    x3 = x2; x2 = x1; x1 = x;
    return siluf_(y);
}
DEV int opaque_tid() { return tidx(); }
#define OPQ_TID() const int tid = opaque_tid(), lane = tid & 63, w = tid >> 6, c = lane & 15, g = lane >> 4; (void)lane; (void)w; (void)c; (void)g
DEV void gdn_a_item(const Params& p, char* smem, int item) {
    const int bh = item >> 8, n = item & 255, b = bh >> 2, h = bh & 3, t0 = n * 64;
    const bfraw* G0 = (const bfraw*)(p.ws + O_G0);
    const float* cw = p.in[I_GCONV];
    bfraw* qbuf = (bfraw*)(smem + GA_XR);
    float* Lm = (float*)(smem + GA_LM);
    bfraw* XT = (bfraw*)(smem + GA_XR);
    bfraw* kbuf = (bfraw*)(smem + GA_KB);
    bfraw* kdT = (bfraw*)(smem + GA_KDT);
    bfraw* att = (bfraw*)(smem + GA_ATT);
    float* gc = (float*)(smem + GA_SM);
    bfraw* rhs = (bfraw*)(smem + GA_RHS);
    float* beta = gc + 64; float* eg = gc + 128; float* ed = gc + 192;
    __syncthreads();
    bfraw* raw = (bfraw*)(smem + GA_RAW);
    for (int m = 0; m < 2; ++m) {
        {
            OPQ_TID();
            for (int ch = tid; ch < 67 * 16; ch += NTHR) {
                const int rr = ch >> 4, cc = (ch & 15) * 8, tt = t0 - 3 + rr;
                uint4 v = make_uint4(0u, 0u, 0u, 0u);
                if (tt >= 0) v = *(const uint4*)(G0 + (size_t)(b * TT + tt) * 1536 + m * 512 + h * 128 + cc);
                *(uint4*)&raw[rr * 128 + cc] = v;
            }
        }
        __syncthreads();
        {
            OPQ_TID();
            const int d = tid & 127, qt = tid >> 7, col = m * 512 + h * 128 + d, i0 = qt * 16;
            bfraw* dstb = m ? kbuf : qbuf;
            const float w0 = cw[col], w1 = cw[1536 + col], w2 = cw[2 * 1536 + col], w3 = cw[3 * 1536 + col];
            float x3 = bf2f(raw[(i0) * 128 + d]), x2 = bf2f(raw[(i0 + 1) * 128 + d]), x1 = bf2f(raw[(i0 + 2) * 128 + d]);
#pragma unroll 4
            for (int i = i0; i < i0 + 16; ++i) {
                const float x = bf2f(raw[(i + 3) * 128 + d]);
                dstb[i * 136 + d] = f2bf(siluf_(w0 * x3 + w1 * x2 + w2 * x1 + w3 * x));
                x3 = x2; x2 = x1; x1 = x;
            }
        }
        __syncthreads();
    }
    { OPQ_TID();
    if (w == 0) {
        const float* sm = (const float*)(p.ws + O_SM0) + (size_t)(b * TT + t0 + lane) * 16;
        const float gv = -__expf(p.in[I_GALOG][h]) * softplusf_(sm[8 + h] + p.in[I_GDTB][h]);
        float incl = gv;
        for (int m = 1; m < 64; m <<= 1) { const float o = __shfl_up(incl, m); if (lane >= m) incl += o; }
        const float gl = __shfl(incl, 63);
        gc[lane] = incl; beta[lane] = sigmoidf_(sm[12 + h]); eg[lane] = __expf(incl); ed[lane] = __expf(gl - incl);
        if (lane == 0) gc[256] = __expf(gl);
    } }
    __syncthreads();
    { OPQ_TID();
#pragma unroll 1
    for (int rr = 0; rr < 8; ++rr) {
        const int i = w * 8 + rr;
        uint32_t* qp = (uint32_t*)&qbuf[i * 136 + lane * 2];
        uint32_t* kp = (uint32_t*)&kbuf[i * 136 + lane * 2];
        const uint32_t qv = *qp, kv = *kp;
        const float q0 = lo2f(qv), q1 = hi2f(qv), k0 = lo2f(kv), k1 = hi2f(kv);
        const float qs = wave_sum(q0 * q0 + q1 * q1), ks = wave_sum(k0 * k0 + k1 * k1);
        const float qi = rsqrtf(qs + EPSF) * 0.08838834764831845f, ki = rsqrtf(ks + EPSF);
        *qp = pack2(q0 * qi, q1 * qi);
        *kp = pack2(k0 * ki, k1 * ki);
        const float e = ed[i];
        kdT[(lane * 2) * 72 + i] = f2bf(k0 * ki * e);
        kdT[(lane * 2 + 1) * 72 + i] = f2bf(k1 * ki * e);
    } }
    __syncthreads();
    {
        OPQ_TID();
        const int mat = w >> 2, ti = w & 3;
        const bfraw* Ab = mat ? qbuf : kbuf;
        f32x4 acc[4];
#pragma unroll
        for (int j = 0; j < 4; ++j) acc[j] = f32x4{0.f, 0.f, 0.f, 0.f};
#pragma unroll
        for (int ks = 0; ks < 4; ++ks) {
            const bf16x8 a = ld8(&Ab[(ti * 16 + c) * 136 + ks * 32 + g * 8]);
#pragma unroll
            for (int j = 0; j < 4; ++j) acc[j] = mfma16(a, ld8(&kbuf[(j * 16 + c) * 136 + ks * 32 + g * 8]), acc[j]);
        }
#pragma unroll
        for (int j = 0; j < 4; ++j)
#pragma unroll
            for (int r = 0; r < 4; ++r) {
                const int i = ti * 16 + 4 * g + r, jj = j * 16 + c;
                const float dec = __expf(gc[i] - gc[jj]);
                if (mat == 0) Lm[i * 64 + jj] = (i > jj) ? beta[i] * acc[j][r] * dec : 0.f;
                else att[i * 72 + jj] = f2bf((i >= jj) ? acc[j][r] * dec : 0.f);
            }
        const int i = tid >> 3, d0 = (tid & 7) * 16;
        const float e = eg[i];
        bfraw* qe = (bfraw*)(p.ws + O_QEFF) + ((size_t)item * 64 + i) * 128 + d0;
        U4 oa, ob;
#pragma unroll
        for (int q = 0; q < 4; ++q) {
            const uint32_t v = *(const uint32_t*)&qbuf[i * 136 + d0 + 2 * q]; oa.w[q] = pack2(lo2f(v) * e, hi2f(v) * e);
            const uint32_t v2 = *(const uint32_t*)&qbuf[i * 136 + d0 + 8 + 2 * q]; ob.w[q] = pack2(lo2f(v2) * e, hi2f(v2) * e);
        }
        *(uint4*)qe = oa.u; *(uint4*)(qe + 8) = ob.u;
    }
    lds_barrier();
    {
        OPQ_TID();
        for (int ch = tid; ch < 67 * 16; ch += NTHR) {
            const int rr = ch >> 4, cc = (ch & 15) * 8, tt = t0 - 3 + rr;
            uint4 v = make_uint4(0u, 0u, 0u, 0u);
            if (tt >= 0) v = *(const uint4*)(G0 + (size_t)(b * TT + tt) * 1536 + 1024 + h * 128 + cc);
            *(uint4*)&raw[rr * 128 + cc] = v;
        }
    }
    __syncthreads();
    {
        OPQ_TID();
        const int d = tid & 127, qt = tid >> 7, col = 1024 + h * 128 + d, i0 = qt * 16;
        const float w0 = cw[col], w1 = cw[1536 + col], w2 = cw[2 * 1536 + col], w3 = cw[3 * 1536 + col];
        float x3 = bf2f(raw[(i0) * 128 + d]), x2 = bf2f(raw[(i0 + 1) * 128 + d]), x1 = bf2f(raw[(i0 + 2) * 128 + d]);
#pragma unroll 4
        for (int i = i0; i < i0 + 16; ++i) {
            const float x = bf2f(raw[(i + 3) * 128 + d]);
            rhs[i * 264 + d] = f2bf(siluf_(w0 * x3 + w1 * x2 + w2 * x1 + w3 * x) * beta[i]);
            rhs[i * 264 + 128 + d] = f2bf(bf2f(kbuf[i * 136 + d]) * beta[i] * eg[i]);
            x3 = x2; x2 = x1; x1 = x;
        }
    }
    __syncthreads();
    float x[64];
    const int tid = opaque_tid();
    if (tid < 256) {
#pragma unroll
        for (int i = 0; i < 64; ++i) {
            float s = bf2f(rhs[i * 264 + tid]), s2 = 0.f;
            const float4* Lr = (const float4*)&Lm[i * 64];
#pragma unroll
            for (int j4 = 0; j4 < (i + 3) / 4; ++j4) {
                const float4 lv = Lr[j4];
                s -= lv.x * x[j4 * 4];
                if (j4 * 4 + 1 < i) s2 -= lv.y * x[j4 * 4 + 1];
                if (j4 * 4 + 2 < i) s -= lv.z * x[j4 * 4 + 2];
                if (j4 * 4 + 3 < i) s2 -= lv.w * x[j4 * 4 + 3];
            }
            s += s2;
            asm volatile("" : "+v"(s) :: "memory");
            x[i] = s;
        }
    }
    __syncthreads();
    if (tid < 256) {
#pragma unroll
        for (int q = 0; q < 8; ++q) {
            uint4 o; o.x = pack2(x[q * 8 + 0], x[q * 8 + 1]); o.y = pack2(x[q * 8 + 2], x[q * 8 + 3]); o.z = pack2(x[q * 8 + 4], x[q * 8 + 5]); o.w = pack2(x[q * 8 + 6], x[q * 8 + 7]);
            *(uint4*)&XT[tid * 72 + q * 8] = o;
        }
    }
    block_sync_mem();
    {
        OPQ_TID();
        f32x4 a3[4], a4[4];
#pragma unroll
        for (int it = 0; it < 4; ++it) { a3[it] = f32x4{0.f, 0.f, 0.f, 0.f}; a4[it] = f32x4{0.f, 0.f, 0.f, 0.f}; }
#pragma unroll
        for (int ks = 0; ks < 2; ++ks) {
            const bf16x8 aw = ld8(&XT[(128 + w * 16 + c) * 72 + ks * 32 + g * 8]);
            const bf16x8 au = ld8(&XT[(w * 16 + c) * 72 + ks * 32 + g * 8]);
#pragma unroll
            for (int it = 0; it < 4; ++it) {
                const bf16x8 bt = ld8(&att[(it * 16 + c) * 72 + ks * 32 + g * 8]);
                a3[it] = mfma16(aw, bt, a3[it]); a4[it] = mfma16(au, bt, a4[it]);
            }
        }
        bfraw* qe = (bfraw*)(p.ws + O_QEFF) + (size_t)item * 64 * 128;
        bfraw* yc = (bfraw*)(p.ws + O_YCAT);
#pragma unroll
        for (int it = 0; it < 4; ++it) {
            const int i = it * 16 + c, d = w * 16 + 4 * g;
            bfraw* qp = qe + (size_t)i * 128 + d;
            const uint2 qv = *(const uint2*)qp;
            st4bf(qp, lo2f(qv.x) - a3[it][0], hi2f(qv.x) - a3[it][1], lo2f(qv.y) - a3[it][2], hi2f(qv.y) - a3[it][3]);
            st4bf(yc + (size_t)(b * TT + t0 + i) * 1024 + 512 + h * 128 + d, a4[it][0], a4[it][1], a4[it][2], a4[it][3]);
        }
    }
    {
        OPQ_TID();
        const float egl = gc[256];
        bfraw* Mb = (bfraw*)(p.ws + O_MBUF) + (size_t)item * 16384;
        bfraw* Nb = (bfraw*)(p.ws + O_NS) + (size_t)item * 16384;
#pragma unroll 1
        for (int half = 0; half < 2; ++half) {
            f32x4 a5[4], a6[4];
#pragma unroll
            for (int q = 0; q < 4; ++q) { a5[q] = f32x4{0.f, 0.f, 0.f, 0.f}; a6[q] = f32x4{0.f, 0.f, 0.f, 0.f}; }
#pragma unroll
            for (int ks = 0; ks < 2; ++ks) {
                const bf16x8 aw = ld8(&XT[(128 + w * 16 + c) * 72 + ks * 32 + g * 8]);
                const bf16x8 ak = ld8(&kdT[(w * 16 + c) * 72 + ks * 32 + g * 8]);
#pragma unroll
                for (int q = 0; q < 4; ++q) {
                    const int tl = half * 4 + q;
                    a5[q] = mfma16(aw, ld8(&kdT[(tl * 16 + c) * 72 + ks * 32 + g * 8]), a5[q]);
                    a6[q] = mfma16(ak, ld8(&XT[(tl * 16 + c) * 72 + ks * 32 + g * 8]), a6[q]);
                }
            }
#pragma unroll
            for (int q = 0; q < 4; ++q) {
                const int tl = half * 4 + q;
                const int d = tl * 16 + c, dp = w * 16 + 4 * g;
                st4bf(Mb + (size_t)d * 128 + dp, (d == dp ? egl : 0.f) - a5[q][0], (d == dp + 1 ? egl : 0.f) - a5[q][1],
                      (d == dp + 2 ? egl : 0.f) - a5[q][2], (d == dp + 3 ? egl : 0.f) - a5[q][3]);
                const int e = tl * 16 + c, dd = w * 16 + 4 * g;
                st4bf(Nb + (size_t)e * 128 + dd, a6[q][0], a6[q][1], a6[q][2], a6[q][3]);
            }
        }
    }
    lds_barrier();
}

DEV void gdn_scan_item(const Params& p, int bh) {
    const int lane = tidx() & 63, w = tidx() >> 6, c = lane & 15, g = lane >> 4;
    const int e = w * 16 + c;
    f32x4 S[8];
#pragma unroll
    for (int dt = 0; dt < 8; ++dt) S[dt] = f32x4{0.f, 0.f, 0.f, 0.f};
    const bfraw* MB = (const bfraw*)(p.ws + O_MBUF) + (size_t)bh * 256 * 16384;
    bfraw* NB = (bfraw*)(p.ws + O_NS) + (size_t)bh * 256 * 16384;
    for (int n = 0; n < 256; ++n) {
        const bfraw* M = MB + (size_t)n * 16384;
        bfraw* N = NB + (size_t)n * 16384 + (size_t)e * 128 + 4 * g;
        bf16x8 bs[4];
#pragma unroll
        for (int s = 0; s < 4; ++s) bs[s] = pack8(S[2 * s][0], S[2 * s][1], S[2 * s][2], S[2 * s][3], S[2 * s + 1][0], S[2 * s + 1][1], S[2 * s + 1][2], S[2 * s + 1][3]);
        uint2 nf[8];
#pragma unroll
        for (int dt = 0; dt < 8; ++dt) nf[dt] = *(const uint2*)(N + dt * 16);
        asm volatile("s_waitcnt vmcnt(0)" ::: "memory");
#pragma unroll
        for (int dt = 0; dt < 8; ++dt) st4bf(N + dt * 16, S[dt][0], S[dt][1], S[dt][2], S[dt][3]);
#pragma unroll
        for (int dt = 0; dt < 8; ++dt) {
            f32x4 acc = f32x4{lo2f(nf[dt].x), hi2f(nf[dt].x), lo2f(nf[dt].y), hi2f(nf[dt].y)};
#pragma unroll
            for (int s = 0; s < 4; ++s) {
                const bfraw* mp = M + (size_t)(dt * 16 + c) * 128 + 32 * s + 4 * g;
                acc = mfma16(ld4x2(mp, mp + 16), bs[s], acc);
            }
            S[dt] = acc;
        }
    }
}

DEV void gdn_c_witem(const Params& p, int witem, bool dry = false) {
    const int lane = tidx() & 63, c = lane & 15, g = lane >> 4;
    const int item = witem >> 2, it = witem & 3;
    const int bh = item >> 8, n = item & 255, b = bh >> 2, h = bh & 3;
    const bfraw* Sb = (const bfraw*)(p.ws + O_SB) + (size_t)item * 16384;
    const bfraw* Qe = (const bfraw*)(p.ws + O_QEFF) + (size_t)item * 64 * 128;
    f32x4 acc[8];
#pragma unroll
    for (int et = 0; et < 8; ++et) acc[et] = f32x4{0.f, 0.f, 0.f, 0.f};
#pragma unroll
    for (int ks = 0; ks < 4; ++ks) {
        const bf16x8 bq = ld8(Qe + (size_t)(it * 16 + c) * 128 + ks * 32 + g * 8);
#pragma unroll
        for (int et = 0; et < 8; ++et) acc[et] = mfma16(ld8(Sb + (size_t)(et * 16 + c) * 128 + ks * 32 + g * 8), bq, acc[et]);
    }
    const int tok = b * TT + n * 64 + it * 16 + c;
    bfraw* yp = (bfraw*)(p.ws + O_YCAT) + (size_t)tok * 1024 + 512 + h * 128 + 4 * g;
    const bfraw* gz = (const bfraw*)(p.ws + O_GZ) + (size_t)tok * 512 + h * 128 + 4 * g;
    float ss = 0.f;
#pragma unroll
    for (int et = 0; et < 8; ++et) {
        const uint2 o0 = *(const uint2*)(yp + et * 16);
        acc[et][0] += lo2f(o0.x); acc[et][1] += hi2f(o0.x); acc[et][2] += lo2f(o0.y); acc[et][3] += hi2f(o0.y);
        ss += acc[et][0] * acc[et][0] + acc[et][1] * acc[et][1] + acc[et][2] * acc[et][2] + acc[et][3] * acc[et][3];
    }
    ss = grpx_sum(ss);
    const float rs = rsqrtf(ss * (1.f / 128.f) + EPSF);
#pragma unroll
    for (int et = 0; et < 8; ++et) {
        const uint2 zv = *(const uint2*)(gz + et * 16);
        const float4 gn = *(const float4*)(p.in[I_GON] + et * 16 + 4 * g);
        st4bf((dry ? (bfraw*)(p.ws + O_MBUF) + (size_t)tok * 1024 + 4 * g : yp) + et * 16, acc[et][0] * rs * gn.x * siluf_(lo2f(zv.x)), acc[et][1] * rs * gn.y * siluf_(hi2f(zv.x)),
                            acc[et][2] * rs * gn.z * siluf_(lo2f(zv.y)), acc[et][3] * rs * gn.w * siluf_(hi2f(zv.y)));
    }
}
constexpr int TS_K = 0, TS_V = 18432, TS_C = 36864;
template <bool WITHV, bool WITHC, class KEYOF, class BODY>
DEV void tile_stream(char* smem, const bfraw* Kg, const bfraw* Vg, size_t vstride, const float* Cg, int ntiles, KEYOF key_of, BODY body) {
    const int tid = tidx(), srow = tid >> 3, sseg = tid & 7;
    bfraw* Kl = (bfraw*)(smem + TS_K); bfraw* Vl = (bfraw*)(smem + TS_V); float* Cl = (float*)(smem + TS_C);
    if (ntiles <= 0) return;
    uint4 ka, va = make_uint4(0u, 0u, 0u, 0u), kb = make_uint4(0u, 0u, 0u, 0u), vb = make_uint4(0u, 0u, 0u, 0u);
    float4 ca = make_float4(0.f, 0.f, 0.f, 0.f), cb = make_float4(0.f, 0.f, 0.f, 0.f);
    auto ldt = [&](int t, uint4& rk, uint4& rv, float4& rc) {
        const int k0 = key_of(t);
        rk = *(const uint4*)(Kg + (size_t)(k0 + srow) * 64 + sseg * 8);
        if (WITHV) rv = *(const uint4*)(Vg + (size_t)srow * vstride + k0 + sseg * 8);
        if (WITHC) { if (tid < 16) rc = *(const float4*)(Cg + k0 + 4 * tid); }
    };
    auto stt = [&](int buf, const uint4& rk, const uint4& rv, const float4& rc) {
        *(uint4*)&Kl[buf * 64 * 72 + srow * 72 + sseg * 8] = rk;
        if (WITHV) *(uint4*)&Vl[buf * 64 * 72 + srow * 72 + sseg * 8] = rv;
        if (WITHC) { if (tid < 16) *(float4*)&Cl[buf * 64 + 4 * tid] = rc; }
    };
    __syncthreads();
    ldt(0, ka, va, ca);
    if (ntiles > 1) ldt(1, kb, vb, cb);
    stt(0, ka, va, ca);
    lds_barrier();
    for (int t = 0; t < ntiles; t += 2) {
        if (t + 2 < ntiles) ldt(t + 2, ka, va, ca);
        body(t, Kl, Vl, Cl);
        if (t + 1 < ntiles) stt(1, kb, vb, cb);
        lds_barrier();
        if (t + 1 >= ntiles) break;
        if (t + 3 < ntiles) ldt(t + 3, kb, vb, cb);
        body(t + 1, Kl + 64 * 72, Vl + 64 * 72, Cl + 64);
        if (t + 2 < ntiles) stt(0, ka, va, ca);
        lds_barrier();
    }
}

constexpr int TS2_K = 0, TS2_V = 36864, TS2_END = 71680;
template <class KEYOF, class KEYOF2, class BODY>
DEV void tile_stream2(char* smem, const bfraw* Kg, const bfraw* Vg, size_t vstride, int ntiles, KEYOF key_of, KEYOF2 key_of2, BODY body) {
    const int tid = tidx(), srow = tid >> 3, sseg = tid & 7;
    bfraw* Kl = (bfraw*)(smem + TS2_K); bfraw* Vl = (bfraw*)(smem + TS2_V);
    if (ntiles <= 0) return;
    uint4 ka0, ka1, va0, va1, kb0 = make_uint4(0u, 0u, 0u, 0u), kb1 = kb0, vb0 = kb0, vb1 = kb0;
#define TS2_LD(T, K0, K1, V0, V1) { const int a0 = key_of(T), a1 = key_of2(T); K0 = *(const uint4*)(Kg + (size_t)(a0 + srow) * 64 + sseg * 8); K1 = *(const uint4*)(Kg + (size_t)(a1 + srow) * 64 + sseg * 8); \
        V0 = *(const uint4*)(Vg + (size_t)srow * vstride + a0 + sseg * 8); V1 = *(const uint4*)(Vg + (size_t)srow * vstride + a1 + sseg * 8); }
#define TS2_ST(BUF, K0, K1, V0, V1) { bfraw* kp = Kl + (BUF) * 128 * 72 + srow * 72 + sseg * 8; *(uint4*)kp = K0; *(uint4*)(kp + 64 * 72) = K1; \
        bfraw* vp = Vl + (BUF) * 64 * 136 + srow * 136 + sseg * 8; *(uint4*)vp = V0; *(uint4*)(vp + 64) = V1; }
    __syncthreads();
    TS2_LD(0, ka0, ka1, va0, va1)
    if (ntiles > 1) TS2_LD(1, kb0, kb1, vb0, vb1)
    TS2_ST(0, ka0, ka1, va0, va1)
    lds_barrier();
    for (int t = 0; t < ntiles; t += 2) {
        if (t + 2 < ntiles) TS2_LD(t + 2, ka0, ka1, va0, va1)
        body(t, Kl, Vl);
        if (t + 1 < ntiles) TS2_ST(1, kb0, kb1, vb0, vb1)
        lds_barrier();
        if (t + 1 >= ntiles) break;
        if (t + 3 < ntiles) TS2_LD(t + 3, kb0, kb1, vb0, vb1)
        body(t + 1, Kl + 128 * 72, Vl + 64 * 136);
        if (t + 2 < ntiles) TS2_ST(0, ka0, ka1, va0, va1)
        lds_barrier();
    }
#undef TS2_LD
#undef TS2_ST
}

DEV void fox_item2(const Params& p, char* smem, int bh, int qb) {
    const int tid = tidx(), lane = tid & 63, w = tid >> 6, c = lane & 15, g = lane >> 4;
    const int b = bh >> 3, h = bh & 7;
    const bfraw* Q = (const bfraw*)(p.ws + O_QF) + (size_t)bh * TT * 64;
    const bfraw* K = (const bfraw*)(p.ws + O_KF) + (size_t)bh * TT * 64;
    const bfraw* VT = (const bfraw*)(p.ws + O_VFT) + (size_t)bh * 64 * TT;
    const float* cum = (const float*)(p.ws + O_CUMF) + (size_t)bh * TT;
    const float mq = wave_max(fabsf(p.in[I_FOXQN][lane])), mk = wave_max(fabsf(p.in[I_FOXKN][lane]));
    const float Mb2 = 8.f * mq * mk * LOG2E;
    const float thr = -(105.f + 16.f * mq * mk) * LOG2E;
    const int Q0 = qb * 256, q0w = Q0 + w * 32, jw = q0w >> 6, jmax = (Q0 >> 6) + 3;
    int* red = (int*)(smem + TS_C + 1024);
    __syncthreads();
    if (tid == 0) red[0] = 0;
    __syncthreads();
    {
        const float cq0 = cum[Q0];
        bool dead = false;
        if (tid <= jmax && tid < 256) dead = (cq0 - cum[64 * tid + 63] < thr);
        const unsigned long long bm = __ballot(dead);
        if (lane == 0 && bm) atomicMax(red, w * 64 + 64 - __builtin_clzll(bm));
    }
    __syncthreads();
    const int jmin = red[0];
    int tq[2]; float cq[2]; bf16x8 qf[2][2]; f32x4 O[2][4]; float l[2];
#pragma unroll
    for (int cg = 0; cg < 2; ++cg) {
        tq[cg] = q0w + cg * 16 + c; cq[cg] = cum[tq[cg]] - Mb2; l[cg] = 0.f;
#pragma unroll
        for (int ks = 0; ks < 2; ++ks) qf[cg][ks] = ld8(Q + (size_t)tq[cg] * 64 + ks * 32 + g * 8);
#pragma unroll
        for (int dt = 0; dt < 4; ++dt) O[cg][dt] = f32x4{0.f, 0.f, 0.f, 0.f};
    }
    tile_stream<true, true>(smem, K, VT, TT, cum, jmax - jmin + 1, [&](int t) { return (jmax - t) * 64; },
        [&](int t, const bfraw* Kb, const bfraw* Vb, const float* Cb) {
            const int j = jmax - t;
            if (j > jw) return;
            const bool diag = (j == jw);
            bf16x8 pb[2][2];
#pragma unroll
            for (int kt = 0; kt < 4; ++kt) {
                const bf16x8 k0 = ld8(&Kb[(kt * 16 + c) * 72 + g * 8]), k1 = ld8(&Kb[(kt * 16 + c) * 72 + 32 + g * 8]);
                const float4 ck = *(const float4*)&Cb[kt * 16 + 4 * g];
#pragma unroll
                for (int cg = 0; cg < 2; ++cg) {
                    f32x4 S = f32x4{cq[cg] - ck.x, cq[cg] - ck.y, cq[cg] - ck.z, cq[cg] - ck.w};
                    S = mfma16(k0, qf[cg][0], S);
                    S = mfma16(k1, qf[cg][1], S);
                    float e[4];
#pragma unroll
                    for (int r = 0; r < 4; ++r) {
                        e[r] = ex2(S[r]);
                        if (diag && (64 * j + kt * 16 + 4 * g + r > tq[cg])) e[r] = 0.f;
                        l[cg] += e[r];
                    }
                    U4 tt;
                    if (kt & 1) { tt.v = pb[cg][kt >> 1]; tt.w[2] = pack2(e[0], e[1]); tt.w[3] = pack2(e[2], e[3]); }
                    else { tt.w[0] = pack2(e[0], e[1]); tt.w[1] = pack2(e[2], e[3]); tt.w[2] = 0u; tt.w[3] = 0u; }
                    pb[cg][kt >> 1] = tt.v;
                }
            }
#pragma unroll
            for (int dt = 0; dt < 4; ++dt) {
                const bfraw* vp = &Vb[(dt * 16 + c) * 72 + 4 * g];
                const bf16x8 v0 = ld4x2(vp, vp + 16), v1 = ld4x2(vp + 32, vp + 48);
#pragma unroll
                for (int cg = 0; cg < 2; ++cg) { O[cg][dt] = mfma16(v0, pb[cg][0], O[cg][dt]); O[cg][dt] = mfma16(v1, pb[cg][1], O[cg][dt]); }
            }
        });
    bfraw* yc = (bfraw*)(p.ws + O_YCAT);
#pragma unroll
    for (int cg = 0; cg < 2; ++cg) {
        const float inv = 1.f / grpx_sum(l[cg]);
        bfraw* d = yc + (size_t)(b * TT + tq[cg]) * 1024 + h * 64 + 4 * g;
#pragma unroll
        for (int dt = 0; dt < 4; ++dt) st4bf(d + dt * 16, O[cg][dt][0] * inv, O[cg][dt][1] * inv, O[cg][dt][2] * inv, O[cg][dt][3] * inv);
    }
    __syncthreads();
}

constexpr int GS_STAGE = 34816 + 4352;
DEV void gdn_scan_item2(const Params& p, char* smem, int item) {
    const int tid = tidx(), lane = tid & 63, w = tid >> 6, c = lane & 15, g = lane >> 4;
    const int bh = item & 7, e0 = (item >> 3) * 16;
    const bfraw* MB = (const bfraw*)(p.ws + O_MBUF) + (size_t)bh * 256 * 16384;
    const bfraw* NB = (const bfraw*)(p.ws + O_NS) + (size_t)bh * 256 * 16384 + (size_t)e0 * 128;
    bfraw* SB = (bfraw*)(p.ws + O_SB) + (size_t)bh * 256 * 16384 + (size_t)e0 * 128;
    __syncthreads();
    if (w >= 4) {
        const int lt = tid - 256, lrow = lt >> 4, lcol = (lt & 15) * 8;
#define GS_LDR(N, R) { const bfraw* Mn = MB + (size_t)(N) * 16384 + (size_t)lrow * 128 + lcol; \
            R##m0 = *(const uint4*)(Mn + 0 * 128); R##m1 = *(const uint4*)(Mn + 16 * 128); R##m2 = *(const uint4*)(Mn + 32 * 128); R##m3 = *(const uint4*)(Mn + 48 * 128); R##m4 = *(const uint4*)(Mn + 64 * 128); R##m5 = *(const uint4*)(Mn + 80 * 128); R##m6 = *(const uint4*)(Mn + 96 * 128); R##m7 = *(const uint4*)(Mn + 112 * 128); \
            R##n = *(const uint4*)(NB + (size_t)(N) * 16384 + (size_t)lrow * 128 + lcol); }
#define GS_STR(STAGE, R) { bfraw* Mw = (bfraw*)(smem + (STAGE) * GS_STAGE) + lrow * 136 + lcol; \
            *(uint4*)(Mw + 0 * 136) = R##m0; *(uint4*)(Mw + 16 * 136) = R##m1; *(uint4*)(Mw + 32 * 136) = R##m2; *(uint4*)(Mw + 48 * 136) = R##m3; *(uint4*)(Mw + 64 * 136) = R##m4; *(uint4*)(Mw + 80 * 136) = R##m5; *(uint4*)(Mw + 96 * 136) = R##m6; *(uint4*)(Mw + 112 * 136) = R##m7; \
            *(uint4*)(Mw + 128 * 136) = R##n; }
        uint4 ram0, ram1, ram2, ram3, ram4, ram5, ram6, ram7, rbm0, rbm1, rbm2, rbm3, rbm4, rbm5, rbm6, rbm7, rcm0, rcm1, rcm2, rcm3, rcm4, rcm5, rcm6, rcm7, ran, rbn, rcn;
        GS_LDR(0, ra) GS_LDR(1, rb) GS_LDR(2, rc)
        GS_STR(0, ra)
        lds_barrier();
#define GS_IT(N, RCUR, RNEXT, STG) { const int n_ = (N); if (n_ < 256) { if (n_ + 3 < 256) GS_LDR(n_ + 3, RCUR) if (n_ + 1 < 256) GS_STR((STG) ^ 1, RNEXT) lds_barrier(); } }
        for (int n = 0; n < 256; n += 6) {
            GS_IT(n + 0, ra, rb, 0) GS_IT(n + 1, rb, rc, 1) GS_IT(n + 2, rc, ra, 0)
            GS_IT(n + 3, ra, rb, 1) GS_IT(n + 4, rb, rc, 0) GS_IT(n + 5, rc, ra, 1)
        }
#undef GS_IT
#undef GS_LDR
#undef GS_STR
    } else if (w == 0) {
        f32x4 S[8];
#pragma unroll
        for (int dt = 0; dt < 8; ++dt) S[dt] = f32x4{0.f, 0.f, 0.f, 0.f};
        lds_barrier();
        for (int n = 0; n < 256; ++n) {
            const bfraw* Mb = (const bfraw*)(smem + (n & 1) * GS_STAGE);
            const bfraw* Nl = Mb + 128 * 136;
            bfraw* Sn = SB + (size_t)n * 16384 + (size_t)c * 128 + 4 * g;
            bf16x8 bs[4];
#pragma unroll
            for (int s = 0; s < 4; ++s)
                bs[s] = pack8(S[2 * s][0], S[2 * s][1], S[2 * s][2], S[2 * s][3], S[2 * s + 1][0], S[2 * s + 1][1], S[2 * s + 1][2], S[2 * s + 1][3]);
#pragma unroll
            for (int dt = 0; dt < 8; ++dt) st4bf(Sn + dt * 16, S[dt][0], S[dt][1], S[dt][2], S[dt][3]);
#pragma unroll
            for (int dt = 0; dt < 8; ++dt) {
                const uint2 n0 = *(const uint2*)&Nl[c * 136 + dt * 16 + 4 * g];
                f32x4 a0 = f32x4{lo2f(n0.x), hi2f(n0.x), lo2f(n0.y), hi2f(n0.y)};
#pragma unroll
                for (int s = 0; s < 4; ++s) {
                    const bfraw* mp = &Mb[(dt * 16 + c) * 136 + 32 * s + 4 * g];
                    a0 = mfma16(ld4x2(mp, mp + 16), bs[s], a0);
                }
                S[dt] = a0;
            }
            lds_barrier();
        }
    } else {
        lds_barrier();
        for (int n = 0; n < 256; ++n) lds_barrier();
    }
}
DEV void phase_outproj(const Params& p, char* smem, int layer, unsigned* xq) {
    const bfraw* A = (const bfraw*)(p.ws + O_YCAT);
    const bfraw* Bt = (const bfraw*)(p.ws + (layer ? O_WOUT1 : O_WOUT0));
    const float* xin = layer ? p.out : p.in[I_X];
    for (int rr = 0;; ++rr) {
        int mt, nt;
        if (!xs_tile(4, rr, mt, nt)) break;
        const int m0 = mt * 256, n0 = nt * 256;
        gemm_tile2(smem, 16, 64,
            [&](int r) { return A + (size_t)(m0 + r) * 1024; },
            [&](int r) { return Bt + (size_t)(n0 + r) * 1024; },
            [&](const f32x4 (&acc)[8][4], int rb, int cbk, int lane) {
                const int c = lane & 15, g = lane >> 4, tok0 = m0 + rb, b = tok0 >> 14;
                const float* g1 = modp(p, layer, b, 2) + n0 + cbk + 4 * g;
#pragma unroll
                for (int j = 0; j < 4; ++j) {
                    const float4 gv = *(const float4*)(g1 + j * 16);
#pragma unroll
                    for (int i = 0; i < 8; ++i) {
                        const size_t o = (size_t)(tok0 + i * 16 + c) * 1024 + n0 + cbk + j * 16 + 4 * g;
                        const float4 xv = *(const float4*)(xin + o);
                        *(float4*)(p.out + o) = make_float4(xv.x + gv.x * acc[i][j][0], xv.y + gv.y * acc[i][j][1], xv.z + gv.z * acc[i][j][2], xv.w + gv.w * acc[i][j][3]);
                    }
                }
            });
    }
}

constexpr int RT_LG = 55296;
DEV void phase_router(const Params& p, char* smem, int layer, bool dry = false) {
    const int tid = tidx(), lane = tid & 63, w = tid >> 6;
    bfraw* hb = (bfraw*)(p.ws + O_HBUF);
    const bfraw* Wr = (const bfraw*)(p.ws + O_WRT) + (size_t)layer * 128 * 1024;
    float* lg = (float*)(smem + RT_LG);
    unsigned* cnts = (unsigned*)(p.ws + O_CNT) + 16 + layer * 128;
    float* pairw = (float*)(p.ws + O_PAIRW);
    int* plist = (int*)(p.ws + O_PLIST);
    for (int item = blockIdx.x; item < 256; item += gridDim.x) {
        const int m0 = item * 128, b = m0 >> 14;
        for (int rr = 0; rr < 16; ++rr) {
            const int row = m0 + w * 16 + rr;
            norm_row(p.out + (size_t)row * 1024, p.in[I_NFFN] + layer * 1024, modp(p, layer, b, 4), modp(p, layer, b, 3), hb + (size_t)row * 1024, lane);
        }
        block_sync_mem();
        gemm_tile(smem, 16, 64,
            [&](int r) { return hb + (size_t)(m0 + (r & 127)) * 1024; },
            [&](int r) { return Wr + (size_t)r * 1024; },
            [&](const f32x4 (&acc)[4][4], int rb, int cbk, int ln) {
                if (cbk == 0 && rb < 128) {
                    const int c = ln & 15, g = ln >> 4;
#pragma unroll
                    for (int i = 0; i < 4; ++i)
#pragma unroll
                        for (int j = 0; j < 4; ++j)
#pragma unroll
                            for (int r = 0; r < 4; ++r) lg[(rb + i * 16 + 4 * g + r) * 64 + j * 16 + c] = acc[i][j][r];
                }
            });
        __syncthreads();
        const float eb = p.in[I_MBIAS][layer * 64 + lane];
        const int grp = lane >> 3;
        for (int rr = 0; rr < 16; ++rr) {
            const int row = w * 16 + rr, tok = m0 + row;
            const float score = sigmoidf_(lg[row * 64 + lane]);
            const float biased = score + eb;
            float m1 = biased;
            m1 = fmaxf(m1, __shfl_xor(m1, 1)); m1 = fmaxf(m1, __shfl_xor(m1, 2)); m1 = fmaxf(m1, __shfl_xor(m1, 4));
            const unsigned long long eq = __ballot(biased == m1);
            const unsigned gm = (unsigned)(eq >> (grp * 8)) & 0xffu;
            const int first = __builtin_ctz(gm);
            float m2 = ((lane & 7) == first) ? -INFINITY : biased;
            m2 = fmaxf(m2, __shfl_xor(m2, 1)); m2 = fmaxf(m2, __shfl_xor(m2, 2)); m2 = fmaxf(m2, __shfl_xor(m2, 4));
            const float gs = m1 + m2;
            int grank = 0;
#pragma unroll
            for (int j = 0; j < 8; ++j) { const float gj = __shfl(gs, j * 8); grank += (gj > gs || (gj == gs && j < grp)) ? 1 : 0; }
            const bool gsel = grank < 4;
            const float v = gsel ? biased : -INFINITY;
            int er = 0;
#pragma unroll 8
            for (int j = 0; j < 64; ++j) { const float vj = __shfl(v, j); er += (vj > v || (vj == v && j < lane)) ? 1 : 0; }
            const bool sel = gsel && er < 6;
            const float ssum = wave_sum(sel ? score : 0.f);
            if (sel && !dry) {
                pairw[(size_t)tok * 6 + er] = score / ssum * 2.5f;
                const unsigned pos = atomicAdd(&cnts[b * 64 + lane], 1u);
                plist[(size_t)(b * 64 + lane) * 16384 + pos] = tok * 8 + er;
            }
        }
        __syncthreads();
    }
}

DEV void moe_tiles(const Params& p, char* smem, int layer, int hb, int* ts  ) {
    const unsigned* cnts = (const unsigned*)(p.ws + O_CNT) + 16 + layer * 128 + hb * 64;
    __syncthreads();
    if (tidx() == 0) {
        int a = 0;
        for (int e = 0; e < 64; ++e) { ts[e] = a; a += ((int)cnts[e] + 255) >> 8; }
        ts[64] = a; a += 64; ts[65] = a;
    }
    __syncthreads();
}
DEV int moe_find(const int* ts, int mt) { int e = 0; while (e < 64 && ts[e + 1] <= mt) ++e; return e; }
constexpr int MOE_TS = 147456;

DEV void phase_moe1(const Params& p, char* smem, int layer, int hb) {
    int* ts = (int*)(smem + MOE_TS);
    moe_tiles(p, smem, layer, hb, ts);
    const unsigned* cnts = (const unsigned*)(p.ws + O_CNT) + 16 + layer * 128 + hb * 64;
    const int* plist = (const int*)(p.ws + O_PLIST);
    const bfraw* hbuf = (const bfraw*)(p.ws + O_HBUF);
    const bfraw* wgu = (const bfraw*)(p.ws + O_WGU);
    bfraw* H = (bfraw*)(p.ws + O_H);
    const int total = ts[65];
    for (int item = blockIdx.x; item < total * 2; item += gridDim.x) {
        const int mt = item >> 1, nt = item & 1;
        const int e = moe_find(ts, mt), idx0 = (mt - ts[e]) * 256;
        const int cnt = e < 64 ? (int)cnts[e] : 16384;
        gemm_tile2<false>(smem, 16, 64,
            [&](int r) {
                const int idx = idx0 + r;
                int tok;
                if (e < 64) tok = idx < cnt ? (plist[(size_t)(hb * 64 + e) * 16384 + idx] >> 3) : 0;
                else tok = hb * 16384 + idx;
                return hbuf + (size_t)tok * 1024;
            },
            [&](int r) {
                const int hidden = nt * 128 + (r >> 6) * 32 + ((r >> 4) & 1) * 16 + (r & 15);
                return wgu + ((size_t)e * 512 + ((r >> 5) & 1) * 256 + hidden) * 1024;
            },
            [&](const f32x4 (&acc)[8][4], int rb, int cbk, int lane) {
                const int c = lane & 15, g = lane >> 4;
#pragma unroll
                for (int i = 0; i < 8; ++i) {
                    bfraw* hrow = H + (size_t)(mt * 256 + rb + i * 16 + c) * 256 + nt * 128 + (cbk >> 6) * 32 + 4 * g;
#pragma unroll
                    for (int jj = 0; jj < 2; ++jj)
                        st4bf(hrow + jj * 16, siluf_(acc[i][jj][0]) * acc[i][jj + 2][0], siluf_(acc[i][jj][1]) * acc[i][jj + 2][1],
                              siluf_(acc[i][jj][2]) * acc[i][jj + 2][2], siluf_(acc[i][jj][3]) * acc[i][jj + 2][3]);
                }
            });
    }
}

DEV void phase_moe2(const Params& p, char* smem, int layer, int hb) {
    int* ts = (int*)(smem + MOE_TS);
    moe_tiles(p, smem, layer, hb, ts);
    const unsigned* cnts = (const unsigned*)(p.ws + O_CNT) + 16 + layer * 128 + hb * 64;
    const int* plist = (const int*)(p.ws + O_PLIST);
    const float* pairw = (const float*)(p.ws + O_PAIRW);
    const bfraw* wd = (const bfraw*)(p.ws + O_WD);
    const bfraw* H = (const bfraw*)(p.ws + O_H);
    bfraw* Y = (bfraw*)(p.ws + O_Y);
    const int total = ts[65];
    for (int item = blockIdx.x; item < total * 4; item += gridDim.x) {
        const int mt = item >> 2, nt = item & 3;
        const int e = moe_find(ts, mt), idx0 = (mt - ts[e]) * 256;
        const int cnt = e < 64 ? (int)cnts[e] : 16384;
        gemm_tile2(smem, 4, 64,
            [&](int r) { return H + (size_t)(mt * 256 + r) * 256; },
            [&](int r) { return wd + ((size_t)e * 1024 + nt * 256 + r) * 256; },
            [&](const f32x4 (&acc)[8][4], int rb, int cbk, int lane) {
                const int c = lane & 15, g = lane >> 4;
                int yrow[8]; float wg[8];
                if (e < 64) {
                    const int* pl = plist + (size_t)(hb * 64 + e) * 16384;
                    int pr[8];
#pragma unroll
                    for (int i = 0; i < 8; ++i) pr[i] = pl[min(idx0 + rb + i * 16 + c, cnt - 1)];
#pragma unroll
                    for (int i = 0; i < 8; ++i) {
                        const int tok = pr[i] >> 3, j = pr[i] & 7;
                        wg[i] = pairw[(size_t)tok * 6 + j]; yrow[i] = (tok - hb * 16384) * 7 + j;
                    }
                } else {
#pragma unroll
                    for (int i = 0; i < 8; ++i) { wg[i] = 1.f; yrow[i] = (idx0 + rb + i * 16 + c) * 7 + 6; }
                }
#pragma unroll
                for (int i = 0; i < 8; ++i) {
                    const int idx = idx0 + rb + i * 16 + c;
                    if (idx < cnt) {
                        bfraw* yp = Y + (size_t)yrow[i] * 1024 + nt * 256 + cbk + 4 * g;
                        const float wgi = wg[i];
#pragma unroll
                        for (int j = 0; j < 4; ++j) st4bf(yp + j * 16, wgi * acc[i][j][0], wgi * acc[i][j][1], wgi * acc[i][j][2], wgi * acc[i][j][3]);
                    }
                }
            });
    }
}

DEV void phase_combine(const Params& p, int layer, int hb, bool next_norm, bool dry = false) {
    const int lane = tidx() & 63, w = tidx() >> 6;
    const bfraw* Y = (const bfraw*)(p.ws + O_Y);
    bfraw* hbuf = (bfraw*)(p.ws + O_HBUF);
    const float* g2 = modp(p, layer, hb, 5);
    for (int tl = blockIdx.x * 8 + w; tl < 16384; tl += gridDim.x * 8) {
        const int tok = hb * 16384 + tl;
        float* xr = p.out + (size_t)tok * 1024;
        float4 v[4]; float ss = 0.f;
#pragma unroll
        for (int i = 0; i < 4; ++i) {
            const int cix = lane * 4 + 256 * i;
            float s0 = 0.f, s1 = 0.f, s2 = 0.f, s3 = 0.f;
#pragma unroll
            for (int j = 0; j < 7; ++j) {
                const uint2 y = *(const uint2*)(Y + ((size_t)tl * 7 + j) * 1024 + cix);
                s0 += lo2f(y.x); s1 += hi2f(y.x); s2 += lo2f(y.y); s3 += hi2f(y.y);
            }
            const float4 x = *(const float4*)(xr + cix), gg = *(const float4*)(g2 + cix);
            v[i].x = x.x + gg.x * s0; v[i].y = x.y + gg.y * s1; v[i].z = x.z + gg.z * s2; v[i].w = x.w + gg.w * s3;
            *(float4*)(dry ? (float*)(p.ws + O_YCAT) + (size_t)(tl & 8191) * 1024 + cix : xr + cix) = v[i];
            ss += v[i].x * v[i].x + v[i].y * v[i].y + v[i].z * v[i].z + v[i].w * v[i].w;
        }
        if (next_norm) {
            ss = wave_sum(ss);
            const float rs = rsqrtf(ss * (1.f / 1024.f) + EPSF);
            const float* gain = p.in[I_NMIX] + (layer + 1) * 1024;
            const float* sc = modp(p, layer + 1, hb, 1); const float* sh = modp(p, layer + 1, hb, 0);
#pragma unroll
            for (int i = 0; i < 4; ++i) {
                const int cix = lane * 4 + 256 * i;
                const float4 gn = *(const float4*)(gain + cix), s1 = *(const float4*)(sc + cix), s0 = *(const float4*)(sh + cix);
                st4bf((dry ? (bfraw*)(p.ws + O_YCAT) : hbuf) + (size_t)tok * 1024 + cix, v[i].x * rs * gn.x * (1.f + s1.x) + s0.x, v[i].y * rs * gn.y * (1.f + s1.y) + s0.y,
                      v[i].z * rs * gn.z * (1.f + s1.z) + s0.z, v[i].w * rs * gn.w * (1.f + s1.w) + s0.w);
            }
        }
    }
}
#define HAVE_L1 1
DEV void phase_inproj1(const Params& p, char* smem, unsigned* xq) {
    const bfraw* A = (const bfraw*)(p.ws + O_HBUF);
    const bfraw* Bt = (const bfraw*)(p.ws + O_WIN1);
    constexpr int NTL = NIN1 / 256;
    for (int rr = 0;; ++rr) {
        int mt, nt;
        if (!xs_tile(NTL, rr, mt, nt)) break;
        const int m0 = __builtin_amdgcn_readfirstlane(mt * 256), n0 = __builtin_amdgcn_readfirstlane(nt * 256);
        gemm_tile2(smem, 16, 64,
            [&](int r) { return A + (size_t)(m0 + r) * 1024; },
            [&](int r) { return Bt + (size_t)(n0 + r) * 1024; },
            [&](const f32x4 (&acc)[8][4], int rb, int cbk, int lane) {
                const int cb = n0 + cbk, tok0 = m0 + rb, b = tok0 >> 14, t0 = tok0 & (TT - 1);
                if (cb < 512) {
                    epi2_headnorm<8>(acc, lane, p.in[I_NSAQN], 0.125f * LOG2E, (bfraw*)(p.ws + O_QN) + ((size_t)(b * 8 + (cb >> 6)) * TT + t0) * 64, 64);
                } else if (cb < 640) {
                    epi2_store_bf16<8>(acc, lane, (bfraw*)(p.ws + O_KCR) + (size_t)tok0 * 128 + (cb - 512), 128);
                } else if (cb < 768) {
                    epi2_store_bf16<8>(acc, lane, (bfraw*)(p.ws + O_VCR) + (size_t)tok0 * 128 + (cb - 640), 128);
                } else if (cb < 896) {
                    epi2_headnorm<8>(acc, lane, p.in[I_NSAKN], 1.f, (bfraw*)(p.ws + O_KS) + ((size_t)(b * 2 + ((cb - 768) >> 6)) * TT + t0) * 64, 64);
                } else if (cb < 1024) {
                    epi2_store_T<8>(acc, lane, (bfraw*)(p.ws + O_VST) + (size_t)(b * 2 + ((cb - 896) >> 6)) * 64 * TT + t0, TT);
                } else if (cb < 1152) {
                    epi2_headnorm<8>(acc, lane, p.in[I_NSAKN], 1.f, (bfraw*)(p.ws + O_KW) + ((size_t)(b * 2 + ((cb - 1024) >> 6)) * TT + t0) * 64, 64);
                } else if (cb < 1280) {
                    epi2_store_T<8>(acc, lane, (bfraw*)(p.ws + O_VWT) + (size_t)(b * 2 + ((cb - 1152) >> 6)) * 64 * TT + t0, TT);
                } else if (cb < 1536) {
                    epi2_store_bf16<8>(acc, lane, (bfraw*)(p.ws + O_LQ) + (size_t)tok0 * 256 + (cb - 1280), 256);
                } else if (cb < 1792) {
                    epi2_store_bf16<8>(acc, lane, (bfraw*)(p.ws + O_LK) + (size_t)tok0 * 256 + (cb - 1536), 256);
                } else if (cb < 2304) {
                    epi2_store_bf16<8>(acc, lane, (bfraw*)(p.ws + O_LV) + (size_t)tok0 * 512 + (cb - 1792), 512);
                } else if (cb < 2816) {
                    epi2_store_bf16<8>(acc, lane, (bfraw*)(p.ws + O_LR) + (size_t)tok0 * 512 + (cb - 2304), 512);
                } else if (cb == 2816) {
                    const int c = lane & 15, g = lane >> 4;
                    float* sm = (float*)(p.ws + O_SM1);
#pragma unroll
                    for (int j = 0; j < 3; ++j)
                        if (j * 16 + 4 * g < 40) {
#pragma unroll
                            for (int i = 0; i < 8; ++i) *(float4*)&sm[(size_t)(tok0 + i * 16 + c) * 40 + j * 16 + 4 * g] = make_float4(acc[i][j][0], acc[i][j][1], acc[i][j][2], acc[i][j][3]);
                        }
                }
            });
    }
}

constexpr int NC_H1 = 0;
DEV void nsa_compress_item(const Params& p, char* smem, int item) {
    const int tid = tidx(), lane = tid & 63, w = tid >> 6, c = lane & 15, g = lane >> 4;
    const int wh = item >> 6, rt = item & 63;
    const int R0 = rt * 64, bk = R0 >> 10, b = bk >> 1, kvh = bk & 1, nb0 = R0 & 1023;
    const bfraw* raw = (const bfraw*)(p.ws + (wh ? O_VCR : O_KCR));
    const bfraw* W1 = (const bfraw*)(p.ws + O_W1T) + (size_t)wh * 256 * 2048;
    const bfraw* W2 = (const bfraw*)(p.ws + O_W2T) + (size_t)wh * 64 * 256;
    bfraw* H1 = (bfraw*)(smem + NC_H1);
    __syncthreads();
    {
        const int wm = w & 3, wn = w >> 2;
        int n = nb0 + wm * 16 + c; if (n > 1022) n = 1022;
        const bfraw* arow = raw + ((size_t)b * TT + 16 * n) * 128 + kvh * 64 + 8 * g;
        const bfraw* brow = W1 + (size_t)(wn * 128 + c) * 2048 + 8 * g;
        f32x4 acc[8];
#pragma unroll
        for (int j = 0; j < 8; ++j) acc[j] = f32x4{0.f, 0.f, 0.f, 0.f};
#pragma unroll 2
        for (int ks = 0; ks < 64; ++ks) {
            const bf16x8 a = ld8(arow + (size_t)(ks >> 1) * 128 + (ks & 1) * 32);
#pragma unroll
            for (int j = 0; j < 8; ++j) acc[j] = mfma16(a, ld8(brow + (size_t)j * 16 * 2048 + ks * 32), acc[j]);
        }
        const float* b1 = (const float*)(p.ws + O_BIAS1) + wh * 256;
#pragma unroll
        for (int j = 0; j < 8; ++j) {
            const int col = wn * 128 + j * 16 + c;
            const float bb = b1[col];
#pragma unroll
            for (int r = 0; r < 4; ++r) H1[(wm * 16 + 4 * g + r) * 264 + col] = f2bf(siluf_(acc[j][r] + bb));
        }
    }
    __syncthreads();
    if (w < 4) {
        f32x4 acc[4];
#pragma unroll
        for (int j = 0; j < 4; ++j) acc[j] = f32x4{0.f, 0.f, 0.f, 0.f};
#pragma unroll
        for (int ks = 0; ks < 8; ++ks) {
            const bf16x8 a = ld8(&H1[(w * 16 + c) * 264 + ks * 32 + 8 * g]);
#pragma unroll
            for (int j = 0; j < 4; ++j) acc[j] = mfma16(a, ld8(W2 + (size_t)(j * 16 + c) * 256 + ks * 32 + 8 * g), acc[j]);
        }
        const int nrow = nb0 + w * 16 + 4 * g;
        if (wh == 0) {
            bfraw* kc = (bfraw*)(p.ws + O_KCMP) + (size_t)bk * 1024 * 64;
#pragma unroll
            for (int r = 0; r < 4; ++r) {
                float ss = 0.f;
#pragma unroll
                for (int j = 0; j < 4; ++j) ss += acc[j][r] * acc[j][r];
                ss = grp16_sum(ss);
                const float rs = (nrow + r < 1023) ? rsqrtf(ss * (1.f / 64.f) + EPSF) : 0.f;
#pragma unroll
                for (int j = 0; j < 4; ++j) kc[(size_t)(nrow + r) * 64 + j * 16 + c] = f2bf(acc[j][r] * rs * p.in[I_NSAKN][j * 16 + c]);
            }
        } else {
            bfraw* vc = (bfraw*)(p.ws + O_VCMPT) + (size_t)bk * 64 * 1024;
#pragma unroll
            for (int j = 0; j < 4; ++j)
                st4bf(vc + (size_t)(j * 16 + c) * 1024 + nrow, acc[j][0], acc[j][1], acc[j][2], (nrow + 3 < 1023) ? acc[j][3] : 0.f);
        }
    }
    __syncthreads();
}

constexpr int GL_G = 0, GL_QD = 16384, GL_KN = 25600, GL_AT = 34816, GL_VT = 44032, GL_KDT = 62464, GL_TOT = 71680;
DEV void gla_a_item(const Params& p, char* smem, int item) {
    const int bh = item >> 8, n = item & 255, b = bh >> 2, h = bh & 3, tok0 = b * TT + n * 64;
    float* G = (float*)(smem + GL_G);
    bfraw* qd = (bfraw*)(smem + GL_QD);
    bfraw* kn = (bfraw*)(smem + GL_KN);
    bfraw* at = (bfraw*)(smem + GL_AT);
    bfraw* vT = (bfraw*)(smem + GL_VT);
    bfraw* kdT = (bfraw*)(smem + GL_KDT);
    float* tot = (float*)(smem + GL_TOT);
    const float* sm1 = (const float*)(p.ws + O_SM1);
    __syncthreads();
    {
        OPQ_TID();
        const int d = tid & 63, ig = tid >> 6;
        float wu[16];
#pragma unroll
        for (int r = 0; r < 16; ++r) wu[r] = p.in[I_GLAWG][r * 256 + h * 64 + d];
        const float bg = p.in[I_GLABG][h * 64 + d];
        float run = 0.f;
#pragma unroll 1
        for (int ii = 0; ii < 8; ++ii) {
            const int i = ig * 8 + ii;
            const float* lg = sm1 + (size_t)(tok0 + i) * 40 + 24;
            float z = bg;
#pragma unroll
            for (int r = 0; r < 16; ++r) z += lg[r] * wu[r];
            run += logsigmoidf_(z) * (1.f / 16.f);
            G[i * 64 + d] = run;
        }
        tot[ig * 64 + d] = run;
    }
    __syncthreads();
    {
        OPQ_TID();
        const int d = tid & 63, ig = tid >> 6;
        float off = 0.f;
        for (int q = 0; q < ig; ++q) off += tot[q * 64 + d];
#pragma unroll 1
        for (int ii = 0; ii < 8; ++ii) G[(ig * 8 + ii) * 64 + d] += off;
    }
    __syncthreads();
    {
        OPQ_TID();
        const int i = tid >> 3, d0 = (tid & 7) * 8, e0 = (tid & 7) * 16;
        U4 qv, kv;
        qv.u = *(const uint4*)((const bfraw*)(p.ws + O_LQ) + (size_t)(tok0 + i) * 256 + h * 64 + d0);
        kv.u = *(const uint4*)((const bfraw*)(p.ws + O_LK) + (size_t)(tok0 + i) * 256 + h * 64 + d0);
        U4 qo, ko;
#pragma unroll
        for (int q = 0; q < 4; ++q) {
            const float g0 = G[i * 64 + d0 + 2 * q], g1 = G[i * 64 + d0 + 2 * q + 1];
            const float gl0 = G[63 * 64 + d0 + 2 * q], gl1 = G[63 * 64 + d0 + 2 * q + 1];
            const float q0 = lo2f(qv.w[q]), q1 = hi2f(qv.w[q]), k0 = lo2f(kv.w[q]), k1 = hi2f(kv.w[q]);
            qo.w[q] = pack2(q0 * 0.125f * __expf(g0), q1 * 0.125f * __expf(g1));
            ko.w[q] = pack2(k0 * __expf(-g0), k1 * __expf(-g1));
            kdT[(d0 + 2 * q) * 72 + i] = f2bf(k0 * __expf(gl0 - g0));
            kdT[(d0 + 2 * q + 1) * 72 + i] = f2bf(k1 * __expf(gl1 - g1));
        }
        *(uint4*)&qd[i * 72 + d0] = qo.u;
        *(uint4*)&kn[i * 72 + d0] = ko.u;
        *(uint4*)((bfraw*)(p.ws + O_QD) + ((size_t)item * 64 + i) * 64 + d0) = qo.u;
        const bfraw* vp = (const bfraw*)(p.ws + O_LV) + (size_t)(tok0 + i) * 512 + h * 128 + e0;
        U4 v0, v1; v0.u = *(const uint4*)vp; v1.u = *(const uint4*)(vp + 8);
#pragma unroll
        for (int q = 0; q < 4; ++q) {
            vT[(e0 + 2 * q) * 72 + i] = (bfraw)(v0.w[q] & 0xffffu); vT[(e0 + 2 * q + 1) * 72 + i] = (bfraw)(v0.w[q] >> 16);
            vT[(e0 + 8 + 2 * q) * 72 + i] = (bfraw)(v1.w[q] & 0xffffu); vT[(e0 + 8 + 2 * q + 1) * 72 + i] = (bfraw)(v1.w[q] >> 16);
        }
        if (tid < 64) ((float*)(p.ws + O_AN))[(size_t)item * 64 + tid] = __expf(G[63 * 64 + tid]);
    }
    __syncthreads();
    {
        OPQ_TID();
        const int ti = w >> 1, tj0 = (w & 1) * 2;
        f32x4 acc[2];
        acc[0] = f32x4{0.f, 0.f, 0.f, 0.f}; acc[1] = f32x4{0.f, 0.f, 0.f, 0.f};
#pragma unroll
        for (int ks = 0; ks < 2; ++ks) {
            const bf16x8 a = ld8(&qd[(ti * 16 + c) * 72 + ks * 32 + 8 * g]);
#pragma unroll
            for (int jt = 0; jt < 2; ++jt) acc[jt] = mfma16(a, ld8(&kn[((tj0 + jt) * 16 + c) * 72 + ks * 32 + 8 * g]), acc[jt]);
        }
#pragma unroll
        for (int jt = 0; jt < 2; ++jt)
#pragma unroll
            for (int r = 0; r < 4; ++r) {
                const int i = ti * 16 + 4 * g + r, j = (tj0 + jt) * 16 + c;
                at[i * 72 + j] = f2bf(i >= j ? acc[jt][r] : 0.f);
            }
    }
    __syncthreads();
    {
        OPQ_TID();
        f32x4 ao[4], ab[4];
#pragma unroll
        for (int q = 0; q < 4; ++q) { ao[q] = f32x4{0.f, 0.f, 0.f, 0.f}; ab[q] = f32x4{0.f, 0.f, 0.f, 0.f}; }
#pragma unroll
        for (int ks = 0; ks < 2; ++ks) {
            const bf16x8 ve = ld8(&vT[(w * 16 + c) * 72 + ks * 32 + 8 * g]);
#pragma unroll
            for (int q = 0; q < 4; ++q) {
                ao[q] = mfma16(ve, ld8(&at[(q * 16 + c) * 72 + ks * 32 + 8 * g]), ao[q]);
                ab[q] = mfma16(ld8(&kdT[(q * 16 + c) * 72 + ks * 32 + 8 * g]), ve, ab[q]);
            }
        }
        bfraw* yc = (bfraw*)(p.ws + O_YCAT);
        float* st = (float*)(p.ws + O_ST) + (size_t)item * 8192;
#pragma unroll
        for (int q = 0; q < 4; ++q) {
            st4bf(yc + (size_t)(tok0 + q * 16 + c) * 1024 + 512 + h * 128 + w * 16 + 4 * g, ao[q][0], ao[q][1], ao[q][2], ao[q][3]);
            *(float4*)(st + (size_t)(w * 16 + c) * 64 + q * 16 + 4 * g) = make_float4(ab[q][0], ab[q][1], ab[q][2], ab[q][3]);
        }
    }
    lds_barrier();
}

DEV void gla_scan_item(const Params& p, int item) {
    const int id = item * 512 + tidx(), bh = id >> 13, rem = id & 8191, d = rem & 63;
    float* st = (float*)(p.ws + O_ST) + (size_t)bh * 256 * 8192 + rem;
    const float* an = (const float*)(p.ws + O_AN) + (size_t)bh * 256 * 64 + d;
    float S = 0.f;
    for (int n0 = 0; n0 < 256; n0 += 8) {
        float bv[8], av[8];
#pragma unroll
        for (int q = 0; q < 8; ++q) { bv[q] = st[(size_t)(n0 + q) * 8192]; av[q] = an[(size_t)(n0 + q) * 64]; }
#pragma unroll
        for (int q = 0; q < 8; ++q) { st[(size_t)(n0 + q) * 8192] = S; S = av[q] * S + bv[q]; }
    }
}

DEV void gla_c_witem(const Params& p, int witem, bool dry = false) {
    const int lane = tidx() & 63, c = lane & 15, g = lane >> 4;
    const int item = witem >> 2, it = witem & 3;
    const int bh = item >> 8, n = item & 255, b = bh >> 2, h = bh & 3;
    const float* st = (const float*)(p.ws + O_ST) + (size_t)item * 8192;
    const bfraw* qd = (const bfraw*)(p.ws + O_QD) + (size_t)item * 4096;
    f32x4 acc[8];
#pragma unroll
    for (int et = 0; et < 8; ++et) acc[et] = f32x4{0.f, 0.f, 0.f, 0.f};
#pragma unroll
    for (int ks = 0; ks < 2; ++ks) {
        const bf16x8 bq = ld8(qd + (size_t)(it * 16 + c) * 64 + ks * 32 + 8 * g);
#pragma unroll
        for (int et = 0; et < 8; ++et) {
            const float* sp = st + (size_t)(et * 16 + c) * 64 + ks * 32 + 8 * g;
            const float4 s0 = *(const float4*)sp, s1 = *(const float4*)(sp + 4);
            acc[et] = mfma16(pack8(s0.x, s0.y, s0.z, s0.w, s1.x, s1.y, s1.z, s1.w), bq, acc[et]);
        }
    }
    const int tok = b * TT + n * 64 + it * 16 + c;
    bfraw* yp = (bfraw*)(p.ws + O_YCAT) + (size_t)tok * 1024 + 512 + h * 128 + 4 * g;
    const bfraw* lr = (const bfraw*)(p.ws + O_LR) + (size_t)tok * 512 + h * 128 + 4 * g;
    float ss = 0.f;
#pragma unroll
    for (int et = 0; et < 8; ++et) {
        const uint2 o0 = *(const uint2*)(yp + et * 16);
        acc[et][0] += lo2f(o0.x); acc[et][1] += hi2f(o0.x); acc[et][2] += lo2f(o0.y); acc[et][3] += hi2f(o0.y);
        ss += acc[et][0] * acc[et][0] + acc[et][1] * acc[et][1] + acc[et][2] * acc[et][2] + acc[et][3] * acc[et][3];
    }
    ss = grpx_sum(ss);
    const float rs = rsqrtf(ss * (1.f / 128.f) + EPSF);
#pragma unroll
    for (int et = 0; et < 8; ++et) {
        const uint2 zv = *(const uint2*)(lr + et * 16);
        const float4 gn = *(const float4*)(p.in[I_GLAON] + et * 16 + 4 * g);
        st4bf((dry ? (bfraw*)(p.ws + O_KS) + (size_t)tok * 128 + 4 * g : yp) + et * 16, acc[et][0] * rs * gn.x * siluf_(lo2f(zv.x)), acc[et][1] * rs * gn.y * siluf_(hi2f(zv.x)),
                            acc[et][2] * rs * gn.z * siluf_(lo2f(zv.y)), acc[et][3] * rs * gn.w * siluf_(hi2f(zv.y)));
    }
}
constexpr int NS_IMP = 0;
constexpr int NS_IMPW = 16448;
constexpr int NS_LINV = 131584;
constexpr int NS_BTAB = 132096;
constexpr int NS_SELW = 134400;
DEV int t5_bucket(int n) {
    if (n < 16) return n;
    int v = 16 + (int)(__logf((float)n * (1.f / 16.f)) / 2.0794415416798357f * 16.f);
    return v < 31 ? v : 31;
}
template <int MODE>
DEV void nsa_step(const bfraw* Kb, const bfraw* VTb, size_t vstride, int kb, const bf16x8 (&qf)[2], int tpos, int lim, bool colsel, const float* bt, float Mb2,
                  f32x4 (&O)[4], float& l, float* impU, int c, int g) {
    bf16x8 kf[2][2];
#pragma unroll
    for (int kt = 0; kt < 2; ++kt)
#pragma unroll
        for (int ks = 0; ks < 2; ++ks) kf[kt][ks] = ld8(Kb + (size_t)(kb + kt * 16 + c) * 64 + ks * 32 + 8 * g);
    bf16x8 vf[4];
#pragma unroll
    for (int dt = 0; dt < 4; ++dt) { const bfraw* vp = VTb + (size_t)(dt * 16 + c) * vstride + kb + 4 * g; vf[dt] = ld4x2(vp, vp + 16); }
    float pr[2][4];
#pragma unroll
    for (int kt = 0; kt < 2; ++kt) {
        f32x4 S = mfma16(kf[kt][0], qf[0], f32x4{0.f, 0.f, 0.f, 0.f});
        S = mfma16(kf[kt][1], qf[1], S);
#pragma unroll
        for (int r = 0; r < 4; ++r) {
            const int key = kb + kt * 16 + 4 * g + r;
            int dist; bool valid;
            if (MODE == 0) { dist = tpos - 16 * key - 31; valid = key < lim; }
            else if (MODE == 1) { dist = tpos - key; valid = colsel && dist >= 0; }
            else { dist = tpos - key; valid = dist >= 0 && dist < 512; }
            const int bi = dist < 0 ? 0 : (dist > 128 ? 128 : dist);
            const float e = valid ? ex2(S[r] + bt[bi] - Mb2) : 0.f;
            pr[kt][r] = e; l += e;
        }
        if (MODE == 0) {
            const int blk = ((kb + kt * 16) >> 2) + g;
            atomicAdd(&impU[blk * 16 + c], pr[kt][0] + pr[kt][1] + pr[kt][2] + pr[kt][3]);
            atomicAdd(&impU[(blk + 1) * 16 + c], pr[kt][3]);
        }
    }
    const bf16x8 pb = pack8(pr[0][0], pr[0][1], pr[0][2], pr[0][3], pr[1][0], pr[1][1], pr[1][2], pr[1][3]);
#pragma unroll
    for (int dt = 0; dt < 4; ++dt) O[dt] = mfma16(vf[dt], pb, O[dt]);
}

DEV void nsa_item(const Params& p, char* smem, int item) {
    const int tid = tidx(), lane = tid & 63, w = tid >> 6, c = lane & 15, g = lane >> 4;
    const int bk = item >> 9, tq0 = (item & 511) * 32, b = bk >> 1, kvh = bk & 1;
    const int qi = c >> 2, hg = c & 3, h = kvh * 4 + hg;
    const int tw0 = tq0 + 4 * w, tpos = tw0 + qi;
    float* impU = (float*)(smem + NS_IMP + w * NS_IMPW);
    float* linv = (float*)(smem + NS_LINV) + w * 16;
    float* btab = (float*)(smem + NS_BTAB);
    unsigned long long* selw = (unsigned long long*)(smem + NS_SELW) + w * 20;
    __syncthreads();
    for (int idx = tid; idx < 4 * 129; idx += NTHR) {
        const int hh = idx / 129, dd = idx % 129;
        btab[idx] = p.in[I_RELB][(dd < 128 ? t5_bucket(dd) : 31) * 8 + kvh * 4 + hh] * LOG2E;
    }
    for (int idx = lane; idx < 257 * 16; idx += 64) impU[idx] = 0.f;
    const float mq = wave_max(fabsf(p.in[I_NSAQN][lane])), mk = wave_max(fabsf(p.in[I_NSAKN][lane]));
    const float mb = wave_max(fmaxf(fmaxf(fabsf(p.in[I_RELB][lane]), fabsf(p.in[I_RELB][64 + lane])), fmaxf(fabsf(p.in[I_RELB][128 + lane]), fabsf(p.in[I_RELB][192 + lane]))));
    const float Mb2 = (8.f * mq * mk + mb) * LOG2E;
    __syncthreads();
    const float* bt = btab + hg * 129;
    bf16x8 qf[2];
    {
        const bfraw* qp = (const bfraw*)(p.ws + O_QN) + ((size_t)(b * 8 + h) * TT + tpos) * 64 + 8 * g;
        qf[0] = ld8(qp); qf[1] = ld8(qp + 32);
    }
    const float* gp = (const float*)(p.ws + O_SM1) + (size_t)(b * TT + tpos) * 40 + h * 3;
    const float gt0 = sigmoidf_(gp[0]), gt1 = sigmoidf_(gp[1]), gt2 = sigmoidf_(gp[2]);
    f32x4 ot[4];
#pragma unroll
    for (int dt = 0; dt < 4; ++dt) ot[dt] = f32x4{0.f, 0.f, 0.f, 0.f};
    {
        const int ncnt = tpos >= 31 ? ((tpos - 31) >> 4) + 1 : 0;
        const int tmax = tw0 + 3;
        const int ncw = tmax >= 31 ? ((tmax - 31) >> 4) + 1 : 0;
        const bfraw* Kb = (const bfraw*)(p.ws + O_KCMP) + (size_t)bk * 1024 * 64;
        const bfraw* Vb = (const bfraw*)(p.ws + O_VCMPT) + (size_t)bk * 64 * 1024;
        f32x4 O[4]; float l = 0.f;
#pragma unroll
        for (int dt = 0; dt < 4; ++dt) O[dt] = f32x4{0.f, 0.f, 0.f, 0.f};
        for (int kb = 0; kb < ncw; kb += 32) nsa_step<0>(Kb, Vb, 1024, kb, qf, tpos, ncnt, true, bt, Mb2, O, l, impU, c, g);
        const float lt = grpx_sum(l);
        const float inv = lt > 0.f ? 1.f / lt : 0.f;
        if (g == 0) linv[c] = inv;
#pragma unroll
        for (int dt = 0; dt < 4; ++dt) ot[dt] += O[dt] * (gt0 * inv);
    }
    const int cur = tw0 >> 6;
    {
        unsigned long long un[4] = {0ull, 0ull, 0ull, 0ull};
#pragma unroll 1
        for (int q = 0; q < 4; ++q) {
            float v[4]; bool sel[4];
#pragma unroll
            for (int m = 0; m < 4; ++m) {
                const int s = lane + 64 * m;
                float a = -1.f;
                if (s <= cur) {
                    a = 0.f;
#pragma unroll
                    for (int hh = 0; hh < 4; ++hh) a += impU[s * 16 + q * 4 + hh] * linv[q * 4 + hh];
                }
                const bool forced = (s <= cur) && (s == 0 || s == cur || s == cur - 1);
                sel[m] = forced; v[m] = forced ? -1.f : a;
            }
            const int nforced = cur == 0 ? 1 : (cur == 1 ? 2 : 3);
            const int need = (cur + 1 < 16 ? cur + 1 : 16) - nforced;
            for (int itn = 0; itn < need; ++itn) {
                const float vmax = wave_max(fmaxf(fmaxf(v[0], v[1]), fmaxf(v[2], v[3])));
                if (!(vmax >= 0.f)) break;
                bool done = false;
#pragma unroll
                for (int m = 0; m < 4; ++m) {
                    const unsigned long long mk2 = __ballot(v[m] == vmax);
                    if (!done && mk2 != 0ull) {
                        const int ln = __builtin_ctzll(mk2);
                        if (lane == ln) { sel[m] = true; v[m] = -1.f; }
                        done = true;
                    }
                }
            }
#pragma unroll
            for (int m = 0; m < 4; ++m) {
                const unsigned long long bm = __ballot(sel[m]);
                if (lane == 0) selw[q * 4 + m] = bm;
                un[m] |= bm;
            }
        }
        if (lane == 0) {
#pragma unroll
            for (int m = 0; m < 4; ++m) selw[16 + m] = un[m];
        }
    }
    {
        const bfraw* Kb = (const bfraw*)(p.ws + O_KS) + (size_t)bk * TT * 64;
        const bfraw* Vb = (const bfraw*)(p.ws + O_VST) + (size_t)bk * 64 * TT;
        f32x4 O[4]; float l = 0.f;
#pragma unroll
        for (int dt = 0; dt < 4; ++dt) O[dt] = f32x4{0.f, 0.f, 0.f, 0.f};
#pragma unroll 1
        for (int m = 0; m < 4; ++m) {
            unsigned long long um = selw[16 + m];
            const unsigned long long mine = selw[qi * 4 + m];
            while (um) {
                const int bit = __builtin_ctzll(um);
                um &= um - 1ull;
                const bool colsel = (mine >> bit) & 1ull;
                const int k0 = (64 * m + bit) * 64;
                nsa_step<1>(Kb, Vb, TT, k0, qf, tpos, 0, colsel, bt, Mb2, O, l, impU, c, g);
                nsa_step<1>(Kb, Vb, TT, k0 + 32, qf, tpos, 0, colsel, bt, Mb2, O, l, impU, c, g);
            }
        }
        const float lt = grpx_sum(l);
        const float inv = lt > 0.f ? 1.f / lt : 0.f;
#pragma unroll
        for (int dt = 0; dt < 4; ++dt) ot[dt] += O[dt] * (gt1 * inv);
    }
    {
        const bfraw* Kb = (const bfraw*)(p.ws + O_KW) + (size_t)bk * TT * 64;
        const bfraw* Vb = (const bfraw*)(p.ws + O_VWT) + (size_t)bk * 64 * TT;
        f32x4 O[4]; float l = 0.f;
#pragma unroll
        for (int dt = 0; dt < 4; ++dt) O[dt] = f32x4{0.f, 0.f, 0.f, 0.f};
        int ks0 = tw0 - 511; if (ks0 < 0) ks0 = 0; ks0 &= ~31;
        for (int kb = ks0; kb <= tw0 + 3; kb += 32) nsa_step<2>(Kb, Vb, TT, kb, qf, tpos, 0, true, bt, Mb2, O, l, impU, c, g);
        const float lt = grpx_sum(l);
        const float inv = lt > 0.f ? 1.f / lt : 0.f;
#pragma unroll
        for (int dt = 0; dt < 4; ++dt) ot[dt] += O[dt] * (gt2 * inv);
    }
    bfraw* yp = (bfraw*)(p.ws + O_YCAT) + (size_t)(b * TT + tpos) * 1024 + h * 64 + 4 * g;
#pragma unroll
    for (int dt = 0; dt < 4; ++dt) st4bf(yp + dt * 16, ot[dt][0], ot[dt][1], ot[dt][2], ot[dt][3]);
    __syncthreads();
}
constexpr int N2_IMP = 71680, N2_BTAB = 138240, N2_SELW = 140320;
constexpr int N2_IMPW = 8 * 260;

template <int MODE>
DEV void nsa_tile(const bfraw* Kb, const bfraw* Vb, int key0, const bf16x8 (&qf)[2][2], const int (&tpos)[2], const int (&lim)[2], const bool (&colsel)[2],
                  const bool (&act)[2], const float* bt, bool far, float Mb2, const float (&pscale)[2], f32x4 (&O)[2][4], float (&l)[2], float* impq, int c, int g, int vld = 72, float* carry = nullptr) {
    bf16x8 pb[2][2];
    const float bfar = bt[128] - Mb2;
#pragma unroll
    for (int kt = 0; kt < 4; ++kt) {
        const bf16x8 k0 = ld8(&Kb[(kt * 16 + c) * 72 + g * 8]), k1 = ld8(&Kb[(kt * 16 + c) * 72 + 32 + g * 8]);
#pragma unroll
        for (int cg = 0; cg < 2; ++cg) {
            if (!act[cg]) continue;
            float e[4];
            if (far) {
                const float bi = (MODE == 2 && !colsel[cg]) ? -INFINITY : bfar;
                f32x4 S = mfma16(k0, qf[cg][0], f32x4{bi, bi, bi, bi});
                S = mfma16(k1, qf[cg][1], S);
#pragma unroll
                for (int r = 0; r < 4; ++r) { e[r] = ex2(S[r]); if (MODE == 1) e[r] *= pscale[cg]; l[cg] += e[r]; }
            } else {
                f32x4 S = mfma16(k0, qf[cg][0], f32x4{0.f, 0.f, 0.f, 0.f});
                S = mfma16(k1, qf[cg][1], S);
#pragma unroll
                for (int r = 0; r < 4; ++r) {
                    const int key = key0 + kt * 16 + 4 * g + r;
                    bool valid; int dist;
                    if (MODE <= 1) { dist = tpos[cg] - 16 * key - 31; valid = key < lim[cg]; }
                    else { dist = tpos[cg] - key; valid = (MODE == 2) ? (colsel[cg] && dist >= 0) : (dist >= 0 && dist < 512); }
                    const float bias = bt[dist < 0 ? 0 : (dist > 128 ? 128 : dist)] - Mb2;
                    e[r] = valid ? ex2(S[r] + bias) : 0.f;
                    if (MODE == 1) e[r] *= pscale[cg];
                    l[cg] += e[r];
                }
            }
            if (MODE == 1) {
                float a = (e[0] + e[1]) + (e[2] + e[3]), a3 = e[3];
                a += __shfl_xor(a, 1); a3 += __shfl_xor(a3, 1);
                a += __shfl_xor(a, 2); a3 += __shfl_xor(a3, 2);
                const float pu = __shfl_up(a3, 16), pw = __shfl(carry[cg], (c + 48) & 63);
                a += (g == 0) ? pw : pu;
                carry[cg] = a3;
                if ((c & 3) == 0) impq[(cg * 4 + (c >> 2)) * 260 + ((key0 + kt * 16) >> 2) + g] = a;
            }
            if (MODE != 0) {
                U4 t;
                if (kt & 1) { t.v = pb[cg][kt >> 1]; t.w[2] = pack2(e[0], e[1]); t.w[3] = pack2(e[2], e[3]); }
                else { t.w[0] = pack2(e[0], e[1]); t.w[1] = pack2(e[2], e[3]); t.w[2] = 0u; t.w[3] = 0u; }
                pb[cg][kt >> 1] = t.v;
            }
        }
    }
    if (MODE != 0) {
#pragma unroll
        for (int dt = 0; dt < 4; ++dt) {
            const bfraw* vp = &Vb[(dt * 16 + c) * vld + 4 * g];
            const bf16x8 v0 = ld4x2(vp, vp + 16), v1 = ld4x2(vp + 32, vp + 48);
#pragma unroll
            for (int cg = 0; cg < 2; ++cg) if (act[cg]) { O[cg][dt] = mfma16(v0, pb[cg][0], O[cg][dt]); O[cg][dt] = mfma16(v1, pb[cg][1], O[cg][dt]); }
        }
    }
}

DEV void nsa_item2(const Params& p, char* smem, int item) {
    const int tid = tidx(), lane = tid & 63, w = tid >> 6, c = lane & 15, g = lane >> 4;
    const int bk = item >> 8, cur = item & 255, Q0 = cur * 64, b = bk >> 1, kvh = bk & 1;
    const int hg = c & 3, h = kvh * 4 + hg;
    float* impq = (float*)(smem + N2_IMP) + w * N2_IMPW;
    float* btab = (float*)(smem + N2_BTAB);
    unsigned long long* selw = (unsigned long long*)(smem + N2_SELW) + w * 36;
    __syncthreads();
    for (int idx = tid; idx < 4 * 129; idx += NTHR) {
        const int hh = idx / 129, dd = idx % 129;
        btab[idx] = p.in[I_RELB][(dd < 128 ? t5_bucket(dd) : 31) * 8 + kvh * 4 + hh] * LOG2E;
    }
    for (int idx = lane; idx < N2_IMPW; idx += 64) impq[idx] = 0.f;
    const float mq = wave_max(fabsf(p.in[I_NSAQN][lane])), mk = wave_max(fabsf(p.in[I_NSAKN][lane]));
    const float mb = wave_max(fmaxf(fmaxf(fabsf(p.in[I_RELB][lane]), fabsf(p.in[I_RELB][64 + lane])), fmaxf(fabsf(p.in[I_RELB][128 + lane]), fabsf(p.in[I_RELB][192 + lane]))));
    const float Mb2 = (8.f * mq * mk + mb) * LOG2E;
    const float* bt = btab + hg * 129;
    int tpos[2]; bf16x8 qf[2][2];
    float* otl = impq;
#pragma unroll
    for (int cg = 0; cg < 2; ++cg) {
        tpos[cg] = Q0 + 8 * w + 4 * cg + (c >> 2);
        const bfraw* qp = (const bfraw*)(p.ws + O_QN) + ((size_t)(b * 8 + h) * TT + tpos[cg]) * 64 + 8 * g;
        qf[cg][0] = ld8(qp); qf[cg][1] = ld8(qp + 32);
    }
    const float* gbase = (const float*)(p.ws + O_SM1) + (size_t)b * TT * 40 + h * 3;
    const bool csel1[2] = {true, true};
    const float one2[2] = {1.f, 1.f};
    f32x4 Oc[2][4];
    {
        int lim[2];
#pragma unroll
        for (int cg = 0; cg < 2; ++cg) lim[cg] = tpos[cg] >= 31 ? ((tpos[cg] - 31) >> 4) + 1 : 0;
        const int ncb = ((Q0 + 32) >> 4) + 1, nct = (ncb + 63) >> 6;
        const bfraw* Kg = (const bfraw*)(p.ws + O_KCMP) + (size_t)bk * 1024 * 64;
        const bfraw* Vg = (const bfraw*)(p.ws + O_VCMPT) + (size_t)bk * 64 * 1024;
        float l[2] = {0.f, 0.f};
#pragma unroll
        for (int cg = 0; cg < 2; ++cg)
#pragma unroll
            for (int dt = 0; dt < 4; ++dt) Oc[cg][dt] = f32x4{0.f, 0.f, 0.f, 0.f};
        tile_stream<false, false>(smem, Kg, Vg, 1024, nullptr, nct, [](int t) { return t * 64; },
            [&](int t, const bfraw* Kb, const bfraw* Vb, const float*) { nsa_tile<0>(Kb, Vb, t * 64, qf, tpos, lim, csel1, csel1, bt, 1024 * t + 1039 + 128 <= Q0, Mb2, one2, Oc, l, impq, c, g); });
        float linv[2];
#pragma unroll
        for (int cg = 0; cg < 2; ++cg) { const float lt = grpx_sum(l[cg]); linv[cg] = lt > 0.f ? 1.f / lt : 0.f; l[cg] = 0.f; }
        float carry[2] = {0.f, 0.f};
        tile_stream<true, false>(smem, Kg, Vg, 1024, nullptr, nct, [](int t) { return t * 64; },
            [&](int t, const bfraw* Kb, const bfraw* Vb, const float*) { nsa_tile<1>(Kb, Vb, t * 64, qf, tpos, lim, csel1, csel1, bt, 1024 * t + 1039 + 128 <= Q0, Mb2, linv, Oc, l, impq, c, g, 72, carry); });
    }
    {
        unsigned long long un[4] = {0ull, 0ull, 0ull, 0ull};
        const int nforced = cur == 0 ? 1 : (cur == 1 ? 2 : 3);
        const int need = (cur + 1 < 16 ? cur + 1 : 16) - nforced;
#pragma unroll 1
        for (int q = 0; q < 8; ++q) {
            float v[4]; bool sel[4];
#pragma unroll
            for (int m = 0; m < 4; ++m) {
                const int s = lane + 64 * m;
                const bool inr = s <= cur;
                const bool forced = inr && (s == 0 || s == cur || s == cur - 1);
                sel[m] = forced; v[m] = (inr && !forced) ? impq[q * 260 + s] : -1.f;
            }
            for (int itn = 0; itn < need; ++itn) {
                const float vmax = wave_max(fmaxf(fmaxf(v[0], v[1]), fmaxf(v[2], v[3])));
                if (!(vmax >= 0.f)) break;
                bool done = false;
#pragma unroll
                for (int m = 0; m < 4; ++m) {
                    const unsigned long long mk2 = __ballot(v[m] == vmax);
                    if (!done && mk2 != 0ull) {
                        const int ln = __builtin_ctzll(mk2);
                        if (lane == ln) { sel[m] = true; v[m] = -1.f; }
                        done = true;
                    }
                }
            }
#pragma unroll
            for (int m = 0; m < 4; ++m) {
                const unsigned long long bm = __ballot(sel[m]);
                if (lane == 0) selw[q * 4 + m] = bm;
                un[m] |= bm;
            }
        }
        if (lane == 0) {
#pragma unroll
            for (int m = 0; m < 4; ++m) selw[32 + m] = un[m];
        }
    }
#pragma unroll
    for (int cg = 0; cg < 2; ++cg) {
        const float g0 = sigmoidf_(gbase[(size_t)tpos[cg] * 40 + 0]);
#pragma unroll
        for (int dt = 0; dt < 4; ++dt)
#pragma unroll
            for (int r = 0; r < 4; ++r) otl[((cg * 4 + dt) * 4 + r) * 64 + lane] = Oc[cg][dt][r] * g0;
    }
    {
        const bfraw* Kg = (const bfraw*)(p.ws + O_KS) + (size_t)bk * TT * 64;
        const bfraw* Vg = (const bfraw*)(p.ws + O_VST) + (size_t)bk * 64 * TT;
        f32x4 O[2][4]; float l[2] = {0.f, 0.f};
        const int lim0[2] = {0, 0};
#pragma unroll
        for (int cg = 0; cg < 2; ++cg)
#pragma unroll
            for (int dt = 0; dt < 4; ++dt) O[cg][dt] = f32x4{0.f, 0.f, 0.f, 0.f};
        tile_stream2(smem, Kg, Vg, TT, (cur + 2) >> 1, [](int t) { return t * 128; }, [&](int t) { return (2 * t + 1 <= cur ? 2 * t + 1 : cur) * 64; },
            [&](int t, const bfraw* Kb, const bfraw* Vb) {
#pragma unroll
                for (int u = 0; u < 2; ++u) {
                    const int s = 2 * t + u;
                    if (s > cur) continue;
                    const int m = s >> 6, bit = s & 63;
                    if ((selw[32 + m] >> bit) & 1ull) {
                        bool cs[2], ac[2];
                        cs[0] = (selw[(c >> 2) * 4 + m] >> bit) & 1ull;
                        cs[1] = (selw[(4 + (c >> 2)) * 4 + m] >> bit) & 1ull;
                        ac[0] = ((selw[0 + m] | selw[4 + m] | selw[8 + m] | selw[12 + m]) >> bit) & 1ull;
                        ac[1] = ((selw[16 + m] | selw[20 + m] | selw[24 + m] | selw[28 + m]) >> bit) & 1ull;
                        nsa_tile<2>(Kb + u * 64 * 72, Vb + u * 64, s * 64, qf, tpos, lim0, cs, ac, bt, cur - s >= 3, Mb2, one2, O, l, impq, c, g, 136);
                    }
                }
            });
#pragma unroll
        for (int cg = 0; cg < 2; ++cg) {
            const float lt = grpx_sum(l[cg]);
            const float sc = (lt > 0.f ? 1.f / lt : 0.f) * sigmoidf_(gbase[(size_t)tpos[cg] * 40 + 1]);
#pragma unroll
            for (int dt = 0; dt < 4; ++dt)
#pragma unroll
                for (int r = 0; r < 4; ++r) otl[((cg * 4 + dt) * 4 + r) * 64 + lane] += O[cg][dt][r] * sc;
        }
    }
    {
        const bfraw* Kg = (const bfraw*)(p.ws + O_KW) + (size_t)bk * TT * 64;
        const bfraw* Vg = (const bfraw*)(p.ws + O_VWT) + (size_t)bk * 64 * TT;
        f32x4 O[2][4]; float l[2] = {0.f, 0.f};
        const int lim0[2] = {0, 0};
#pragma unroll
        for (int cg = 0; cg < 2; ++cg)
#pragma unroll
            for (int dt = 0; dt < 4; ++dt) O[cg][dt] = f32x4{0.f, 0.f, 0.f, 0.f};
        const int j0 = cur >= 8 ? cur - 8 : 0;
        tile_stream<true, false>(smem, Kg, Vg, TT, nullptr, cur - j0 + 1, [&](int t) { return (j0 + t) * 64; },
            [&](int t, const bfraw* Kb, const bfraw* Vb, const float*) {
                const int j = j0 + t;
                nsa_tile<3>(Kb, Vb, j * 64, qf, tpos, lim0, csel1, csel1, bt, (cur - j >= 3) && (cur - j <= 6), Mb2, one2, O, l, impq, c, g);
            });
#pragma unroll
        for (int cg = 0; cg < 2; ++cg) {
            const float lt = grpx_sum(l[cg]);
            const float sc = (lt > 0.f ? 1.f / lt : 0.f) * sigmoidf_(gbase[(size_t)tpos[cg] * 40 + 2]);
            bfraw* yp = (bfraw*)(p.ws + O_YCAT) + (size_t)(b * TT + tpos[cg]) * 1024 + h * 64 + 4 * g;
#pragma unroll
            for (int dt = 0; dt < 4; ++dt) {
                const float* op = &otl[((cg * 4 + dt) * 4) * 64 + lane];
                st4bf(yp + dt * 16, op[0] + O[cg][dt][0] * sc, op[64] + O[cg][dt][1] * sc, op[128] + O[cg][dt][2] * sc, op[192] + O[cg][dt][3] * sc);
            }
        }
    }
    __syncthreads();
}
constexpr int SM_QSLOT = 148000, SM_BARW = 148016;
DEV int q_pop(unsigned* ctr, char* smem) {
    int* slot = (int*)(smem + SM_QSLOT);
    __syncthreads();
    if (tidx() == 0) *slot = (int)atomicAdd(ctr, 1u);
    __syncthreads();
    return *slot;
}

template <int P, int REP = 0> DEV void run_phase(const Params& p, char* smem) {
    unsigned* ctrs = (unsigned*)(p.ws + O_CNT);
    if constexpr (P == 0) {
        phase_prologue(p, smem);
    } else if constexpr (P == 1) {
        phase_norm1(p, p.in[I_X], 0);
    } else if constexpr (P == 2) {
        phase_inproj0(p, smem, ctrs + 512 + (2 * 3 + REP) * 8);
    } else if constexpr (P == 3) {
#ifdef DBG_NO_GDN
        for (int it = blockIdx.x; it < 16; it += gridDim.x) fox_cumsum_item(p, smem, it);
#else
        for (int it = blockIdx.x; it < 16 + 2048; it += gridDim.x) { if (it < 16) fox_cumsum_item(p, smem, it); else gdn_a_item(p, smem, it - 16); }
#endif
    } else if constexpr (P == 4) {
#if !defined(DBG_NO_GDN) && !defined(DBG_NO_SCAN)
        if (REP != 2 && blockIdx.x < 64) gdn_scan_item2(p, smem, blockIdx.x);
#endif
        for (;;) {
            const int it = q_pop(&ctrs[REP ? 4 + REP : 0], smem);
            if (it >= 1024) break;
            fox_item2(p, smem, it & 15, 63 - (it >> 4));
        }
    } else if constexpr (P == 5) {
        const int w = tidx() >> 6;
#ifdef DBG_NO_GDN
        for (size_t i = (size_t)blockIdx.x * NTHR + tidx(); i < (size_t)NT * 512; i += (size_t)gridDim.x * NTHR) ((bfraw*)(p.ws + O_YCAT))[(i >> 9) * 1024 + 512 + (i & 511)] = 0;
#elif defined(DBG_NO_GDNC)
#else
        for (int wi = blockIdx.x * 8 + w; wi < 8192; wi += gridDim.x * 8) gdn_c_witem(p, wi, REP != 0);
#endif
#ifdef DBG_NO_FOX
        for (size_t i = (size_t)blockIdx.x * NTHR + tidx(); i < (size_t)NT * 512; i += (size_t)gridDim.x * NTHR) ((bfraw*)(p.ws + O_YCAT))[(i >> 9) * 1024 + (i & 511)] = 0;
#endif
    } else if constexpr (P == 6 || P == 18) {
        constexpr int L = (P == 6) ? 0 : 1;
        phase_outproj(p, smem, L, ctrs + 512 + ((P == 6 ? 6 : 7) * 3 + REP) * 8);
        phase_moe_convert(p, smem, L);
    } else if constexpr (P == 7 || P == 19) {
        phase_router(p, smem, (P == 7) ? 0 : 1, REP != 0);
    } else if constexpr (P == 8 || P == 11 || P == 20 || P == 23) {
        phase_moe1(p, smem, P >= 20 ? 1 : 0, (P == 8 || P == 20) ? 0 : 1);
        if constexpr (P == 11 || P == 23) { if (REP == 0) phase_combine(p, P >= 20 ? 1 : 0, 0, P < 20, false); }
    } else if constexpr (P == 9 || P == 12 || P == 21 || P == 24) {
        phase_moe2(p, smem, P >= 20 ? 1 : 0, (P == 9 || P == 21) ? 0 : 1);
    } else if constexpr (P == 10 || P == 13 || P == 22 || P == 25) {
        if constexpr (P == 13 || P == 25) phase_combine(p, P >= 20 ? 1 : 0, 1, P < 20, REP != 0);
    }
#ifdef HAVE_L1
    else if constexpr (P == 14) {
        phase_inproj1(p, smem, ctrs + 512 + (14 * 3 + REP) * 8);
    } else if constexpr (P == 15) {
        for (int it = blockIdx.x; it < 128 + 2048; it += gridDim.x) { if (it < 128) nsa_compress_item(p, smem, it); else gla_a_item(p, smem, it - 128); }
    } else if constexpr (P == 16) {
        for (;;) {
            const int it = q_pop(&ctrs[REP ? 8 + REP : 1], smem);
            if (it >= 128 + 1024) break;
            if (REP && it < 128) continue;
            if (it < 128) gla_scan_item(p, it);
            else { const int f = it - 128; nsa_item2(p, smem, (f & 3) * 256 + 255 - (f >> 2)); }
        }
    } else if constexpr (P == 17) {
        const int w = tidx() >> 6;
        for (int wi = blockIdx.x * 8 + w; wi < 8192; wi += gridDim.x * 8) gla_c_witem(p, wi, REP != 0);
    }
#endif
}

template <int P, int PEND> DEV void run_range(const Params& p, char* smem, const XcdBarrier& bar) {
    constexpr bool kEmpty = (P == 10 || P == 22);
    if constexpr (!kEmpty) run_phase<P>(p, smem);
#ifdef REP_PHASE
    if constexpr (P == REP_PHASE) { xcd_barrier(bar); run_phase<P, 1>(p, smem); xcd_barrier(bar); run_phase<P, 2>(p, smem); }
#endif
    if constexpr (P + 1 < PEND) { if constexpr (!kEmpty) xcd_barrier(bar); run_range<P + 1, PEND>(p, smem, bar); }
}

#ifndef NPHASE
#define NPHASE 14
#endif

template <int P0, int P1>
__global__ void __launch_bounds__(512, 2) mk_kernel(Params p) {
    extern __shared__ __attribute__((aligned(16))) char smem[];
    if (tidx() == 0) *(uint4*)(smem + SM_BARW) = make_uint4(0u, 0u, 0u, 0u);
    __syncthreads();
    XcdBarrier bar = xcd_barrier_post((unsigned*)(p.ws + O_BAR), (volatile LAS unsigned*)(smem + SM_BARW));
    run_range<P0, P1>(p, smem, bar);
}

#ifdef DBG_SANITIZE
__global__ void k_sanitize(float* o, size_t n) { for (size_t i = (size_t)blockIdx.x * blockDim.x + tidx(); i < n; i += (size_t)gridDim.x * blockDim.x) { const float v = o[i]; if (!(fabsf(v) < 1e30f)) o[i] = 0.f; } }
#endif
template <int P> static void launch_one(const Params& p, int grid, hipStream_t stream) {
    hipFuncSetAttribute((const void*)mk_kernel<P, P + 1>, hipFuncAttributeMaxDynamicSharedMemorySize, SMEM_BYTES);
    mk_kernel<P, P + 1><<<grid, NTHR, SMEM_BYTES, stream>>>(p);
}
template <int P, int PEND> static void launch_seq(const Params& p, int grid, hipStream_t stream) {
    launch_one<P>(p, grid, stream);
    if constexpr (P + 1 < PEND) launch_seq<P + 1, PEND>(p, grid, stream);
}

extern "C" void kernel_launch(void* const* d_in, const int* in_sizes, int n_in, void* d_out, int out_size, void* d_ws, size_t ws_size, hipStream_t stream) {
    if (ws_size < WS_NEED || n_in < N_IN) return;
    Params p{};
    for (int i = 0; i < N_IN; ++i) p.in[i] = (const float*)d_in[i];
    p.out = (float*)d_out;
    p.ws = (char*)d_ws;
    hipMemsetAsync(d_ws, 0, ZERO_BYTES, stream);
#ifdef MULTI_LAUNCH
    launch_seq<0, NPHASE>(p, 256, stream);
#ifdef DBG_SANITIZE
    k_sanitize<<<1024, 256, 0, stream>>>(p.out, (size_t)NT * 1024);
#endif
#else
    static int grid = 0;
    if (!grid) {
        hipFuncSetAttribute((const void*)mk_kernel<0, NPHASE>, hipFuncAttributeMaxDynamicSharedMemorySize, SMEM_BYTES);
        int dev = 0, cus = 0, per_cu = 0;
        hipGetDevice(&dev);
        hipDeviceGetAttribute(&cus, hipDeviceAttributeMultiprocessorCount, dev);
        hipOccupancyMaxActiveBlocksPerMultiprocessor(&per_cu, (const void*)mk_kernel<0, NPHASE>, NTHR, SMEM_BYTES);
        grid = per_cu >= 1 ? cus : 0;
    }
    if (grid) mk_kernel<0, NPHASE><<<grid, NTHR, SMEM_BYTES, stream>>>(p);
#endif
}
```

```cpp
#define NPHASE 26
#include <hip/hip_runtime.h>
#include <stdint.h>

typedef unsigned short bfraw;
typedef __attribute__((ext_vector_type(8))) short bf16x8;
typedef __attribute__((ext_vector_type(4))) float f32x4;
#define DEV __device__ __forceinline__
#define LAS __attribute__((address_space(3)))

constexpr int NT = 32768, TT = 16384, DM = 1024;
constexpr float EPSF = 1e-6f;
constexpr float LOG2E = 1.4426950408889634f;
constexpr int NTHR = 512;
constexpr int SMEM_BYTES = 148480;

enum { I_X = 0, I_C, I_ADAW, I_ADAB, I_NMIX, I_NFFN, I_RELB, I_EVWIN, I_EVWOUT, I_FOXFB, I_FOXQN, I_FOXKN, I_GCONV, I_GALOG,
       I_GDTB, I_GON, I_ODWIN, I_ODWOUT, I_NSAQN, I_NSAKN, I_NSAPOS, I_CW1, I_CW2, I_GLAWG, I_GLABG, I_GLAON, I_ROUTER,
       I_MBIAS, I_MWG, I_MWU, I_MWD, I_SWG, I_SWU, I_SWD, N_IN };

struct Params {
    const float* in[N_IN];
    float* out;
    char* ws;
};

constexpr size_t MiB = 1048576;
constexpr size_t O_BAR = 0;
constexpr size_t O_CNT = 16384;
constexpr size_t O_MOD = 32768;
constexpr size_t ZERO_BYTES = 262144;
constexpr int NIN0 = 3840, NIN1 = 3072;
constexpr size_t O_WIN0 = ZERO_BYTES;
constexpr size_t O_WOUT0 = O_WIN0 + (size_t)NIN0 * 1024 * 2;
constexpr size_t O_WIN1 = O_WOUT0 + (size_t)1024 * 1024 * 2;
constexpr size_t O_WOUT1 = O_WIN1 + (size_t)NIN1 * 1024 * 2;
constexpr size_t O_WRT = O_WOUT1 + (size_t)1024 * 1024 * 2;
constexpr size_t O_W1T = O_WRT + (size_t)2 * 128 * 1024 * 2;
constexpr size_t O_W2T = O_W1T + (size_t)2 * 256 * 2048 * 2;
constexpr size_t O_BIAS1 = O_W2T + (size_t)2 * 64 * 256 * 2;
constexpr size_t O_PAIRW = O_BIAS1 + 4096;
constexpr size_t O_PLIST = O_PAIRW + (size_t)NT * 6 * 4;
constexpr size_t O_HBUF = O_PLIST + (size_t)2 * 64 * 16384 * 4;
constexpr size_t O_YCAT = O_HBUF + (size_t)NT * 1024 * 2;
constexpr size_t O_R = O_YCAT + (size_t)NT * 1024 * 2;
constexpr size_t O_WGU = O_R;
constexpr size_t O_WD = O_WGU + (size_t)65 * 512 * 1024 * 2;
constexpr size_t O_R2 = O_WD + (size_t)65 * 1024 * 256 * 2;
constexpr int HROWS = 98304 + 64 * 256 + 16384;
constexpr size_t O_H = O_R2;
constexpr size_t O_Y = O_H + (size_t)HROWS * 256 * 2;
constexpr size_t O_END_MOE = O_Y + (size_t)16384 * 7 * 1024 * 2;
constexpr size_t O_QF = O_R;
constexpr size_t O_KF = O_QF + (size_t)NT * 512 * 2;
constexpr size_t O_VFT = O_KF + (size_t)NT * 512 * 2;
constexpr size_t O_G0 = O_VFT + (size_t)NT * 512 * 2;
constexpr size_t O_GZ = O_G0 + (size_t)NT * 1536 * 2;
constexpr size_t O_SM0 = O_GZ + (size_t)NT * 512 * 2;
constexpr size_t O_CUMF = O_SM0 + (size_t)NT * 16 * 4;
constexpr size_t O_MBUF = O_CUMF + (size_t)16 * TT * 4;
constexpr size_t O_NS = O_MBUF + (size_t)2048 * 128 * 128 * 2;
constexpr size_t O_SB = O_NS + (size_t)2048 * 128 * 128 * 2;
constexpr size_t O_END_L0 = O_SB + (size_t)2048 * 128 * 128 * 2;
constexpr size_t O_QEFF = O_HBUF;
constexpr size_t O_QN = O_R2;
constexpr size_t O_KCR = O_QN + (size_t)NT * 512 * 2;
constexpr size_t O_VCR = O_KCR + (size_t)NT * 128 * 2;
constexpr size_t O_KS = O_VCR + (size_t)NT * 128 * 2;
constexpr size_t O_VST = O_KS + (size_t)NT * 128 * 2;
constexpr size_t O_KW = O_VST + (size_t)NT * 128 * 2;
constexpr size_t O_VWT = O_KW + (size_t)NT * 128 * 2;
constexpr size_t O_LQ = O_VWT + (size_t)NT * 128 * 2;
constexpr size_t O_LK = O_LQ + (size_t)NT * 256 * 2;
constexpr size_t O_LV = O_LK + (size_t)NT * 256 * 2;
constexpr size_t O_LR = O_LV + (size_t)NT * 512 * 2;
constexpr size_t O_SM1 = O_LR + (size_t)NT * 512 * 2;
constexpr size_t O_KCMP = O_SM1 + (size_t)NT * 40 * 4;
constexpr size_t O_VCMPT = O_KCMP + (size_t)4 * 1024 * 64 * 2;
constexpr size_t O_QD = O_VCMPT + (size_t)4 * 1024 * 64 * 2;
constexpr size_t O_AN = O_QD + (size_t)2048 * 64 * 64 * 2;
constexpr size_t O_ST = O_AN + (size_t)2048 * 64 * 4;
constexpr size_t O_END_L1 = O_ST + (size_t)2048 * 128 * 64 * 4;
constexpr size_t WS_NEED = (O_END_MOE > O_END_L0 ? (O_END_MOE > O_END_L1 ? O_END_MOE : O_END_L1) : (O_END_L0 > O_END_L1 ? O_END_L0 : O_END_L1));
static_assert(WS_NEED < (size_t)600 * MiB, "workspace too large");

DEV int tidx() { int t = threadIdx.x; asm volatile("" : "+v"(t)); return t; }
typedef __bf16 bf2_t __attribute__((ext_vector_type(2)));
typedef float f2_t __attribute__((ext_vector_type(2)));
DEV bfraw f2bf(float f) { return __builtin_bit_cast(bfraw, (__bf16)f); }
DEV float bf2f(bfraw b) { return __uint_as_float(((uint32_t)b) << 16); }
DEV uint32_t pack2(float lo, float hi) { f2_t f = {lo, hi}; return __builtin_bit_cast(uint32_t, __builtin_convertvector(f, bf2_t)); }
DEV float lo2f(uint32_t u) { return __uint_as_float(u << 16); }
DEV float hi2f(uint32_t u) { return __uint_as_float(u & 0xffff0000u); }
DEV f32x4 mfma16(bf16x8 a, bf16x8 b, f32x4 c) { return __builtin_amdgcn_mfma_f32_16x16x32_bf16(a, b, c, 0, 0, 0); }
DEV float sigmoidf_(float x) { return 1.f / (1.f + __expf(-x)); }
DEV float siluf_(float x) { return x / (1.f + __expf(-x)); }
DEV float softplusf_(float x) { return fmaxf(x, 0.f) + log1pf(__expf(-fabsf(x))); }
DEV float logsigmoidf_(float x) { return fminf(x, 0.f) - log1pf(__expf(-fabsf(x))); }
DEV float ex2(float x) { return __builtin_amdgcn_exp2f(x); }
DEV void vm_drain() { asm volatile("s_waitcnt vmcnt(0)" ::: "memory"); }
DEV void lds_barrier() { asm volatile("s_waitcnt lgkmcnt(0)" ::: "memory"); __builtin_amdgcn_s_barrier(); asm volatile("" ::: "memory"); }
DEV void block_sync_mem() { asm volatile("s_waitcnt vmcnt(0) lgkmcnt(0)" ::: "memory"); __syncthreads(); }
union U4 { uint4 u; bf16x8 v; uint32_t w[4]; };
union U2 { uint2 u; uint32_t w[2]; };
DEV bf16x8 ld8(const bfraw* p) { U4 t; t.u = *(const uint4*)p; return t.v; }
DEV bf16x8 ld4x2(const bfraw* p0, const bfraw* p1) { U4 t; uint2 a = *(const uint2*)p0, b = *(const uint2*)p1; t.w[0] = a.x; t.w[1] = a.y; t.w[2] = b.x; t.w[3] = b.y; return t.v; }
DEV bf16x8 pack8(float a0, float a1, float a2, float a3, float a4, float a5, float a6, float a7) {
    U4 t; t.w[0] = pack2(a0, a1); t.w[1] = pack2(a2, a3); t.w[2] = pack2(a4, a5); t.w[3] = pack2(a6, a7); return t.v; }
DEV void st4bf(bfraw* p, float a, float b, float c, float d) { uint2 v; v.x = pack2(a, b); v.y = pack2(c, d); *(uint2*)p = v; }
DEV float shx(float v, int m) { const int l = tidx(); return __int_as_float(__builtin_amdgcn_ds_bpermute(((l ^ m) & 63) << 2, __float_as_int(v))); }
DEV float wave_sum(float v) { for (int m = 32; m >= 1; m >>= 1) v += shx(v, m); return v; }
DEV float wave_max(float v) { for (int m = 32; m >= 1; m >>= 1) v = fmaxf(v, shx(v, m)); return v; }
DEV float grp16_sum(float v) { v += shx(v, 1); v += shx(v, 2); v += shx(v, 4); v += shx(v, 8); return v; }
DEV float grpx_sum(float v) { v += shx(v, 16); v += shx(v, 32); return v; }

#define XB_TMO      128
#define XB_XCNT(j)  (256  + 64 * (j))
#define XB_XSUB(j)  (1280 + 64 * (j))
#define XB_XGEN(j)  (2304 + 64 * (j))
#define XB_TOP      3328
#define XB_TOPGEN   3392
#define XCD_BAR_WORDS 3456
#define XB_SPIN_CAP (1u << 27)
DEV unsigned xb_ld(unsigned* p)              { return __hip_atomic_load(p, __ATOMIC_RELAXED, __HIP_MEMORY_SCOPE_AGENT); }
DEV unsigned xb_add(unsigned* p, unsigned v) { return __hip_atomic_fetch_add(p, v, __ATOMIC_RELAXED, __HIP_MEMORY_SCOPE_AGENT); }
DEV unsigned xb_xcc_id() { return (unsigned)__builtin_amdgcn_s_getreg((3 << 11) | 20) & 0xFu; }
#define XB_SPIN(cond, bar) do { unsigned _sp = 0; while (cond) { __builtin_amdgcn_s_sleep(1); \
    if ((++_sp & 255u) == 0u) { if (xb_ld(&(bar)[XB_TMO])) break; if (_sp > XB_SPIN_CAP) { atomicAdd(&(bar)[XB_TMO], 1u); break; } } } } while (0)
struct XcdBarrier { unsigned* bar; unsigned x; volatile LAS unsigned* st; };
DEV XcdBarrier xcd_barrier_post(unsigned* bar, volatile LAS unsigned* st) {
    XcdBarrier b; b.bar = bar; b.x = xb_xcc_id(); b.st = st;
    if (tidx() == 0) (void)xb_add(&bar[XB_XCNT(b.x)], 1u);
    return b;
}
DEV void xcd_barrier_complete(unsigned* bar, unsigned x, unsigned& nloc, unsigned& nx) {
    const unsigned G = gridDim.x * gridDim.y * gridDim.z;
    unsigned sum, cnt, mine, sp = 0u;
    for (;;) {
        sum = 0u; cnt = 0u; mine = 0u;
#pragma unroll
        for (unsigned j = 0; j < 16; ++j) { const unsigned c = xb_ld(&bar[XB_XCNT(j)]); sum += c; cnt += (c > 0u) ? 1u : 0u; mine = (j == x) ? c : mine; }
        if (sum == G) break;
        __builtin_amdgcn_s_sleep(1);
        if ((++sp & 255u) == 0u) { if (xb_ld(&bar[XB_TMO])) break; if (sp > XB_SPIN_CAP) { atomicAdd(&bar[XB_TMO], 1u); break; } }
    }
    nloc = mine > 0u ? mine : 1u; nx = cnt > 0u ? cnt : 1u;
}
DEV void xcd_barrier(const XcdBarrier& b) {
    asm volatile("s_waitcnt vmcnt(0)" ::: "memory");
    __syncthreads();
    if (tidx() == 0) {
        unsigned* bar = b.bar;
        __builtin_amdgcn_s_waitcnt(0);
        unsigned nloc = b.st[0], nx = b.st[1];
        if (nloc == 0u) { xcd_barrier_complete(bar, b.x, nloc, nx); b.st[0] = nloc; b.st[1] = nx; }
        const unsigned old = xb_add(&bar[XB_XSUB(b.x)], 1u);
        const unsigned gen = old / nloc;
        if (old + 1u == (gen + 1u) * nloc) {
            __builtin_amdgcn_fence(__ATOMIC_RELEASE, "agent");
            asm volatile("s_waitcnt vmcnt(0)" ::: "memory");
            const unsigned og = xb_add(&bar[XB_TOP], 1u);
            const unsigned tg = og / nx;
            if (og + 1u == (tg + 1u) * nx) xb_add(&bar[XB_TOPGEN], 1u);
            else XB_SPIN(xb_ld(&bar[XB_TOPGEN]) == tg, bar);
            __builtin_amdgcn_fence(__ATOMIC_ACQUIRE, "agent");
            xb_add(&bar[XB_XGEN(b.x)], 1u);
            asm volatile("s_waitcnt vmcnt(0)" ::: "memory");
        } else {
            XB_SPIN(xb_ld(&bar[XB_XGEN(b.x)]) == gen, bar);
            __builtin_amdgcn_fence(__ATOMIC_ACQUIRE, "agent");
            asm volatile("s_waitcnt vmcnt(0)" ::: "memory");
        }
    }
    __syncthreads();
}

template <class AP, class BP, class EPI>
DEV void gemm_tile(char* smem, int nk, int a_kstep, AP aptr, BP bptr, EPI epi) {
    bfraw* As = (bfraw*)smem; bfraw* Bs = As + 256 * 72;
    const int tid = tidx(), lane = tid & 63, w = tid >> 6, wr = w >> 1, wc = w & 1;
    const int seg = tid & 7, r0 = tid >> 3;
    const bfraw* pa[4]; const bfraw* pb[2];
#pragma unroll
    for (int i = 0; i < 4; ++i) pa[i] = aptr(r0 + 64 * i) + seg * 8;
#pragma unroll
    for (int i = 0; i < 2; ++i) pb[i] = bptr(r0 + 64 * i) + seg * 8;
    uint4 ra0 = *(const uint4*)pa[0], ra1 = *(const uint4*)pa[1], ra2 = *(const uint4*)pa[2], ra3 = *(const uint4*)pa[3];
    uint4 rb0 = *(const uint4*)pb[0], rb1 = *(const uint4*)pb[1];
    f32x4 acc[4][4];
#pragma unroll
    for (int i = 0; i < 4; ++i)
#pragma unroll
        for (int j = 0; j < 4; ++j) acc[i][j] = f32x4{0.f, 0.f, 0.f, 0.f};
    for (int kt = 0; kt < nk; ++kt) {
        __syncthreads();
        *(uint4*)&As[(r0) * 72 + seg * 8] = ra0;
        *(uint4*)&As[(r0 + 64) * 72 + seg * 8] = ra1;
        *(uint4*)&As[(r0 + 128) * 72 + seg * 8] = ra2;
        *(uint4*)&As[(r0 + 192) * 72 + seg * 8] = ra3;
        *(uint4*)&Bs[(r0) * 72 + seg * 8] = rb0;
        *(uint4*)&Bs[(r0 + 64) * 72 + seg * 8] = rb1;
        __syncthreads();
        if (kt + 1 < nk) {
            const size_t ao = (size_t)(kt + 1) * a_kstep, bo = (size_t)(kt + 1) * 64;
            ra0 = *(const uint4*)(pa[0] + ao); ra1 = *(const uint4*)(pa[1] + ao); ra2 = *(const uint4*)(pa[2] + ao); ra3 = *(const uint4*)(pa[3] + ao);
            rb0 = *(const uint4*)(pb[0] + bo); rb1 = *(const uint4*)(pb[1] + bo);
        }
#pragma unroll
        for (int ks = 0; ks < 2; ++ks) {
            bf16x8 af[4], bfr[4];
#pragma unroll
            for (int i = 0; i < 4; ++i) af[i] = ld8(&As[(wr * 64 + i * 16 + (lane & 15)) * 72 + ks * 32 + (lane >> 4) * 8]);
#pragma unroll
            for (int j = 0; j < 4; ++j) bfr[j] = ld8(&Bs[(wc * 64 + j * 16 + (lane & 15)) * 72 + ks * 32 + (lane >> 4) * 8]);
#pragma unroll
            for (int i = 0; i < 4; ++i)
#pragma unroll
                for (int j = 0; j < 4; ++j) acc[i][j] = mfma16(af[i], bfr[j], acc[i][j]);
        }
    }
    epi(acc, wr * 64, wc * 64, lane);
}

constexpr int GLD = 72;
constexpr int GBUF = 512 * GLD;
template <bool AFFA = true, bool SGB = true, class AP, class BP, class EPI>
DEV void gemm_tile2(char* smem, int nk, int a_kstep, AP aptr, BP bptr, EPI epi) {
    bfraw* As = (bfraw*)smem;
    const int tid = tidx(), lane = tid & 63, w = tid >> 6, wr = w >> 2, wc = w & 3;
    const int seg = tid & 7, r0 = tid >> 3;
    const bfraw* pa0 = aptr(r0) + seg * 8;
    const int ast = (int)(aptr(r0 + 64) - aptr(r0));
    const bfraw* pa1 = AFFA ? pa0 + ast : aptr(r0 + 64) + seg * 8; const bfraw* pa2 = AFFA ? pa0 + 2 * ast : aptr(r0 + 128) + seg * 8; const bfraw* pa3 = AFFA ? pa0 + 3 * ast : aptr(r0 + 192) + seg * 8;
    const bfraw* pb0 = bptr(r0) + seg * 8;
    const int bst = (int)(bptr(r0 + 64) - bptr(r0));
    uint4 ra0 = *(const uint4*)pa0, ra1 = *(const uint4*)pa1, ra2 = *(const uint4*)pa2, ra3 = *(const uint4*)pa3;
    uint4 rb0 = *(const uint4*)pb0, rb1 = *(const uint4*)(pb0 + bst), rb2 = *(const uint4*)(pb0 + 2 * bst), rb3 = *(const uint4*)(pb0 + 3 * bst);
    f32x4 acc[8][4];
#pragma unroll
    for (int i = 0; i < 8; ++i)
#pragma unroll
        for (int j = 0; j < 4; ++j) acc[i][j] = f32x4{0.f, 0.f, 0.f, 0.f};
    const int so = r0 * GLD + seg * 8;
    const int fo = (lane & 15) * GLD + (lane >> 4) * 8;
    lds_barrier();
    {
        bfraw* Aw = As + so;
        *(uint4*)&Aw[0] = ra0; *(uint4*)&Aw[64 * GLD] = ra1; *(uint4*)&Aw[128 * GLD] = ra2; *(uint4*)&Aw[192 * GLD] = ra3;
        *(uint4*)&Aw[256 * GLD] = rb0; *(uint4*)&Aw[320 * GLD] = rb1; *(uint4*)&Aw[384 * GLD] = rb2; *(uint4*)&Aw[448 * GLD] = rb3;
        const size_t ao = (size_t)a_kstep, bo = 64;
        __builtin_amdgcn_sched_barrier(0);
        ra0 = *(const uint4*)(pa0 + ao); __builtin_amdgcn_sched_barrier(0); rb0 = *(const uint4*)(pb0 + bo); __builtin_amdgcn_sched_barrier(0);
        ra1 = *(const uint4*)(pa1 + ao); __builtin_amdgcn_sched_barrier(0); rb1 = *(const uint4*)(pb0 + (bst + bo)); __builtin_amdgcn_sched_barrier(0);
        ra2 = *(const uint4*)(pa2 + ao); __builtin_amdgcn_sched_barrier(0); rb2 = *(const uint4*)(pb0 + (2 * bst + bo)); __builtin_amdgcn_sched_barrier(0);
        ra3 = *(const uint4*)(pa3 + ao); __builtin_amdgcn_sched_barrier(0); rb3 = *(const uint4*)(pb0 + (3 * bst + bo)); __builtin_amdgcn_sched_barrier(0);
    }
#define GT_WL(i, W, L)                                                                                                               \
    if (W) {                                                                                                                         \
        if (i == 0) { *(uint4*)&Aw[0] = ra0; if (L) ra0 = *(const uint4*)(pa0 + ao); }                                               \
        if (i == 1) { *(uint4*)&Aw[256 * GLD] = rb0; if (L) rb0 = *(const uint4*)(pb0 + bo); }                                       \
        if (i == 2) { *(uint4*)&Aw[64 * GLD] = ra1; if (L) ra1 = *(const uint4*)(pa1 + ao); }                                        \
        if (i == 3) { *(uint4*)&Aw[320 * GLD] = rb1; if (L) rb1 = *(const uint4*)(pb0 + (bst + bo)); }                               \
        if (i == 4) { *(uint4*)&Aw[128 * GLD] = ra2; if (L) ra2 = *(const uint4*)(pa2 + ao); }                                       \
        if (i == 5) { *(uint4*)&Aw[384 * GLD] = rb2; if (L) rb2 = *(const uint4*)(pb0 + (2 * bst + bo)); }                           \
        if (i == 6) { *(uint4*)&Aw[192 * GLD] = ra3; if (L) ra3 = *(const uint4*)(pa3 + ao); }                                       \
        if (i == 7) { *(uint4*)&Aw[448 * GLD] = rb3; if (L) rb3 = *(const uint4*)(pb0 + (3 * bst + bo)); }                           \
    }
#define GT_BODY(W, L)                                                                                                                \
    {                                                                                                                                \
        lds_barrier();                                                                                                               \
        const int cur = kt & 1;                                                                                                      \
        const bfraw* Ac = As + cur * GBUF + fo;                                                                                      \
        bfraw* Aw = As + (cur ^ 1) * GBUF + so;                                                                                      \
        const size_t ao = (size_t)(kt + 2) * a_kstep, bo = (size_t)(kt + 2) * 64;                                                    \
        _Pragma("unroll") for (int ks = 0; ks < 2; ++ks) {                                                                           \
            const bfraw* Ab = Ac + (wr * 128) * GLD + ks * 32;                                                                       \
            const bfraw* Bb = Ac + (256 + wc * 64) * GLD + ks * 32;                                                                  \
            bf16x8 bfr[4], af[8];                                                                                                    \
            _Pragma("unroll") for (int j = 0; j < 4; ++j) bfr[j] = ld8(Bb + j * 16 * GLD);                                           \
            af[0] = ld8(Ab); af[1] = ld8(Ab + 16 * GLD);                                                                             \
            _Pragma("unroll") for (int i = 0; i < 8; ++i) {                                                                          \
                _Pragma("unroll") for (int j = 0; j < 4; ++j) acc[i][j] = mfma16(bfr[j], af[i], acc[i][j]);                          \
                if (i + 2 < 8) af[i + 2] = ld8(Ab + (i + 2) * 16 * GLD);                                                             \
                if (ks == 1) { GT_WL(i, W, L) }                                                                                      \
            }                                                                                                                        \
            if (SGB) {                                                                                                               \
                __builtin_amdgcn_sched_group_barrier(0x100, 6, 0);                                                                   \
                _Pragma("unroll") for (int i = 0; i < 8; ++i) {                                                                      \
                    __builtin_amdgcn_sched_group_barrier(0x008, 4, 0);                                                               \
                    if (i + 2 < 8) __builtin_amdgcn_sched_group_barrier(0x100, 1, 0);                                                \
                    if (ks == 1 && W) __builtin_amdgcn_sched_group_barrier(0x200, 1, 0);                                             \
                    if (ks == 1 && W && L) __builtin_amdgcn_sched_group_barrier(0x020, 1, 0);                                        \
                }                                                                                                                    \
            }                                                                                                                        \
        }                                                                                                                            \
    }
    int kt = 0;
    for (; kt + 2 < nk; ++kt) GT_BODY(1, 1)
    GT_BODY(1, 0)
    ++kt;
    GT_BODY(0, 0)
#undef GT_BODY
#undef GT_WL
    epi(acc, wr * 128, wc * 64, lane);
}

DEV bool xq_next(unsigned* q, int nN, char* smem, int& mt, int& nt) {
    int* slot = (int*)(smem + 148000);
    __syncthreads();
    if (tidx() == 0) {
        const int T = 16 * nN, x0 = (int)xb_xcc_id() & 7;
        int res = -1;
        for (int k = 0; k < 8 && res < 0; ++k) {
            const int x = (x0 + k) & 7;
            if (xb_ld(&q[x]) < (unsigned)T) { const unsigned s = atomicAdd(&q[x], 1u); if (s < (unsigned)T) res = x * T + (int)s; }
        }
        *slot = res;
    }
    __syncthreads();
    const int res = *slot;
    if (res < 0) return false;
    const int T = 16 * nN, x = res / T, s = res % T, mg = s / (4 * nN), rem = s % (4 * nN);
    nt = rem >> 2; mt = x * 16 + mg * 4 + (rem & 3);
    return true;
}

DEV bool xs_tile(int nN, int rr, int& mt, int& nt) {
    const int T = 16 * nN;
    int G = (int)gridDim.x, bid = (int)blockIdx.x;
    asm volatile("" : "+s"(G), "+s"(bid));
    int gidx;
    if ((G & 7) == 0) { const int bpx = G >> 3, s = (bid >> 3) + bpx * rr; if (s >= T) return false; gidx = (bid & 7) * T + s; }
    else { gidx = bid + G * rr; if (gidx >= 8 * T) return false; }
    const int x = gidx / T, s = gidx % T, mg = s / (4 * nN), rem = s % (4 * nN);
    nt = __builtin_amdgcn_readfirstlane(rem >> 2); mt = __builtin_amdgcn_readfirstlane(x * 16 + mg * 4 + (rem & 3));
    return true;
}

template <class CM>
DEV void tr_tile_w(float* tl, const float* src, size_t ldsrc, bfraw* dst, size_t lddst, int k0, int n0, CM cmap) {
    const int lane = tidx() & 63;
    const int c4 = (lane & 15) * 4, r = lane >> 4;
    const int sc = cmap(n0 + c4);
    float4 v[16];
#pragma unroll
    for (int ps = 0; ps < 16; ++ps) v[ps] = sc >= 0 ? *(const float4*)(src + (size_t)(k0 + ps * 4 + r) * ldsrc + sc) : make_float4(0.f, 0.f, 0.f, 0.f);
#pragma unroll
    for (int ps = 0; ps < 16; ++ps) *(float4*)&tl[(ps * 4 + r) * 68 + c4] = v[ps];
    const int n = lane;
#pragma unroll
    for (int ks = 0; ks < 8; ++ks) {
        float q[8];
#pragma unroll
        for (int j = 0; j < 8; ++j) q[j] = tl[(ks * 8 + j) * 68 + n];
        uint4 o; o.x = pack2(q[0], q[1]); o.y = pack2(q[2], q[3]); o.z = pack2(q[4], q[5]); o.w = pack2(q[6], q[7]);
        *(uint4*)&dst[(size_t)(n0 + n) * lddst + k0 + ks * 8] = o;
    }
}
template <class CM>
DEV void tr_tile(char* smem, const float* src, size_t ldsrc, bfraw* dst, size_t lddst, int k0, int n0, CM cmap) {
    float* tl = (float*)smem;
    const int tid = tidx();
    {
        const int c = tid & 63, r = tid >> 6;
        const int sc = cmap(n0 + c);
#pragma unroll
        for (int ps = 0; ps < 8; ++ps) {
            const int k = ps * 8 + r;
            tl[k * 65 + c] = sc >= 0 ? src[(size_t)(k0 + k) * ldsrc + sc] : 0.f;
        }
    }
    __syncthreads();
    {
        const int n = tid >> 3, ks = tid & 7;
        float v[8];
#pragma unroll
        for (int q = 0; q < 8; ++q) v[q] = tl[(ks * 8 + q) * 65 + n];
        uint4 o; o.x = pack2(v[0], v[1]); o.y = pack2(v[2], v[3]); o.z = pack2(v[4], v[5]); o.w = pack2(v[6], v[7]);
        *(uint4*)&dst[(size_t)(n0 + n) * lddst + k0 + ks * 8] = o;
    }
    __syncthreads();
}
DEV int map_in0(int n) {
    if (n < 1536) return n;
    if (n < 3072) return 1544 + (n - 1536);
    if (n < 3584) return 3088 + (n - 3072);
    if (n < 3592) return 1536 + (n - 3584);
    if (n < 3596) return 3080 + (n - 3592);
    if (n < 3600) return 3084 + (n - 3596);
    return -1;
}
DEV int map_in1(int n) {
    if (n < 1280) return n;
    if (n < 1536) return 1304 + (n - 1280);
    if (n < 1792) return 1560 + (n - 1536);
    if (n < 2304) return 1816 + (n - 1792);
    if (n < 2816) return 2344 + (n - 2304);
    if (n < 2840) return 1280 + (n - 2816);
    if (n < 2856) return 2328 + (n - 2840);
    return -1;
}

DEV void prologue_item(const Params& p, char* smem, int item) {
    const int tid = tidx();
    {
        const int l = item / 96, nch = item % 96;
        const int n = nch * 64 + (tid & 63), kg = tid >> 6, k0 = kg * 128;
        const float* W = p.in[I_ADAW] + (size_t)l * 1024 * 6144;
        const float* c = p.in[I_C];
        float a0 = 0.f, a1 = 0.f;
#pragma unroll 8
        for (int k = 0; k < 128; ++k) {
            const float wv = W[(size_t)(k0 + k) * 6144 + n];
            a0 += siluf_(c[k0 + k]) * wv; a1 += siluf_(c[1024 + k0 + k]) * wv;
        }
        float* red = (float*)smem;
        __syncthreads();
        red[tid] = a0; red[512 + tid] = a1;
        __syncthreads();
        if (tid < 128) {
            const int bb = tid >> 6, nn = tid & 63;
            float sacc = p.in[I_ADAB][l * 6144 + nch * 64 + nn];
#pragma unroll
            for (int q = 0; q < 8; ++q) sacc += red[bb * 512 + q * 64 + nn];
            ((float*)(p.ws + O_MOD))[(l * 2 + bb) * 6144 + nch * 64 + nn] = sacc;
        }
        __syncthreads();
    }
}
constexpr int PRO_WITEMS = 960 + 256 + 768 + 256 + 64 + 256 + 8;
DEV void prologue_witem(const Params& p, float* tl, int item) {
    if (item < 960) { tr_tile_w(tl, p.in[I_EVWIN], 3600, (bfraw*)(p.ws + O_WIN0), 1024, (item % 16) * 64, (item / 16) * 64, [](int n) { return map_in0(n); }); return; }
    item -= 960;
    if (item < 256) { tr_tile_w(tl, p.in[I_EVWOUT], 1024, (bfraw*)(p.ws + O_WOUT0), 1024, (item % 16) * 64, (item / 16) * 64, [](int n) { return n; }); return; }
    item -= 256;
    if (item < 768) { tr_tile_w(tl, p.in[I_ODWIN], 2856, (bfraw*)(p.ws + O_WIN1), 1024, (item % 16) * 64, (item / 16) * 64, [](int n) { return map_in1(n); }); return; }
    item -= 768;
    if (item < 256) { tr_tile_w(tl, p.in[I_ODWOUT], 1024, (bfraw*)(p.ws + O_WOUT1), 1024, (item % 16) * 64, (item / 16) * 64, [](int n) { return n; }); return; }
    item -= 256;
    if (item < 64) {
        const int l = item / 32, rem = item % 32;
        tr_tile_w(tl, p.in[I_ROUTER] + (size_t)l * 1024 * 64, 64, (bfraw*)(p.ws + O_WRT) + (size_t)l * 128 * 1024, 1024, (rem % 16) * 64, (rem / 16) * 64, [](int n) { return n < 64 ? n : -1; });
        return;
    }
    item -= 64;
    if (item < 256) {
        const int wh = item / 128, rem = item % 128;
        tr_tile_w(tl, p.in[I_CW1] + (size_t)wh * 2048 * 256, 256, (bfraw*)(p.ws + O_W1T) + (size_t)wh * 256 * 2048, 2048, (rem % 32) * 64, (rem / 32) * 64, [](int n) { return n; });
        return;
    }
    item -= 256;
    { const int wh = item / 4, kt = item % 4;
      tr_tile_w(tl, p.in[I_CW2] + (size_t)wh * 256 * 64, 64, (bfraw*)(p.ws + O_W2T) + (size_t)wh * 64 * 256, 256, kt * 64, 0, [](int n) { return n; }); }
}
DEV void prologue_bias1(const Params& p, char* smem, int wh) {
    const int tid = tidx();
    const float* pos = p.in[I_NSAPOS] + wh * 2048;
    const float* w1 = p.in[I_CW1] + (size_t)wh * 2048 * 256;
    const int j = tid & 255, kh = tid >> 8;
    float a = 0.f;
    for (int kk = kh * 1024; kk < kh * 1024 + 1024; ++kk) a += pos[kk] * w1[(size_t)kk * 256 + j];
    float* red = (float*)smem;
    __syncthreads();
    if (kh == 1) red[j] = a;
    __syncthreads();
    if (kh == 0) ((float*)(p.ws + O_BIAS1))[wh * 256 + j] = a + red[j];
    __syncthreads();
}
DEV void phase_prologue(const Params& p, char* smem) {
    for (int it = blockIdx.x; it < 192 + 2; it += gridDim.x) { if (it < 192) prologue_item(p, smem, it); else prologue_bias1(p, smem, it - 192); }
    const int w = tidx() >> 6;
    float* tl = (float*)smem + w * (64 * 68);
    __syncthreads();
    for (int it = blockIdx.x * 8 + w; it < PRO_WITEMS; it += gridDim.x * 8) prologue_witem(p, tl, it);
    __syncthreads();
}

constexpr int MOECVT_ITEMS = 65 * 192;
DEV void moe_convert_witem(const Params& p, float* tl, int layer, int item) {
    const int e = item / 192, s = item % 192;
    bfraw* wgu = (bfraw*)(p.ws + O_WGU) + (size_t)e * 512 * 1024;
    bfraw* wd = (bfraw*)(p.ws + O_WD) + (size_t)e * 1024 * 256;
    const size_t eo = (size_t)(layer * 64 + e) * 1024 * 256, so = (size_t)layer * 1024 * 256;
    if (s < 64) {
        const float* src = e < 64 ? p.in[I_MWG] + eo : p.in[I_SWG] + so;
        tr_tile_w(tl, src, 256, wgu, 1024, (s % 16) * 64, (s / 16) * 64, [](int n) { return n; });
    } else if (s < 128) {
        const int s2 = s - 64;
        const float* src = e < 64 ? p.in[I_MWU] + eo : p.in[I_SWU] + so;
        tr_tile_w(tl, src, 256, wgu + (size_t)256 * 1024, 1024, (s2 % 16) * 64, (s2 / 16) * 64, [](int n) { return n; });
    } else {
        const int s2 = s - 128;
        const float* src = e < 64 ? p.in[I_MWD] + eo : p.in[I_SWD] + so;
        tr_tile_w(tl, src, 1024, wd, 256, (s2 % 4) * 64, (s2 / 4) * 64, [](int n) { return n; });
    }
}
DEV void phase_moe_convert(const Params& p, char* smem, int layer) {
    const int w = tidx() >> 6;
    float* tl = (float*)smem + w * (64 * 68);
    __syncthreads();
    for (int it = blockIdx.x * 8 + w; it < MOECVT_ITEMS; it += gridDim.x * 8) moe_convert_witem(p, tl, layer, it);
    __syncthreads();
}

DEV void norm_row(const float* xrow, const float* gain, const float* sc, const float* sh, bfraw* drow, int lane) {
    float4 v[4]; float ss = 0.f;
#pragma unroll
    for (int i = 0; i < 4; ++i) { v[i] = *(const float4*)(xrow + lane * 4 + 256 * i); ss += v[i].x * v[i].x + v[i].y * v[i].y + v[i].z * v[i].z + v[i].w * v[i].w; }
    ss = wave_sum(ss);
    const float rs = rsqrtf(ss * (1.f / 1024.f) + EPSF);
#pragma unroll
    for (int i = 0; i < 4; ++i) {
        const int c = lane * 4 + 256 * i;
        const float4 g = *(const float4*)(gain + c), s1 = *(const float4*)(sc + c), s0 = *(const float4*)(sh + c);
        st4bf(drow + c, v[i].x * rs * g.x * (1.f + s1.x) + s0.x, v[i].y * rs * g.y * (1.f + s1.y) + s0.y,
                        v[i].z * rs * g.z * (1.f + s1.z) + s0.z, v[i].w * rs * g.w * (1.f + s1.w) + s0.w);
    }
}
DEV const float* modp(const Params& p, int layer, int b, int chunk) { return (const float*)(p.ws + O_MOD) + (size_t)(layer * 2 + b) * 6144 + chunk * 1024; }

DEV void phase_norm1(const Params& p, const float* xsrc, int layer) {
    const int lane = tidx() & 63, w = tidx() >> 6;
    bfraw* hb = (bfraw*)(p.ws + O_HBUF);
    for (int row = blockIdx.x * 8 + w; row < NT; row += gridDim.x * 8) {
        const int b = row >> 14;
        norm_row(xsrc + (size_t)row * 1024, p.in[I_NMIX] + layer * 1024, modp(p, layer, b, 1), modp(p, layer, b, 0), hb + (size_t)row * 1024, lane);
    }
}

template <int NI>
DEV void epi2_headnorm(const f32x4 (&acc)[NI][4], int lane, const float* gain, float mul, bfraw* dst, size_t rstride) {
    const int c = lane & 15, g = lane >> 4;
    float4 gn[4];
#pragma unroll
    for (int j = 0; j < 4; ++j) { gn[j] = *(const float4*)(gain + j * 16 + 4 * g); gn[j].x *= mul; gn[j].y *= mul; gn[j].z *= mul; gn[j].w *= mul; }
#pragma unroll
    for (int i = 0; i < NI; ++i) {
        float ss = 0.f;
#pragma unroll
        for (int j = 0; j < 4; ++j) ss += acc[i][j][0] * acc[i][j][0] + acc[i][j][1] * acc[i][j][1] + acc[i][j][2] * acc[i][j][2] + acc[i][j][3] * acc[i][j][3];
        ss = grpx_sum(ss);
        const float rs = rsqrtf(ss * (1.f / 64.f) + EPSF);
        bfraw* d = dst + (size_t)(i * 16 + c) * rstride + 4 * g;
#pragma unroll
        for (int j = 0; j < 4; ++j) st4bf(d + j * 16, acc[i][j][0] * rs * gn[j].x, acc[i][j][1] * rs * gn[j].y, acc[i][j][2] * rs * gn[j].z, acc[i][j][3] * rs * gn[j].w);
    }
}
template <int NI>
DEV void epi2_store_bf16(const f32x4 (&acc)[NI][4], int lane, bfraw* dst, size_t rstride) {
    const int c = lane & 15, g = lane >> 4;
#pragma unroll
    for (int i = 0; i < NI; ++i) {
        bfraw* d = dst + (size_t)(i * 16 + c) * rstride + 4 * g;
#pragma unroll
        for (int j = 0; j < 4; ++j) st4bf(d + j * 16, acc[i][j][0], acc[i][j][1], acc[i][j][2], acc[i][j][3]);
    }
}
template <int NI>
DEV void epi2_store_T(const f32x4 (&acc)[NI][4], int lane, bfraw* dstT, size_t cstride) {
    const int c = lane & 15, g = lane >> 4;
#pragma unroll
    for (int i = 0; i < NI; ++i)
#pragma unroll
        for (int j = 0; j < 4; ++j)
#pragma unroll
            for (int r = 0; r < 4; ++r) dstT[(size_t)(j * 16 + 4 * g + r) * cstride + i * 16 + c] = f2bf(acc[i][j][r]);
}

DEV void phase_inproj0(const Params& p, char* smem, unsigned* xq) {
    const bfraw* A = (const bfraw*)(p.ws + O_HBUF);
    const bfraw* Bt = (const bfraw*)(p.ws + O_WIN0);
    constexpr int NTL = NIN0 / 256;
    for (int rr = 0;; ++rr) {
        int mt, nt;
        if (!xs_tile(NTL, rr, mt, nt)) break;
        const int m0 = __builtin_amdgcn_readfirstlane(mt * 256), n0 = __builtin_amdgcn_readfirstlane(nt * 256);
        gemm_tile2(smem, 16, 64,
            [&](int r) { return A + (size_t)(m0 + r) * 1024; },
            [&](int r) { return Bt + (size_t)(n0 + r) * 1024; },
            [&](const f32x4 (&acc)[8][4], int rb, int cbk, int lane) {
                const int cb = n0 + cbk;
                const int tok0 = m0 + rb;
                const int b = tok0 >> 14, t0 = tok0 & (TT - 1);
                if (cb < 512) {
                    const int hh = cb >> 6;
                    epi2_headnorm<8>(acc, lane, p.in[I_FOXQN], 0.125f * LOG2E, (bfraw*)(p.ws + O_QF) + ((size_t)(b * 8 + hh) * TT + t0) * 64, 64);
                } else if (cb < 1024) {
                    const int hh = (cb - 512) >> 6;
                    epi2_headnorm<8>(acc, lane, p.in[I_FOXKN], 1.f, (bfraw*)(p.ws + O_KF) + ((size_t)(b * 8 + hh) * TT + t0) * 64, 64);
                } else if (cb < 1536) {
                    const int hh = (cb - 1024) >> 6;
                    epi2_store_T<8>(acc, lane, (bfraw*)(p.ws + O_VFT) + (size_t)(b * 8 + hh) * 64 * TT + t0, TT);
                } else if (cb < 3072) {
                    epi2_store_bf16<8>(acc, lane, (bfraw*)(p.ws + O_G0) + (size_t)tok0 * 1536 + (cb - 1536), 1536);
                } else if (cb < 3584) {
                    epi2_store_bf16<8>(acc, lane, (bfraw*)(p.ws + O_GZ) + (size_t)tok0 * 512 + (cb - 3072), 512);
                } else if (cb == 3584) {
                    const int c = lane & 15, g = lane >> 4;
                    float* sm = (float*)(p.ws + O_SM0);
#pragma unroll
                    for (int i = 0; i < 8; ++i) *(float4*)&sm[(size_t)(tok0 + i * 16 + c) * 16 + 4 * g] = make_float4(acc[i][0][0], acc[i][0][1], acc[i][0][2], acc[i][0][3]);
                }
            });
    }
}

DEV void fox_cumsum_item(const Params& p, char* smem, int item) {
    const int b = item >> 3, h = item & 7, tid = tidx();
    const float* sm = (const float*)(p.ws + O_SM0);
    const float fb = p.in[I_FOXFB][h];
    float v[32]; float run = 0.f;
    const int tb = tid * 32;
#pragma unroll
    for (int i = 0; i < 32; ++i) { run += logsigmoidf_(sm[(size_t)(b * TT + tb + i) * 16 + h] + fb) * LOG2E; v[i] = run; }
    float* red = (float*)smem;
    __syncthreads();
    red[tid] = run;
    __syncthreads();
    if (tid < 64) {
        float s[8]; float a = 0.f;
#pragma unroll
        for (int i = 0; i < 8; ++i) { a += red[tid * 8 + i]; s[i] = a; }
        float incl = a;
        for (int m = 1; m < 64; m <<= 1) { const float o = __shfl_up(incl, m); if (tid >= m) incl += o; }
        const float excl = incl - a;
#pragma unroll
        for (int i = 0; i < 8; ++i) red[512 + tid * 8 + i] = excl + s[i] - red[tid * 8 + i];
    }
    __syncthreads();
    const float off = red[512 + tid];
    float* cf = (float*)(p.ws + O_CUMF) + (size_t)item * TT + tb;
#pragma unroll
    for (int i = 0; i < 32; ++i) cf[i] = v[i] + off;
    __syncthreads();
}
DEV void fox_item(const Params& p, int bh, int qb) {
    const int lane = tidx() & 63, w = tidx() >> 6, c = lane & 15, g = lane >> 4;
    const int b = bh >> 3, h = bh & 7;
    const bfraw* Q = (const bfraw*)(p.ws + O_QF) + (size_t)bh * TT * 64;
    const bfraw* K = (const bfraw*)(p.ws + O_KF) + (size_t)bh * TT * 64;
    const bfraw* VT = (const bfraw*)(p.ws + O_VFT) + (size_t)bh * 64 * TT;
    const float* cum = (const float*)(p.ws + O_CUMF) + (size_t)bh * TT;
    const float mq = wave_max(fabsf(p.in[I_FOXQN][lane])), mk = wave_max(fabsf(p.in[I_FOXKN][lane]));
    const float Mb2 = 8.f * mq * mk * LOG2E;
    const int q0w = qb * 256 + w * 32;
    int tq[2]; float cq[2]; bf16x8 qf[2][2]; f32x4 O[2][4]; float l[2];
#pragma unroll
    for (int cg = 0; cg < 2; ++cg) {
        tq[cg] = q0w + cg * 16 + c; cq[cg] = cum[tq[cg]] - Mb2; l[cg] = 0.f;
#pragma unroll
        for (int ks = 0; ks < 2; ++ks) qf[cg][ks] = ld8(Q + (size_t)tq[cg] * 64 + ks * 32 + g * 8);
#pragma unroll
        for (int dt = 0; dt < 4; ++dt) O[cg][dt] = f32x4{0.f, 0.f, 0.f, 0.f};
    }
    for (int kb = 0; kb <= q0w; kb += 32) {
        bf16x8 kf[2][2], vf[4]; float4 ck[2];
#pragma unroll
        for (int kt = 0; kt < 2; ++kt) {
#pragma unroll
            for (int ks = 0; ks < 2; ++ks) kf[kt][ks] = ld8(K + (size_t)(kb + kt * 16 + c) * 64 + ks * 32 + g * 8);
            ck[kt] = *(const float4*)(cum + kb + kt * 16 + 4 * g);
        }
#pragma unroll
        for (int dt = 0; dt < 4; ++dt) { const bfraw* vp = VT + (size_t)(dt * 16 + c) * TT + kb + 4 * g; vf[dt] = ld4x2(vp, vp + 16); }
        const bool diag = (kb == q0w);
#pragma unroll
        for (int cg = 0; cg < 2; ++cg) {
            float pr[2][4];
#pragma unroll
            for (int kt = 0; kt < 2; ++kt) {
                f32x4 S = mfma16(kf[kt][0], qf[cg][0], f32x4{0.f, 0.f, 0.f, 0.f});
                S = mfma16(kf[kt][1], qf[cg][1], S);
                const float ckv[4] = {ck[kt].x, ck[kt].y, ck[kt].z, ck[kt].w};
#pragma unroll
                for (int r = 0; r < 4; ++r) {
                    float e = ex2(S[r] + cq[cg] - ckv[r]);
                    if (diag && (kb + kt * 16 + 4 * g + r > tq[cg])) e = 0.f;
                    pr[kt][r] = e; l[cg] += e;
                }
            }
            const bf16x8 pb = pack8(pr[0][0], pr[0][1], pr[0][2], pr[0][3], pr[1][0], pr[1][1], pr[1][2], pr[1][3]);
#pragma unroll
            for (int dt = 0; dt < 4; ++dt) O[cg][dt] = mfma16(vf[dt], pb, O[cg][dt]);
        }
    }
    bfraw* yc = (bfraw*)(p.ws + O_YCAT);
#pragma unroll
    for (int cg = 0; cg < 2; ++cg) {
        const float inv = 1.f / grpx_sum(l[cg]);
        bfraw* d = yc + (size_t)(b * TT + tq[cg]) * 1024 + h * 64 + 4 * g;
#pragma unroll
        for (int dt = 0; dt < 4; ++dt) st4bf(d + dt * 16, O[cg][dt][0] * inv, O[cg][dt][1] * inv, O[cg][dt][2] * inv, O[cg][dt][3] * inv);
    }
}

constexpr int GA_XR = 0, GA_LM = 17408, GA_KB = 36864, GA_KDT = 54272, GA_ATT = 72704, GA_SM = 81920, GA_RHS = 83968, GA_RAW = 117760;
DEV float gdn_conv_at(const bfraw* G0, const float* cw, int b, int t, int col, float& x3, float& x2, float& x1) {
    const float x = bf2f(G0[(size_t)(b * TT + t) * 1536 + col]);
    const float y = cw[0 * 1536 + col] * x3 + cw[1 * 1536 + col] * x2 + cw[2 * 1536 + col] * x1 + cw[3 * 1536 + col] * x;
    x3 = x2; x2 = x1; x1 = x;
    return siluf_(y);
}
DEV int opaque_tid() { return tidx(); }
#define OPQ_TID() const int tid = opaque_tid(), lane = tid & 63, w = tid >> 6, c = lane & 15, g = lane >> 4; (void)lane; (void)w; (void)c; (void)g
DEV void gdn_a_item(const Params& p, char* smem, int item) {
    const int bh = item >> 8, n = item & 255, b = bh >> 2, h = bh & 3, t0 = n * 64;
    const bfraw* G0 = (const bfraw*)(p.ws + O_G0);
    const float* cw = p.in[I_GCONV];
    bfraw* qbuf = (bfraw*)(smem + GA_XR);
    float* Lm = (float*)(smem + GA_LM);
    bfraw* XT = (bfraw*)(smem + GA_XR);
    bfraw* kbuf = (bfraw*)(smem + GA_KB);
    bfraw* kdT = (bfraw*)(smem + GA_KDT);
    bfraw* att = (bfraw*)(smem + GA_ATT);
    float* gc = (float*)(smem + GA_SM);
    bfraw* rhs = (bfraw*)(smem + GA_RHS);
    float* beta = gc + 64; float* eg = gc + 128; float* ed = gc + 192;
    __syncthreads();
    bfraw* raw = (bfraw*)(smem + GA_RAW);
    for (int m = 0; m < 2; ++m) {
        {
            OPQ_TID();
            for (int ch = tid; ch < 67 * 16; ch += NTHR) {
                const int rr = ch >> 4, cc = (ch & 15) * 8, tt = t0 - 3 + rr;
                uint4 v = make_uint4(0u, 0u, 0u, 0u);
                if (tt >= 0) v = *(const uint4*)(G0 + (size_t)(b * TT + tt) * 1536 + m * 512 + h * 128 + cc);
                *(uint4*)&raw[rr * 128 + cc] = v;
            }
        }
        __syncthreads();
        {
            OPQ_TID();
            const int d = tid & 127, qt = tid >> 7, col = m * 512 + h * 128 + d, i0 = qt * 16;
            bfraw* dstb = m ? kbuf : qbuf;
            const float w0 = cw[col], w1 = cw[1536 + col], w2 = cw[2 * 1536 + col], w3 = cw[3 * 1536 + col];
            float x3 = bf2f(raw[(i0) * 128 + d]), x2 = bf2f(raw[(i0 + 1) * 128 + d]), x1 = bf2f(raw[(i0 + 2) * 128 + d]);
#pragma unroll 4
            for (int i = i0; i < i0 + 16; ++i) {
                const float x = bf2f(raw[(i + 3) * 128 + d]);
                dstb[i * 136 + d] = f2bf(siluf_(w0 * x3 + w1 * x2 + w2 * x1 + w3 * x));
                x3 = x2; x2 = x1; x1 = x;
            }
        }
        __syncthreads();
    }
    { OPQ_TID();
    if (w == 0) {
        const float* sm = (const float*)(p.ws + O_SM0) + (size_t)(b * TT + t0 + lane) * 16;
        const float gv = -__expf(p.in[I_GALOG][h]) * softplusf_(sm[8 + h] + p.in[I_GDTB][h]);
        float incl = gv;
        for (int m = 1; m < 64; m <<= 1) { const float o = __shfl_up(incl, m); if (lane >= m) incl += o; }
        const float gl = __shfl(incl, 63);
        gc[lane] = incl; beta[lane] = sigmoidf_(sm[12 + h]); eg[lane] = __expf(incl); ed[lane] = __expf(gl - incl);
        if (lane == 0) gc[256] = __expf(gl);
    } }
    __syncthreads();
    { OPQ_TID();
#pragma unroll 1
    for (int rr = 0; rr < 8; ++rr) {
        const int i = w * 8 + rr;
        uint32_t* qp = (uint32_t*)&qbuf[i * 136 + lane * 2];
        uint32_t* kp = (uint32_t*)&kbuf[i * 136 + lane * 2];
        const uint32_t qv = *qp, kv = *kp;
        const float q0 = lo2f(qv), q1 = hi2f(qv), k0 = lo2f(kv), k1 = hi2f(kv);
        const float qs = wave_sum(q0 * q0 + q1 * q1), ks = wave_sum(k0 * k0 + k1 * k1);
        const float qi = rsqrtf(qs + EPSF) * 0.08838834764831845f, ki = rsqrtf(ks + EPSF);
        *qp = pack2(q0 * qi, q1 * qi);
        *kp = pack2(k0 * ki, k1 * ki);
        const float e = ed[i];
        kdT[(lane * 2) * 72 + i] = f2bf(k0 * ki * e);
        kdT[(lane * 2 + 1) * 72 + i] = f2bf(k1 * ki * e);
    } }
    __syncthreads();
    {
        OPQ_TID();
        const int mat = w >> 2, ti = w & 3;
        const bfraw* Ab = mat ? qbuf : kbuf;
        f32x4 acc[4];
#pragma unroll
        for (int j = 0; j < 4; ++j) acc[j] = f32x4{0.f, 0.f, 0.f, 0.f};
#pragma unroll
        for (int ks = 0; ks < 4; ++ks) {
            const bf16x8 a = ld8(&Ab[(ti * 16 + c) * 136 + ks * 32 + g * 8]);
#pragma unroll
            for (int j = 0; j < 4; ++j) acc[j] = mfma16(a, ld8(&kbuf[(j * 16 + c) * 136 + ks * 32 + g * 8]), acc[j]);
        }
#pragma unroll
        for (int j = 0; j < 4; ++j)
#pragma unroll
            for (int r = 0; r < 4; ++r) {
                const int i = ti * 16 + 4 * g + r, jj = j * 16 + c;
                const float dec = __expf(gc[i] - gc[jj]);
                if (mat == 0) Lm[i * 64 + jj] = (i > jj) ? beta[i] * acc[j][r] * dec : 0.f;
                else att[i * 72 + jj] = f2bf((i >= jj) ? acc[j][r] * dec : 0.f);
            }
        const int i = tid >> 3, d0 = (tid & 7) * 16;
        const float e = eg[i];
        bfraw* qe = (bfraw*)(p.ws + O_QEFF) + ((size_t)item * 64 + i) * 128 + d0;
        U4 oa, ob;
#pragma unroll
        for (int q = 0; q < 4; ++q) {
            const uint32_t v = *(const uint32_t*)&qbuf[i * 136 + d0 + 2 * q]; oa.w[q] = pack2(lo2f(v) * e, hi2f(v) * e);
            const uint32_t v2 = *(const uint32_t*)&qbuf[i * 136 + d0 + 8 + 2 * q]; ob.w[q] = pack2(lo2f(v2) * e, hi2f(v2) * e);
        }
        *(uint4*)qe = oa.u; *(uint4*)(qe + 8) = ob.u;
    }
    lds_barrier();
    {
        OPQ_TID();
        for (int ch = tid; ch < 67 * 16; ch += NTHR) {
            const int rr = ch >> 4, cc = (ch & 15) * 8, tt = t0 - 3 + rr;
            uint4 v = make_uint4(0u, 0u, 0u, 0u);
            if (tt >= 0) v = *(const uint4*)(G0 + (size_t)(b * TT + tt) * 1536 + 1024 + h * 128 + cc);
            *(uint4*)&raw[rr * 128 + cc] = v;
        }
    }
    __syncthreads();
    {
        OPQ_TID();
        const int d = tid & 127, qt = tid >> 7, col = 1024 + h * 128 + d, i0 = qt * 16;
        const float w0 = cw[col], w1 = cw[1536 + col], w2 = cw[2 * 1536 + col], w3 = cw[3 * 1536 + col];
        float x3 = bf2f(raw[(i0) * 128 + d]), x2 = bf2f(raw[(i0 + 1) * 128 + d]), x1 = bf2f(raw[(i0 + 2) * 128 + d]);
#pragma unroll 4
        for (int i = i0; i < i0 + 16; ++i) {
            const float x = bf2f(raw[(i + 3) * 128 + d]);
            rhs[i * 264 + d] = f2bf(siluf_(w0 * x3 + w1 * x2 + w2 * x1 + w3 * x) * beta[i]);
            rhs[i * 264 + 128 + d] = f2bf(bf2f(kbuf[i * 136 + d]) * beta[i] * eg[i]);
            x3 = x2; x2 = x1; x1 = x;
        }
    }
    __syncthreads();
    float x[64];
    const int tid = opaque_tid();
    if (tid < 256) {
#pragma unroll
        for (int i = 0; i < 64; ++i) {
            float s = bf2f(rhs[i * 264 + tid]), s2 = 0.f;
            const float4* Lr = (const float4*)&Lm[i * 64];
#pragma unroll
            for (int j4 = 0; j4 < (i + 3) / 4; ++j4) {
                const float4 lv = Lr[j4];
                s -= lv.x * x[j4 * 4];
                if (j4 * 4 + 1 < i) s2 -= lv.y * x[j4 * 4 + 1];
                if (j4 * 4 + 2 < i) s -= lv.z * x[j4 * 4 + 2];
                if (j4 * 4 + 3 < i) s2 -= lv.w * x[j4 * 4 + 3];
            }
            s += s2;
            asm volatile("" : "+v"(s) :: "memory");
            x[i] = s;
        }
    }
    __syncthreads();
    if (tid < 256) {
#pragma unroll
        for (int q = 0; q < 8; ++q) {
            uint4 o; o.x = pack2(x[q * 8 + 0], x[q * 8 + 1]); o.y = pack2(x[q * 8 + 2], x[q * 8 + 3]); o.z = pack2(x[q * 8 + 4], x[q * 8 + 5]); o.w = pack2(x[q * 8 + 6], x[q * 8 + 7]);
            *(uint4*)&XT[tid * 72 + q * 8] = o;
        }
    }
    block_sync_mem();
    {
        OPQ_TID();
        f32x4 a3[4], a4[4];
#pragma unroll
        for (int it = 0; it < 4; ++it) { a3[it] = f32x4{0.f, 0.f, 0.f, 0.f}; a4[it] = f32x4{0.f, 0.f, 0.f, 0.f}; }
#pragma unroll
        for (int ks = 0; ks < 2; ++ks) {
            const bf16x8 aw = ld8(&XT[(128 + w * 16 + c) * 72 + ks * 32 + g * 8]);
            const bf16x8 au = ld8(&XT[(w * 16 + c) * 72 + ks * 32 + g * 8]);
#pragma unroll
            for (int it = 0; it < 4; ++it) {
                const bf16x8 bt = ld8(&att[(it * 16 + c) * 72 + ks * 32 + g * 8]);
                a3[it] = mfma16(aw, bt, a3[it]); a4[it] = mfma16(au, bt, a4[it]);
            }
        }
        bfraw* qe = (bfraw*)(p.ws + O_QEFF) + (size_t)item * 64 * 128;
        bfraw* yc = (bfraw*)(p.ws + O_YCAT);
#pragma unroll
        for (int it = 0; it < 4; ++it) {
            const int i = it * 16 + c, d = w * 16 + 4 * g;
            bfraw* qp = qe + (size_t)i * 128 + d;
            const uint2 qv = *(const uint2*)qp;
            st4bf(qp, lo2f(qv.x) - a3[it][0], hi2f(qv.x) - a3[it][1], lo2f(qv.y) - a3[it][2], hi2f(qv.y) - a3[it][3]);
            st4bf(yc + (size_t)(b * TT + t0 + i) * 1024 + 512 + h * 128 + d, a4[it][0], a4[it][1], a4[it][2], a4[it][3]);
        }
    }
    {
        OPQ_TID();
        const float egl = gc[256];
        bfraw* Mb = (bfraw*)(p.ws + O_MBUF) + (size_t)item * 16384;
        bfraw* Nb = (bfraw*)(p.ws + O_NS) + (size_t)item * 16384;
#pragma unroll 1
        for (int half = 0; half < 2; ++half) {
            f32x4 a5[4], a6[4];
#pragma unroll
            for (int q = 0; q < 4; ++q) { a5[q] = f32x4{0.f, 0.f, 0.f, 0.f}; a6[q] = f32x4{0.f, 0.f, 0.f, 0.f}; }
#pragma unroll
            for (int ks = 0; ks < 2; ++ks) {
                const bf16x8 aw = ld8(&XT[(128 + w * 16 + c) * 72 + ks * 32 + g * 8]);
                const bf16x8 ak = ld8(&kdT[(w * 16 + c) * 72 + ks * 32 + g * 8]);
#pragma unroll
                for (int q = 0; q < 4; ++q) {
                    const int tl = half * 4 + q;
                    a5[q] = mfma16(aw, ld8(&kdT[(tl * 16 + c) * 72 + ks * 32 + g * 8]), a5[q]);
                    a6[q] = mfma16(ak, ld8(&XT[(tl * 16 + c) * 72 + ks * 32 + g * 8]), a6[q]);
                }
            }
#pragma unroll
            for (int q = 0; q < 4; ++q) {
                const int tl = half * 4 + q;
                const int d = tl * 16 + c, dp = w * 16 + 4 * g;
                st4bf(Mb + (size_t)d * 128 + dp, (d == dp ? egl : 0.f) - a5[q][0], (d == dp + 1 ? egl : 0.f) - a5[q][1],
                      (d == dp + 2 ? egl : 0.f) - a5[q][2], (d == dp + 3 ? egl : 0.f) - a5[q][3]);
                const int e = tl * 16 + c, dd = w * 16 + 4 * g;
                st4bf(Nb + (size_t)e * 128 + dd, a6[q][0], a6[q][1], a6[q][2], a6[q][3]);
            }
        }
    }
    lds_barrier();
}

DEV void gdn_scan_item(const Params& p, int bh) {
    const int lane = tidx() & 63, w = tidx() >> 6, c = lane & 15, g = lane >> 4;
    const int e = w * 16 + c;
    f32x4 S[8];
#pragma unroll
    for (int dt = 0; dt < 8; ++dt) S[dt] = f32x4{0.f, 0.f, 0.f, 0.f};
    const bfraw* MB = (const bfraw*)(p.ws + O_MBUF) + (size_t)bh * 256 * 16384;
    bfraw* NB = (bfraw*)(p.ws + O_NS) + (size_t)bh * 256 * 16384;
    for (int n = 0; n < 256; ++n) {
        const bfraw* M = MB + (size_t)n * 16384;
        bfraw* N = NB + (size_t)n * 16384 + (size_t)e * 128 + 4 * g;
        bf16x8 bs[4];
#pragma unroll
        for (int s = 0; s < 4; ++s) bs[s] = pack8(S[2 * s][0], S[2 * s][1], S[2 * s][2], S[2 * s][3], S[2 * s + 1][0], S[2 * s + 1][1], S[2 * s + 1][2], S[2 * s + 1][3]);
        uint2 nf[8];
#pragma unroll
        for (int dt = 0; dt < 8; ++dt) nf[dt] = *(const uint2*)(N + dt * 16);
        asm volatile("s_waitcnt vmcnt(0)" ::: "memory");
#pragma unroll
        for (int dt = 0; dt < 8; ++dt) st4bf(N + dt * 16, S[dt][0], S[dt][1], S[dt][2], S[dt][3]);
#pragma unroll
        for (int dt = 0; dt < 8; ++dt) {
            f32x4 acc = f32x4{lo2f(nf[dt].x), hi2f(nf[dt].x), lo2f(nf[dt].y), hi2f(nf[dt].y)};
#pragma unroll
            for (int s = 0; s < 4; ++s) {
                const bfraw* mp = M + (size_t)(dt * 16 + c) * 128 + 32 * s + 4 * g;
                acc = mfma16(ld4x2(mp, mp + 16), bs[s], acc);
            }
            S[dt] = acc;
        }
    }
}

DEV void gdn_c_witem(const Params& p, int witem, bool dry = false) {
    const int lane = tidx() & 63, c = lane & 15, g = lane >> 4;
    const int item = witem >> 2, it = witem & 3;
    const int bh = item >> 8, n = item & 255, b = bh >> 2, h = bh & 3;
    const bfraw* Sb = (const bfraw*)(p.ws + O_SB) + (size_t)item * 16384;
    const bfraw* Qe = (const bfraw*)(p.ws + O_QEFF) + (size_t)item * 64 * 128;
    f32x4 acc[8];
#pragma unroll
    for (int et = 0; et < 8; ++et) acc[et] = f32x4{0.f, 0.f, 0.f, 0.f};
#pragma unroll
    for (int ks = 0; ks < 4; ++ks) {
        const bf16x8 bq = ld8(Qe + (size_t)(it * 16 + c) * 128 + ks * 32 + g * 8);
#pragma unroll
        for (int et = 0; et < 8; ++et) acc[et] = mfma16(ld8(Sb + (size_t)(et * 16 + c) * 128 + ks * 32 + g * 8), bq, acc[et]);
    }
    const int tok = b * TT + n * 64 + it * 16 + c;
    bfraw* yp = (bfraw*)(p.ws + O_YCAT) + (size_t)tok * 1024 + 512 + h * 128 + 4 * g;
    const bfraw* gz = (const bfraw*)(p.ws + O_GZ) + (size_t)tok * 512 + h * 128 + 4 * g;
    float ss = 0.f;
#pragma unroll
    for (int et = 0; et < 8; ++et) {
        const uint2 o0 = *(const uint2*)(yp + et * 16);
        acc[et][0] += lo2f(o0.x); acc[et][1] += hi2f(o0.x); acc[et][2] += lo2f(o0.y); acc[et][3] += hi2f(o0.y);
        ss += acc[et][0] * acc[et][0] + acc[et][1] * acc[et][1] + acc[et][2] * acc[et][2] + acc[et][3] * acc[et][3];
    }
    ss = grpx_sum(ss);
    const float rs = rsqrtf(ss * (1.f / 128.f) + EPSF);
#pragma unroll
    for (int et = 0; et < 8; ++et) {
        const uint2 zv = *(const uint2*)(gz + et * 16);
        const float4 gn = *(const float4*)(p.in[I_GON] + et * 16 + 4 * g);
        st4bf((dry ? (bfraw*)(p.ws + O_MBUF) + (size_t)tok * 1024 + 4 * g : yp) + et * 16, acc[et][0] * rs * gn.x * siluf_(lo2f(zv.x)), acc[et][1] * rs * gn.y * siluf_(hi2f(zv.x)),
                            acc[et][2] * rs * gn.z * siluf_(lo2f(zv.y)), acc[et][3] * rs * gn.w * siluf_(hi2f(zv.y)));
    }
}
constexpr int TS_K = 0, TS_V = 18432, TS_C = 36864;
template <bool WITHV, bool WITHC, class KEYOF, class BODY>
DEV void tile_stream(char* smem, const bfraw* Kg, const bfraw* Vg, size_t vstride, const float* Cg, int ntiles, KEYOF key_of, BODY body) {
    const int tid = tidx(), srow = tid >> 3, sseg = tid & 7;
    bfraw* Kl = (bfraw*)(smem + TS_K); bfraw* Vl = (bfraw*)(smem + TS_V); float* Cl = (float*)(smem + TS_C);
    if (ntiles <= 0) return;
    uint4 ka, va = make_uint4(0u, 0u, 0u, 0u), kb = make_uint4(0u, 0u, 0u, 0u), vb = make_uint4(0u, 0u, 0u, 0u);
    float4 ca = make_float4(0.f, 0.f, 0.f, 0.f), cb = make_float4(0.f, 0.f, 0.f, 0.f);
    auto ldt = [&](int t, uint4& rk, uint4& rv, float4& rc) {
        const int k0 = key_of(t);
        rk = *(const uint4*)(Kg + (size_t)(k0 + srow) * 64 + sseg * 8);
        if (WITHV) rv = *(const uint4*)(Vg + (size_t)srow * vstride + k0 + sseg * 8);
        if (WITHC) { if (tid < 16) rc = *(const float4*)(Cg + k0 + 4 * tid); }
    };
    auto stt = [&](int buf, const uint4& rk, const uint4& rv, const float4& rc) {
        *(uint4*)&Kl[buf * 64 * 72 + srow * 72 + sseg * 8] = rk;
        if (WITHV) *(uint4*)&Vl[buf * 64 * 72 + srow * 72 + sseg * 8] = rv;
        if (WITHC) { if (tid < 16) *(float4*)&Cl[buf * 64 + 4 * tid] = rc; }
    };
    __syncthreads();
    ldt(0, ka, va, ca);
    if (ntiles > 1) ldt(1, kb, vb, cb);
    stt(0, ka, va, ca);
    lds_barrier();
    for (int t = 0; t < ntiles; t += 2) {
        if (t + 2 < ntiles) ldt(t + 2, ka, va, ca);
        body(t, Kl, Vl, Cl);
        if (t + 1 < ntiles) stt(1, kb, vb, cb);
        lds_barrier();
        if (t + 1 >= ntiles) break;
        if (t + 3 < ntiles) ldt(t + 3, kb, vb, cb);
        body(t + 1, Kl + 64 * 72, Vl + 64 * 72, Cl + 64);
        if (t + 2 < ntiles) stt(0, ka, va, ca);
        lds_barrier();
    }
}

constexpr int TS2_K = 0, TS2_V = 36864, TS2_END = 71680;
template <class KEYOF, class KEYOF2, class BODY>
DEV void tile_stream2(char* smem, const bfraw* Kg, const bfraw* Vg, size_t vstride, int ntiles, KEYOF key_of, KEYOF2 key_of2, BODY body) {
    const int tid = tidx(), srow = tid >> 3, sseg = tid & 7;
    bfraw* Kl = (bfraw*)(smem + TS2_K); bfraw* Vl = (bfraw*)(smem + TS2_V);
    if (ntiles <= 0) return;
    uint4 ka0, ka1, va0, va1, kb0 = make_uint4(0u, 0u, 0u, 0u), kb1 = kb0, vb0 = kb0, vb1 = kb0;
#define TS2_LD(T, K0, K1, V0, V1) { const int a0 = key_of(T), a1 = key_of2(T); K0 = *(const uint4*)(Kg + (size_t)(a0 + srow) * 64 + sseg * 8); K1 = *(const uint4*)(Kg + (size_t)(a1 + srow) * 64 + sseg * 8); \
        V0 = *(const uint4*)(Vg + (size_t)srow * vstride + a0 + sseg * 8); V1 = *(const uint4*)(Vg + (size_t)srow * vstride + a1 + sseg * 8); }
#define TS2_ST(BUF, K0, K1, V0, V1) { bfraw* kp = Kl + (BUF) * 128 * 72 + srow * 72 + sseg * 8; *(uint4*)kp = K0; *(uint4*)(kp + 64 * 72) = K1; \
        bfraw* vp = Vl + (BUF) * 64 * 136 + srow * 136 + sseg * 8; *(uint4*)vp = V0; *(uint4*)(vp + 64) = V1; }
    __syncthreads();
    TS2_LD(0, ka0, ka1, va0, va1)
    if (ntiles > 1) TS2_LD(1, kb0, kb1, vb0, vb1)
    TS2_ST(0, ka0, ka1, va0, va1)
    lds_barrier();
    for (int t = 0; t < ntiles; t += 2) {
        if (t + 2 < ntiles) TS2_LD(t + 2, ka0, ka1, va0, va1)
        body(t, Kl, Vl);
        if (t + 1 < ntiles) TS2_ST(1, kb0, kb1, vb0, vb1)
        lds_barrier();
        if (t + 1 >= ntiles) break;
        if (t + 3 < ntiles) TS2_LD(t + 3, kb0, kb1, vb0, vb1)
        body(t + 1, Kl + 128 * 72, Vl + 64 * 136);
        if (t + 2 < ntiles) TS2_ST(0, ka0, ka1, va0, va1)
        lds_barrier();
    }
#undef TS2_LD
#undef TS2_ST
}

DEV void fox_item2(const Params& p, char* smem, int bh, int qb) {
    const int tid = tidx(), lane = tid & 63, w = tid >> 6, c = lane & 15, g = lane >> 4;
    const int b = bh >> 3, h = bh & 7;
    const bfraw* Q = (const bfraw*)(p.ws + O_QF) + (size_t)bh * TT * 64;
    const bfraw* K = (const bfraw*)(p.ws + O_KF) + (size_t)bh * TT * 64;
    const bfraw* VT = (const bfraw*)(p.ws + O_VFT) + (size_t)bh * 64 * TT;
    const float* cum = (const float*)(p.ws + O_CUMF) + (size_t)bh * TT;
    const float mq = wave_max(fabsf(p.in[I_FOXQN][lane])), mk = wave_max(fabsf(p.in[I_FOXKN][lane]));
    const float Mb2 = 8.f * mq * mk * LOG2E;
    const float thr = -(105.f + 16.f * mq * mk) * LOG2E;
    const int Q0 = qb * 256, q0w = Q0 + w * 32, jw = q0w >> 6, jmax = (Q0 >> 6) + 3;
    int* red = (int*)(smem + TS_C + 1024);
    __syncthreads();
    if (tid == 0) red[0] = 0;
    __syncthreads();
    {
        const float cq0 = cum[Q0];
        bool dead = false;
        if (tid <= jmax && tid < 256) dead = (cq0 - cum[64 * tid + 63] < thr);
        const unsigned long long bm = __ballot(dead);
        if (lane == 0 && bm) atomicMax(red, w * 64 + 64 - __builtin_clzll(bm));
    }
    __syncthreads();
    const int jmin = red[0];
    int tq[2]; float cq[2]; bf16x8 qf[2][2]; f32x4 O[2][4]; float l[2];
#pragma unroll
    for (int cg = 0; cg < 2; ++cg) {
        tq[cg] = q0w + cg * 16 + c; cq[cg] = cum[tq[cg]] - Mb2; l[cg] = 0.f;
#pragma unroll
        for (int ks = 0; ks < 2; ++ks) qf[cg][ks] = ld8(Q + (size_t)tq[cg] * 64 + ks * 32 + g * 8);
#pragma unroll
        for (int dt = 0; dt < 4; ++dt) O[cg][dt] = f32x4{0.f, 0.f, 0.f, 0.f};
    }
    tile_stream<true, true>(smem, K, VT, TT, cum, jmax - jmin + 1, [&](int t) { return (jmax - t) * 64; },
        [&](int t, const bfraw* Kb, const bfraw* Vb, const float* Cb) {
            const int j = jmax - t;
            if (j > jw) return;
            const bool diag = (j == jw);
            bf16x8 pb[2][2];
#pragma unroll
            for (int kt = 0; kt < 4; ++kt) {
                const bf16x8 k0 = ld8(&Kb[(kt * 16 + c) * 72 + g * 8]), k1 = ld8(&Kb[(kt * 16 + c) * 72 + 32 + g * 8]);
                const float4 ck = *(const float4*)&Cb[kt * 16 + 4 * g];
#pragma unroll
                for (int cg = 0; cg < 2; ++cg) {
                    f32x4 S = f32x4{cq[cg] - ck.x, cq[cg] - ck.y, cq[cg] - ck.z, cq[cg] - ck.w};
                    S = mfma16(k0, qf[cg][0], S);
                    S = mfma16(k1, qf[cg][1], S);
                    float e[4];
#pragma unroll
                    for (int r = 0; r < 4; ++r) {
                        e[r] = ex2(S[r]);
                        if (diag && (64 * j + kt * 16 + 4 * g + r > tq[cg])) e[r] = 0.f;
                        l[cg] += e[r];
                    }
                    U4 tt;
                    if (kt & 1) { tt.v = pb[cg][kt >> 1]; tt.w[2] = pack2(e[0], e[1]); tt.w[3] = pack2(e[2], e[3]); }
                    else { tt.w[0] = pack2(e[0], e[1]); tt.w[1] = pack2(e[2], e[3]); tt.w[2] = 0u; tt.w[3] = 0u; }
                    pb[cg][kt >> 1] = tt.v;
                }
            }
#pragma unroll
            for (int dt = 0; dt < 4; ++dt) {
                const bfraw* vp = &Vb[(dt * 16 + c) * 72 + 4 * g];
                const bf16x8 v0 = ld4x2(vp, vp + 16), v1 = ld4x2(vp + 32, vp + 48);
#pragma unroll
                for (int cg = 0; cg < 2; ++cg) { O[cg][dt] = mfma16(v0, pb[cg][0], O[cg][dt]); O[cg][dt] = mfma16(v1, pb[cg][1], O[cg][dt]); }
            }
        });
    bfraw* yc = (bfraw*)(p.ws + O_YCAT);
#pragma unroll
    for (int cg = 0; cg < 2; ++cg) {
        const float inv = 1.f / grpx_sum(l[cg]);
        bfraw* d = yc + (size_t)(b * TT + tq[cg]) * 1024 + h * 64 + 4 * g;
#pragma unroll
        for (int dt = 0; dt < 4; ++dt) st4bf(d + dt * 16, O[cg][dt][0] * inv, O[cg][dt][1] * inv, O[cg][dt][2] * inv, O[cg][dt][3] * inv);
    }
    __syncthreads();
}

constexpr int GS_STAGE = 34816 + 4352;
DEV void gdn_scan_item2(const Params& p, char* smem, int item) {
    const int tid = tidx(), lane = tid & 63, w = tid >> 6, c = lane & 15, g = lane >> 4;
    const int bh = item & 7, e0 = (item >> 3) * 16;
    const bfraw* MB = (const bfraw*)(p.ws + O_MBUF) + (size_t)bh * 256 * 16384;
    const bfraw* NB = (const bfraw*)(p.ws + O_NS) + (size_t)bh * 256 * 16384 + (size_t)e0 * 128;
    bfraw* SB = (bfraw*)(p.ws + O_SB) + (size_t)bh * 256 * 16384 + (size_t)e0 * 128;
    __syncthreads();
    if (w >= 4) {
        const int lt = tid - 256, lrow = lt >> 4, lcol = (lt & 15) * 8;
#define GS_LDR(N, R) { const bfraw* Mn = MB + (size_t)(N) * 16384 + (size_t)lrow * 128 + lcol; \
            R##m0 = *(const uint4*)(Mn + 0 * 128); R##m1 = *(const uint4*)(Mn + 16 * 128); R##m2 = *(const uint4*)(Mn + 32 * 128); R##m3 = *(const uint4*)(Mn + 48 * 128); R##m4 = *(const uint4*)(Mn + 64 * 128); R##m5 = *(const uint4*)(Mn + 80 * 128); R##m6 = *(const uint4*)(Mn + 96 * 128); R##m7 = *(const uint4*)(Mn + 112 * 128); \
            R##n = *(const uint4*)(NB + (size_t)(N) * 16384 + (size_t)lrow * 128 + lcol); }
#define GS_STR(STAGE, R) { bfraw* Mw = (bfraw*)(smem + (STAGE) * GS_STAGE) + lrow * 136 + lcol; \
            *(uint4*)(Mw + 0 * 136) = R##m0; *(uint4*)(Mw + 16 * 136) = R##m1; *(uint4*)(Mw + 32 * 136) = R##m2; *(uint4*)(Mw + 48 * 136) = R##m3; *(uint4*)(Mw + 64 * 136) = R##m4; *(uint4*)(Mw + 80 * 136) = R##m5; *(uint4*)(Mw + 96 * 136) = R##m6; *(uint4*)(Mw + 112 * 136) = R##m7; \
            *(uint4*)(Mw + 128 * 136) = R##n; }
        uint4 ram0, ram1, ram2, ram3, ram4, ram5, ram6, ram7, rbm0, rbm1, rbm2, rbm3, rbm4, rbm5, rbm6, rbm7, rcm0, rcm1, rcm2, rcm3, rcm4, rcm5, rcm6, rcm7, ran, rbn, rcn;
        GS_LDR(0, ra) GS_LDR(1, rb) GS_LDR(2, rc)
        GS_STR(0, ra)
        lds_barrier();
#define GS_IT(N, RCUR, RNEXT, STG) { const int n_ = (N); if (n_ < 256) { if (n_ + 3 < 256) GS_LDR(n_ + 3, RCUR) if (n_ + 1 < 256) GS_STR((STG) ^ 1, RNEXT) lds_barrier(); } }
        for (int n = 0; n < 256; n += 6) {
            GS_IT(n + 0, ra, rb, 0) GS_IT(n + 1, rb, rc, 1) GS_IT(n + 2, rc, ra, 0)
            GS_IT(n + 3, ra, rb, 1) GS_IT(n + 4, rb, rc, 0) GS_IT(n + 5, rc, ra, 1)
        }
#undef GS_IT
#undef GS_LDR
#undef GS_STR
    } else if (w == 0) {
        f32x4 S[8];
#pragma unroll
        for (int dt = 0; dt < 8; ++dt) S[dt] = f32x4{0.f, 0.f, 0.f, 0.f};
        lds_barrier();
        for (int n = 0; n < 256; ++n) {
            const bfraw* Mb = (const bfraw*)(smem + (n & 1) * GS_STAGE);
            const bfraw* Nl = Mb + 128 * 136;
            bfraw* Sn = SB + (size_t)n * 16384 + (size_t)c * 128 + 4 * g;
            bf16x8 bs[4];
#pragma unroll
            for (int s = 0; s < 4; ++s)
                bs[s] = pack8(S[2 * s][0], S[2 * s][1], S[2 * s][2], S[2 * s][3], S[2 * s + 1][0], S[2 * s + 1][1], S[2 * s + 1][2], S[2 * s + 1][3]);
#pragma unroll
            for (int dt = 0; dt < 8; ++dt) st4bf(Sn + dt * 16, S[dt][0], S[dt][1], S[dt][2], S[dt][3]);
#pragma unroll
            for (int dt = 0; dt < 8; ++dt) {
                const uint2 n0 = *(const uint2*)&Nl[c * 136 + dt * 16 + 4 * g];
                f32x4 a0 = f32x4{lo2f(n0.x), hi2f(n0.x), lo2f(n0.y), hi2f(n0.y)};
#pragma unroll
                for (int s = 0; s < 4; ++s) {
                    const bfraw* mp = &Mb[(dt * 16 + c) * 136 + 32 * s + 4 * g];
                    a0 = mfma16(ld4x2(mp, mp + 16), bs[s], a0);
                }
                S[dt] = a0;
            }
            lds_barrier();
        }
    } else {
        lds_barrier();
        for (int n = 0; n < 256; ++n) lds_barrier();
    }
}
DEV void phase_outproj(const Params& p, char* smem, int layer, unsigned* xq) {
    const bfraw* A = (const bfraw*)(p.ws + O_YCAT);
    const bfraw* Bt = (const bfraw*)(p.ws + (layer ? O_WOUT1 : O_WOUT0));
    const float* xin = layer ? p.out : p.in[I_X];
    for (int rr = 0;; ++rr) {
        int mt, nt;
        if (!xs_tile(4, rr, mt, nt)) break;
        const int m0 = mt * 256, n0 = nt * 256;
        gemm_tile2(smem, 16, 64,
            [&](int r) { return A + (size_t)(m0 + r) * 1024; },
            [&](int r) { return Bt + (size_t)(n0 + r) * 1024; },
            [&](const f32x4 (&acc)[8][4], int rb, int cbk, int lane) {
                const int c = lane & 15, g = lane >> 4, tok0 = m0 + rb, b = tok0 >> 14;
                const float* g1 = modp(p, layer, b, 2) + n0 + cbk + 4 * g;
#pragma unroll
                for (int j = 0; j < 4; ++j) {
                    const float4 gv = *(const float4*)(g1 + j * 16);
#pragma unroll
                    for (int i = 0; i < 8; ++i) {
                        const size_t o = (size_t)(tok0 + i * 16 + c) * 1024 + n0 + cbk + j * 16 + 4 * g;
                        const float4 xv = *(const float4*)(xin + o);
                        *(float4*)(p.out + o) = make_float4(xv.x + gv.x * acc[i][j][0], xv.y + gv.y * acc[i][j][1], xv.z + gv.z * acc[i][j][2], xv.w + gv.w * acc[i][j][3]);
                    }
                }
            });
    }
}

constexpr int RT_LG = 55296;
DEV void phase_router(const Params& p, char* smem, int layer, bool dry = false) {
    const int tid = tidx(), lane = tid & 63, w = tid >> 6;
    bfraw* hb = (bfraw*)(p.ws + O_HBUF);
    const bfraw* Wr = (const bfraw*)(p.ws + O_WRT) + (size_t)layer * 128 * 1024;
    float* lg = (float*)(smem + RT_LG);
    unsigned* cnts = (unsigned*)(p.ws + O_CNT) + 16 + layer * 128;
    float* pairw = (float*)(p.ws + O_PAIRW);
    int* plist = (int*)(p.ws + O_PLIST);
    for (int item = blockIdx.x; item < 256; item += gridDim.x) {
        const int m0 = item * 128, b = m0 >> 14;
        for (int rr = 0; rr < 16; ++rr) {
            const int row = m0 + w * 16 + rr;
            norm_row(p.out + (size_t)row * 1024, p.in[I_NFFN] + layer * 1024, modp(p, layer, b, 4), modp(p, layer, b, 3), hb + (size_t)row * 1024, lane);
        }
        block_sync_mem();
        gemm_tile(smem, 16, 64,
            [&](int r) { return hb + (size_t)(m0 + (r & 127)) * 1024; },
            [&](int r) { return Wr + (size_t)r * 1024; },
            [&](const f32x4 (&acc)[4][4], int rb, int cbk, int ln) {
                if (cbk == 0 && rb < 128) {
                    const int c = ln & 15, g = ln >> 4;
#pragma unroll
                    for (int i = 0; i < 4; ++i)
#pragma unroll
                        for (int j = 0; j < 4; ++j)
#pragma unroll
                            for (int r = 0; r < 4; ++r) lg[(rb + i * 16 + 4 * g + r) * 64 + j * 16 + c] = acc[i][j][r];
                }
            });
        __syncthreads();
        const float eb = p.in[I_MBIAS][layer * 64 + lane];
        const int grp = lane >> 3;
        for (int rr = 0; rr < 16; ++rr) {
            const int row = w * 16 + rr, tok = m0 + row;
            const float score = sigmoidf_(lg[row * 64 + lane]);
            const float biased = score + eb;
            float m1 = biased;
            m1 = fmaxf(m1, __shfl_xor(m1, 1)); m1 = fmaxf(m1, __shfl_xor(m1, 2)); m1 = fmaxf(m1, __shfl_xor(m1, 4));
            const unsigned long long eq = __ballot(biased == m1);
            const unsigned gm = (unsigned)(eq >> (grp * 8)) & 0xffu;
            const int first = __builtin_ctz(gm);
            float m2 = ((lane & 7) == first) ? -INFINITY : biased;
            m2 = fmaxf(m2, __shfl_xor(m2, 1)); m2 = fmaxf(m2, __shfl_xor(m2, 2)); m2 = fmaxf(m2, __shfl_xor(m2, 4));
            const float gs = m1 + m2;
            int grank = 0;
#pragma unroll
            for (int j = 0; j < 8; ++j) { const float gj = __shfl(gs, j * 8); grank += (gj > gs || (gj == gs && j < grp)) ? 1 : 0; }
            const bool gsel = grank < 4;
            const float v = gsel ? biased : -INFINITY;
            int er = 0;
#pragma unroll 8
            for (int j = 0; j < 64; ++j) { const float vj = __shfl(v, j); er += (vj > v || (vj == v && j < lane)) ? 1 : 0; }
            const bool sel = gsel && er < 6;
            const float ssum = wave_sum(sel ? score : 0.f);
            if (sel && !dry) {
                pairw[(size_t)tok * 6 + er] = score / ssum * 2.5f;
                const unsigned pos = atomicAdd(&cnts[b * 64 + lane], 1u);
                plist[(size_t)(b * 64 + lane) * 16384 + pos] = tok * 8 + er;
            }
        }
        __syncthreads();
    }
}

DEV void moe_tiles(const Params& p, char* smem, int layer, int hb, int* ts  ) {
    const unsigned* cnts = (const unsigned*)(p.ws + O_CNT) + 16 + layer * 128 + hb * 64;
    __syncthreads();
    if (tidx() == 0) {
        int a = 0;
        for (int e = 0; e < 64; ++e) { ts[e] = a; a += ((int)cnts[e] + 255) >> 8; }
        ts[64] = a; a += 64; ts[65] = a;
    }
    __syncthreads();
}
DEV int moe_find(const int* ts, int mt) { int e = 0; while (e < 64 && ts[e + 1] <= mt) ++e; return e; }
constexpr int MOE_TS = 147456;

DEV void phase_moe1(const Params& p, char* smem, int layer, int hb) {
    int* ts = (int*)(smem + MOE_TS);
    moe_tiles(p, smem, layer, hb, ts);
    const unsigned* cnts = (const unsigned*)(p.ws + O_CNT) + 16 + layer * 128 + hb * 64;
    const int* plist = (const int*)(p.ws + O_PLIST);
    const bfraw* hbuf = (const bfraw*)(p.ws + O_HBUF);
    const bfraw* wgu = (const bfraw*)(p.ws + O_WGU);
    bfraw* H = (bfraw*)(p.ws + O_H);
    const int total = ts[65];
    for (int item = blockIdx.x; item < total * 2; item += gridDim.x) {
        const int mt = item >> 1, nt = item & 1;
        const int e = moe_find(ts, mt), idx0 = (mt - ts[e]) * 256;
        const int cnt = e < 64 ? (int)cnts[e] : 16384;
        gemm_tile2<false>(smem, 16, 64,
            [&](int r) {
                const int idx = idx0 + r;
                int tok;
                if (e < 64) tok = idx < cnt ? (plist[(size_t)(hb * 64 + e) * 16384 + idx] >> 3) : 0;
                else tok = hb * 16384 + idx;
                return hbuf + (size_t)tok * 1024;
            },
            [&](int r) {
                const int hidden = nt * 128 + (r >> 6) * 32 + ((r >> 4) & 1) * 16 + (r & 15);
                return wgu + ((size_t)e * 512 + ((r >> 5) & 1) * 256 + hidden) * 1024;
            },
            [&](const f32x4 (&acc)[8][4], int rb, int cbk, int lane) {
                const int c = lane & 15, g = lane >> 4;
#pragma unroll
                for (int i = 0; i < 8; ++i) {
                    bfraw* hrow = H + (size_t)(mt * 256 + rb + i * 16 + c) * 256 + nt * 128 + (cbk >> 6) * 32 + 4 * g;
#pragma unroll
                    for (int jj = 0; jj < 2; ++jj)
                        st4bf(hrow + jj * 16, siluf_(acc[i][jj][0]) * acc[i][jj + 2][0], siluf_(acc[i][jj][1]) * acc[i][jj + 2][1],
                              siluf_(acc[i][jj][2]) * acc[i][jj + 2][2], siluf_(acc[i][jj][3]) * acc[i][jj + 2][3]);
                }
            });
    }
}

DEV void phase_moe2(const Params& p, char* smem, int layer, int hb) {
    int* ts = (int*)(smem + MOE_TS);
    moe_tiles(p, smem, layer, hb, ts);
    const unsigned* cnts = (const unsigned*)(p.ws + O_CNT) + 16 + layer * 128 + hb * 64;
    const int* plist = (const int*)(p.ws + O_PLIST);
    const float* pairw = (const float*)(p.ws + O_PAIRW);
    const bfraw* wd = (const bfraw*)(p.ws + O_WD);
    const bfraw* H = (const bfraw*)(p.ws + O_H);
    bfraw* Y = (bfraw*)(p.ws + O_Y);
    const int total = ts[65];
    for (int item = blockIdx.x; item < total * 4; item += gridDim.x) {
        const int mt = item >> 2, nt = item & 3;
        const int e = moe_find(ts, mt), idx0 = (mt - ts[e]) * 256;
        const int cnt = e < 64 ? (int)cnts[e] : 16384;
        gemm_tile2(smem, 4, 64,
            [&](int r) { return H + (size_t)(mt * 256 + r) * 256; },
            [&](int r) { return wd + ((size_t)e * 1024 + nt * 256 + r) * 256; },
            [&](const f32x4 (&acc)[8][4], int rb, int cbk, int lane) {
                const int c = lane & 15, g = lane >> 4;
                int yrow[8]; float wg[8];
                if (e < 64) {
                    const int* pl = plist + (size_t)(hb * 64 + e) * 16384;
                    int pr[8];
#pragma unroll
                    for (int i = 0; i < 8; ++i) pr[i] = pl[min(idx0 + rb + i * 16 + c, cnt - 1)];
#pragma unroll
                    for (int i = 0; i < 8; ++i) {
                        const int tok = pr[i] >> 3, j = pr[i] & 7;
                        wg[i] = pairw[(size_t)tok * 6 + j]; yrow[i] = (tok - hb * 16384) * 7 + j;
                    }
                } else {
#pragma unroll
                    for (int i = 0; i < 8; ++i) { wg[i] = 1.f; yrow[i] = (idx0 + rb + i * 16 + c) * 7 + 6; }
                }
#pragma unroll
                for (int i = 0; i < 8; ++i) {
                    const int idx = idx0 + rb + i * 16 + c;
                    if (idx < cnt) {
                        bfraw* yp = Y + (size_t)yrow[i] * 1024 + nt * 256 + cbk + 4 * g;
                        const float wgi = wg[i];
#pragma unroll
                        for (int j = 0; j < 4; ++j) st4bf(yp + j * 16, wgi * acc[i][j][0], wgi * acc[i][j][1], wgi * acc[i][j][2], wgi * acc[i][j][3]);
                    }
                }
            });
    }
}

DEV void phase_combine(const Params& p, int layer, int hb, bool next_norm, bool dry = false) {
    const int lane = tidx() & 63, w = tidx() >> 6;
    const bfraw* Y = (const bfraw*)(p.ws + O_Y);
    bfraw* hbuf = (bfraw*)(p.ws + O_HBUF);
    const float* g2 = modp(p, layer, hb, 5);
    for (int tl = blockIdx.x * 8 + w; tl < 16384; tl += gridDim.x * 8) {
        const int tok = hb * 16384 + tl;
        float* xr = p.out + (size_t)tok * 1024;
        float4 v[4]; float ss = 0.f;
#pragma unroll
        for (int i = 0; i < 4; ++i) {
            const int cix = lane * 4 + 256 * i;
            float s0 = 0.f, s1 = 0.f, s2 = 0.f, s3 = 0.f;
#pragma unroll
            for (int j = 0; j < 7; ++j) {
                const uint2 y = *(const uint2*)(Y + ((size_t)tl * 7 + j) * 1024 + cix);
                s0 += lo2f(y.x); s1 += hi2f(y.x); s2 += lo2f(y.y); s3 += hi2f(y.y);
            }
            const float4 x = *(const float4*)(xr + cix), gg = *(const float4*)(g2 + cix);
            v[i].x = x.x + gg.x * s0; v[i].y = x.y + gg.y * s1; v[i].z = x.z + gg.z * s2; v[i].w = x.w + gg.w * s3;
            *(float4*)(dry ? (float*)(p.ws + O_YCAT) + (size_t)(tl & 8191) * 1024 + cix : xr + cix) = v[i];
            ss += v[i].x * v[i].x + v[i].y * v[i].y + v[i].z * v[i].z + v[i].w * v[i].w;
        }
        if (next_norm) {
            ss = wave_sum(ss);
            const float rs = rsqrtf(ss * (1.f / 1024.f) + EPSF);
            const float* gain = p.in[I_NMIX] + (layer + 1) * 1024;
            const float* sc = modp(p, layer + 1, hb, 1); const float* sh = modp(p, layer + 1, hb, 0);
#pragma unroll
            for (int i = 0; i < 4; ++i) {
                const int cix = lane * 4 + 256 * i;
                const float4 gn = *(const float4*)(gain + cix), s1 = *(const float4*)(sc + cix), s0 = *(const float4*)(sh + cix);
                st4bf((dry ? (bfraw*)(p.ws + O_YCAT) : hbuf) + (size_t)tok * 1024 + cix, v[i].x * rs * gn.x * (1.f + s1.x) + s0.x, v[i].y * rs * gn.y * (1.f + s1.y) + s0.y,
                      v[i].z * rs * gn.z * (1.f + s1.z) + s0.z, v[i].w * rs * gn.w * (1.f + s1.w) + s0.w);
            }
        }
    }
}
#define HAVE_L1 1
DEV void phase_inproj1(const Params& p, char* smem, unsigned* xq) {
    const bfraw* A = (const bfraw*)(p.ws + O_HBUF);
    const bfraw* Bt = (const bfraw*)(p.ws + O_WIN1);
    constexpr int NTL = NIN1 / 256;
    for (int rr = 0;; ++rr) {
        int mt, nt;
        if (!xs_tile(NTL, rr, mt, nt)) break;
        const int m0 = __builtin_amdgcn_readfirstlane(mt * 256), n0 = __builtin_amdgcn_readfirstlane(nt * 256);
        gemm_tile2(smem, 16, 64,
            [&](int r) { return A + (size_t)(m0 + r) * 1024; },
            [&](int r) { return Bt + (size_t)(n0 + r) * 1024; },
            [&](const f32x4 (&acc)[8][4], int rb, int cbk, int lane) {
                const int cb = n0 + cbk, tok0 = m0 + rb, b = tok0 >> 14, t0 = tok0 & (TT - 1);
                if (cb < 512) {
                    epi2_headnorm<8>(acc, lane, p.in[I_NSAQN], 0.125f * LOG2E, (bfraw*)(p.ws + O_QN) + ((size_t)(b * 8 + (cb >> 6)) * TT + t0) * 64, 64);
                } else if (cb < 640) {
                    epi2_store_bf16<8>(acc, lane, (bfraw*)(p.ws + O_KCR) + (size_t)tok0 * 128 + (cb - 512), 128);
                } else if (cb < 768) {
                    epi2_store_bf16<8>(acc, lane, (bfraw*)(p.ws + O_VCR) + (size_t)tok0 * 128 + (cb - 640), 128);
                } else if (cb < 896) {
                    epi2_headnorm<8>(acc, lane, p.in[I_NSAKN], 1.f, (bfraw*)(p.ws + O_KS) + ((size_t)(b * 2 + ((cb - 768) >> 6)) * TT + t0) * 64, 64);
                } else if (cb < 1024) {
                    epi2_store_T<8>(acc, lane, (bfraw*)(p.ws + O_VST) + (size_t)(b * 2 + ((cb - 896) >> 6)) * 64 * TT + t0, TT);
                } else if (cb < 1152) {
                    epi2_headnorm<8>(acc, lane, p.in[I_NSAKN], 1.f, (bfraw*)(p.ws + O_KW) + ((size_t)(b * 2 + ((cb - 1024) >> 6)) * TT + t0) * 64, 64);
                } else if (cb < 1280) {
                    epi2_store_T<8>(acc, lane, (bfraw*)(p.ws + O_VWT) + (size_t)(b * 2 + ((cb - 1152) >> 6)) * 64 * TT + t0, TT);
                } else if (cb < 1536) {
                    epi2_store_bf16<8>(acc, lane, (bfraw*)(p.ws + O_LQ) + (size_t)tok0 * 256 + (cb - 1280), 256);
                } else if (cb < 1792) {
                    epi2_store_bf16<8>(acc, lane, (bfraw*)(p.ws + O_LK) + (size_t)tok0 * 256 + (cb - 1536), 256);
                } else if (cb < 2304) {
                    epi2_store_bf16<8>(acc, lane, (bfraw*)(p.ws + O_LV) + (size_t)tok0 * 512 + (cb - 1792), 512);
                } else if (cb < 2816) {
                    epi2_store_bf16<8>(acc, lane, (bfraw*)(p.ws + O_LR) + (size_t)tok0 * 512 + (cb - 2304), 512);
                } else if (cb == 2816) {
                    const int c = lane & 15, g = lane >> 4;
                    float* sm = (float*)(p.ws + O_SM1);
#pragma unroll
                    for (int j = 0; j < 3; ++j)
                        if (j * 16 + 4 * g < 40) {
#pragma unroll
                            for (int i = 0; i < 8; ++i) *(float4*)&sm[(size_t)(tok0 + i * 16 + c) * 40 + j * 16 + 4 * g] = make_float4(acc[i][j][0], acc[i][j][1], acc[i][j][2], acc[i][j][3]);
                        }
                }
            });
    }
}

constexpr int NC_H1 = 0;
DEV void nsa_compress_item(const Params& p, char* smem, int item) {
    const int tid = tidx(), lane = tid & 63, w = tid >> 6, c = lane & 15, g = lane >> 4;
    const int wh = item >> 6, rt = item & 63;
    const int R0 = rt * 64, bk = R0 >> 10, b = bk >> 1, kvh = bk & 1, nb0 = R0 & 1023;
    const bfraw* raw = (const bfraw*)(p.ws + (wh ? O_VCR : O_KCR));
    const bfraw* W1 = (const bfraw*)(p.ws + O_W1T) + (size_t)wh * 256 * 2048;
    const bfraw* W2 = (const bfraw*)(p.ws + O_W2T) + (size_t)wh * 64 * 256;
    bfraw* H1 = (bfraw*)(smem + NC_H1);
    __syncthreads();
    {
        const int wm = w & 3, wn = w >> 2;
        int n = nb0 + wm * 16 + c; if (n > 1022) n = 1022;
        const bfraw* arow = raw + ((size_t)b * TT + 16 * n) * 128 + kvh * 64 + 8 * g;
        const bfraw* brow = W1 + (size_t)(wn * 128 + c) * 2048 + 8 * g;
        f32x4 acc[8];
#pragma unroll
        for (int j = 0; j < 8; ++j) acc[j] = f32x4{0.f, 0.f, 0.f, 0.f};
#pragma unroll 2
        for (int ks = 0; ks < 64; ++ks) {
            const bf16x8 a = ld8(arow + (size_t)(ks >> 1) * 128 + (ks & 1) * 32);
#pragma unroll
            for (int j = 0; j < 8; ++j) acc[j] = mfma16(a, ld8(brow + (size_t)j * 16 * 2048 + ks * 32), acc[j]);
        }
        const float* b1 = (const float*)(p.ws + O_BIAS1) + wh * 256;
#pragma unroll
        for (int j = 0; j < 8; ++j) {
            const int col = wn * 128 + j * 16 + c;
            const float bb = b1[col];
#pragma unroll
            for (int r = 0; r < 4; ++r) H1[(wm * 16 + 4 * g + r) * 264 + col] = f2bf(siluf_(acc[j][r] + bb));
        }
    }
    __syncthreads();
    if (w < 4) {
        f32x4 acc[4];
#pragma unroll
        for (int j = 0; j < 4; ++j) acc[j] = f32x4{0.f, 0.f, 0.f, 0.f};
#pragma unroll
        for (int ks = 0; ks < 8; ++ks) {
            const bf16x8 a = ld8(&H1[(w * 16 + c) * 264 + ks * 32 + 8 * g]);
#pragma unroll
            for (int j = 0; j < 4; ++j) acc[j] = mfma16(a, ld8(W2 + (size_t)(j * 16 + c) * 256 + ks * 32 + 8 * g), acc[j]);
        }
        const int nrow = nb0 + w * 16 + 4 * g;
        if (wh == 0) {
            bfraw* kc = (bfraw*)(p.ws + O_KCMP) + (size_t)bk * 1024 * 64;
#pragma unroll
            for (int r = 0; r < 4; ++r) {
                float ss = 0.f;
#pragma unroll
                for (int j = 0; j < 4; ++j) ss += acc[j][r] * acc[j][r];
                ss = grp16_sum(ss);
                const float rs = (nrow + r < 1023) ? rsqrtf(ss * (1.f / 64.f) + EPSF) : 0.f;
#pragma unroll
                for (int j = 0; j < 4; ++j) kc[(size_t)(nrow + r) * 64 + j * 16 + c] = f2bf(acc[j][r] * rs * p.in[I_NSAKN][j * 16 + c]);
            }
        } else {
            bfraw* vc = (bfraw*)(p.ws + O_VCMPT) + (size_t)bk * 64 * 1024;
#pragma unroll
            for (int j = 0; j < 4; ++j)
                st4bf(vc + (size_t)(j * 16 + c) * 1024 + nrow, acc[j][0], acc[j][1], acc[j][2], (nrow + 3 < 1023) ? acc[j][3] : 0.f);
        }
    }
    __syncthreads();
}

constexpr int GL_G = 0, GL_QD = 16384, GL_KN = 25600, GL_AT = 34816, GL_VT = 44032, GL_KDT = 62464, GL_TOT = 71680;
DEV void gla_a_item(const Params& p, char* smem, int item) {
    const int bh = item >> 8, n = item & 255, b = bh >> 2, h = bh & 3, tok0 = b * TT + n * 64;
    float* G = (float*)(smem + GL_G);
    bfraw* qd = (bfraw*)(smem + GL_QD);
    bfraw* kn = (bfraw*)(smem + GL_KN);
    bfraw* at = (bfraw*)(smem + GL_AT);
    bfraw* vT = (bfraw*)(smem + GL_VT);
    bfraw* kdT = (bfraw*)(smem + GL_KDT);
    float* tot = (float*)(smem + GL_TOT);
    const float* sm1 = (const float*)(p.ws + O_SM1);
    __syncthreads();
    {
        OPQ_TID();
        const int d = tid & 63, ig = tid >> 6;
        float wu[16];
#pragma unroll
        for (int r = 0; r < 16; ++r) wu[r] = p.in[I_GLAWG][r * 256 + h * 64 + d];
        const float bg = p.in[I_GLABG][h * 64 + d];
        float run = 0.f;
#pragma unroll 1
        for (int ii = 0; ii < 8; ++ii) {
            const int i = ig * 8 + ii;
            const float* lg = sm1 + (size_t)(tok0 + i) * 40 + 24;
            float z = bg;
#pragma unroll
            for (int r = 0; r < 16; ++r) z += lg[r] * wu[r];
            run += logsigmoidf_(z) * (1.f / 16.f);
            G[i * 64 + d] = run;
        }
        tot[ig * 64 + d] = run;
    }
    __syncthreads();
    {
        OPQ_TID();
        const int d = tid & 63, ig = tid >> 6;
        float off = 0.f;
        for (int q = 0; q < ig; ++q) off += tot[q * 64 + d];
#pragma unroll 1
        for (int ii = 0; ii < 8; ++ii) G[(ig * 8 + ii) * 64 + d] += off;
    }
    __syncthreads();
    {
        OPQ_TID();
        const int i = tid >> 3, d0 = (tid & 7) * 8, e0 = (tid & 7) * 16;
        U4 qv, kv;
        qv.u = *(const uint4*)((const bfraw*)(p.ws + O_LQ) + (size_t)(tok0 + i) * 256 + h * 64 + d0);
        kv.u = *(const uint4*)((const bfraw*)(p.ws + O_LK) + (size_t)(tok0 + i) * 256 + h * 64 + d0);
        U4 qo, ko;
#pragma unroll
        for (int q = 0; q < 4; ++q) {
            const float g0 = G[i * 64 + d0 + 2 * q], g1 = G[i * 64 + d0 + 2 * q + 1];
            const float gl0 = G[63 * 64 + d0 + 2 * q], gl1 = G[63 * 64 + d0 + 2 * q + 1];
            const float q0 = lo2f(qv.w[q]), q1 = hi2f(qv.w[q]), k0 = lo2f(kv.w[q]), k1 = hi2f(kv.w[q]);
            qo.w[q] = pack2(q0 * 0.125f * __expf(g0), q1 * 0.125f * __expf(g1));
            ko.w[q] = pack2(k0 * __expf(-g0), k1 * __expf(-g1));
            kdT[(d0 + 2 * q) * 72 + i] = f2bf(k0 * __expf(gl0 - g0));
            kdT[(d0 + 2 * q + 1) * 72 + i] = f2bf(k1 * __expf(gl1 - g1));
        }
        *(uint4*)&qd[i * 72 + d0] = qo.u;
        *(uint4*)&kn[i * 72 + d0] = ko.u;
        *(uint4*)((bfraw*)(p.ws + O_QD) + ((size_t)item * 64 + i) * 64 + d0) = qo.u;
        const bfraw* vp = (const bfraw*)(p.ws + O_LV) + (size_t)(tok0 + i) * 512 + h * 128 + e0;
        U4 v0, v1; v0.u = *(const uint4*)vp; v1.u = *(const uint4*)(vp + 8);
#pragma unroll
        for (int q = 0; q < 4; ++q) {
            vT[(e0 + 2 * q) * 72 + i] = (bfraw)(v0.w[q] & 0xffffu); vT[(e0 + 2 * q + 1) * 72 + i] = (bfraw)(v0.w[q] >> 16);
            vT[(e0 + 8 + 2 * q) * 72 + i] = (bfraw)(v1.w[q] & 0xffffu); vT[(e0 + 8 + 2 * q + 1) * 72 + i] = (bfraw)(v1.w[q] >> 16);
        }
        if (tid < 64) ((float*)(p.ws + O_AN))[(size_t)item * 64 + tid] = __expf(G[63 * 64 + tid]);
    }
    __syncthreads();
    {
        OPQ_TID();
        const int ti = w >> 1, tj0 = (w & 1) * 2;
        f32x4 acc[2];
        acc[0] = f32x4{0.f, 0.f, 0.f, 0.f}; acc[1] = f32x4{0.f, 0.f, 0.f, 0.f};
#pragma unroll
        for (int ks = 0; ks < 2; ++ks) {
            const bf16x8 a = ld8(&qd[(ti * 16 + c) * 72 + ks * 32 + 8 * g]);
#pragma unroll
            for (int jt = 0; jt < 2; ++jt) acc[jt] = mfma16(a, ld8(&kn[((tj0 + jt) * 16 + c) * 72 + ks * 32 + 8 * g]), acc[jt]);
        }
#pragma unroll
        for (int jt = 0; jt < 2; ++jt)
#pragma unroll
            for (int r = 0; r < 4; ++r) {
                const int i = ti * 16 + 4 * g + r, j = (tj0 + jt) * 16 + c;
                at[i * 72 + j] = f2bf(i >= j ? acc[jt][r] : 0.f);
            }
    }
    __syncthreads();
    {
        OPQ_TID();
        f32x4 ao[4], ab[4];
#pragma unroll
        for (int q = 0; q < 4; ++q) { ao[q] = f32x4{0.f, 0.f, 0.f, 0.f}; ab[q] = f32x4{0.f, 0.f, 0.f, 0.f}; }
#pragma unroll
        for (int ks = 0; ks < 2; ++ks) {
            const bf16x8 ve = ld8(&vT[(w * 16 + c) * 72 + ks * 32 + 8 * g]);
#pragma unroll
            for (int q = 0; q < 4; ++q) {
                ao[q] = mfma16(ve, ld8(&at[(q * 16 + c) * 72 + ks * 32 + 8 * g]), ao[q]);
                ab[q] = mfma16(ld8(&kdT[(q * 16 + c) * 72 + ks * 32 + 8 * g]), ve, ab[q]);
            }
        }
        bfraw* yc = (bfraw*)(p.ws + O_YCAT);
        float* st = (float*)(p.ws + O_ST) + (size_t)item * 8192;
#pragma unroll
        for (int q = 0; q < 4; ++q) {
            st4bf(yc + (size_t)(tok0 + q * 16 + c) * 1024 + 512 + h * 128 + w * 16 + 4 * g, ao[q][0], ao[q][1], ao[q][2], ao[q][3]);
            *(float4*)(st + (size_t)(w * 16 + c) * 64 + q * 16 + 4 * g) = make_float4(ab[q][0], ab[q][1], ab[q][2], ab[q][3]);
        }
    }
    lds_barrier();
}

DEV void gla_scan_item(const Params& p, int item) {
    const int id = item * 512 + tidx(), bh = id >> 13, rem = id & 8191, d = rem & 63;
    float* st = (float*)(p.ws + O_ST) + (size_t)bh * 256 * 8192 + rem;
    const float* an = (const float*)(p.ws + O_AN) + (size_t)bh * 256 * 64 + d;
    float S = 0.f;
    for (int n0 = 0; n0 < 256; n0 += 8) {
        float bv[8], av[8];
#pragma unroll
        for (int q = 0; q < 8; ++q) { bv[q] = st[(size_t)(n0 + q) * 8192]; av[q] = an[(size_t)(n0 + q) * 64]; }
#pragma unroll
        for (int q = 0; q < 8; ++q) { st[(size_t)(n0 + q) * 8192] = S; S = av[q] * S + bv[q]; }
    }
}

DEV void gla_c_witem(const Params& p, int witem, bool dry = false) {
    const int lane = tidx() & 63, c = lane & 15, g = lane >> 4;
    const int item = witem >> 2, it = witem & 3;
    const int bh = item >> 8, n = item & 255, b = bh >> 2, h = bh & 3;
    const float* st = (const float*)(p.ws + O_ST) + (size_t)item * 8192;
    const bfraw* qd = (const bfraw*)(p.ws + O_QD) + (size_t)item * 4096;
    f32x4 acc[8];
#pragma unroll
    for (int et = 0; et < 8; ++et) acc[et] = f32x4{0.f, 0.f, 0.f, 0.f};
#pragma unroll
    for (int ks = 0; ks < 2; ++ks) {
        const bf16x8 bq = ld8(qd + (size_t)(it * 16 + c) * 64 + ks * 32 + 8 * g);
#pragma unroll
        for (int et = 0; et < 8; ++et) {
            const float* sp = st + (size_t)(et * 16 + c) * 64 + ks * 32 + 8 * g;
            const float4 s0 = *(const float4*)sp, s1 = *(const float4*)(sp + 4);
            acc[et] = mfma16(pack8(s0.x, s0.y, s0.z, s0.w, s1.x, s1.y, s1.z, s1.w), bq, acc[et]);
        }
    }
    const int tok = b * TT + n * 64 + it * 16 + c;
    bfraw* yp = (bfraw*)(p.ws + O_YCAT) + (size_t)tok * 1024 + 512 + h * 128 + 4 * g;
    const bfraw* lr = (const bfraw*)(p.ws + O_LR) + (size_t)tok * 512 + h * 128 + 4 * g;
    float ss = 0.f;
#pragma unroll
    for (int et = 0; et < 8; ++et) {
        const uint2 o0 = *(const uint2*)(yp + et * 16);
        acc[et][0] += lo2f(o0.x); acc[et][1] += hi2f(o0.x); acc[et][2] += lo2f(o0.y); acc[et][3] += hi2f(o0.y);
        ss += acc[et][0] * acc[et][0] + acc[et][1] * acc[et][1] + acc[et][2] * acc[et][2] + acc[et][3] * acc[et][3];
    }
    ss = grpx_sum(ss);
    const float rs = rsqrtf(ss * (1.f / 128.f) + EPSF);
#pragma unroll
    for (int et = 0; et < 8; ++et) {
        const uint2 zv = *(const uint2*)(lr + et * 16);
        const float4 gn = *(const float4*)(p.in[I_GLAON] + et * 16 + 4 * g);
        st4bf((dry ? (bfraw*)(p.ws + O_KS) + (size_t)tok * 128 + 4 * g : yp) + et * 16, acc[et][0] * rs * gn.x * siluf_(lo2f(zv.x)), acc[et][1] * rs * gn.y * siluf_(hi2f(zv.x)),
                            acc[et][2] * rs * gn.z * siluf_(lo2f(zv.y)), acc[et][3] * rs * gn.w * siluf_(hi2f(zv.y)));
    }
}
constexpr int NS_IMP = 0;
constexpr int NS_IMPW = 16448;
constexpr int NS_LINV = 131584;
constexpr int NS_BTAB = 132096;
constexpr int NS_SELW = 134400;
DEV int t5_bucket(int n) {
    if (n < 16) return n;
    int v = 16 + (int)(__logf((float)n * (1.f / 16.f)) / 2.0794415416798357f * 16.f);
    return v < 31 ? v : 31;
}
template <int MODE>
DEV void nsa_step(const bfraw* Kb, const bfraw* VTb, size_t vstride, int kb, const bf16x8 (&qf)[2], int tpos, int lim, bool colsel, const float* bt, float Mb2,
                  f32x4 (&O)[4], float& l, float* impU, int c, int g) {
    bf16x8 kf[2][2];
#pragma unroll
    for (int kt = 0; kt < 2; ++kt)
#pragma unroll
        for (int ks = 0; ks < 2; ++ks) kf[kt][ks] = ld8(Kb + (size_t)(kb + kt * 16 + c) * 64 + ks * 32 + 8 * g);
    bf16x8 vf[4];
#pragma unroll
    for (int dt = 0; dt < 4; ++dt) { const bfraw* vp = VTb + (size_t)(dt * 16 + c) * vstride + kb + 4 * g; vf[dt] = ld4x2(vp, vp + 16); }
    float pr[2][4];
#pragma unroll
    for (int kt = 0; kt < 2; ++kt) {
        f32x4 S = mfma16(kf[kt][0], qf[0], f32x4{0.f, 0.f, 0.f, 0.f});
        S = mfma16(kf[kt][1], qf[1], S);
#pragma unroll
        for (int r = 0; r < 4; ++r) {
            const int key = kb + kt * 16 + 4 * g + r;
            int dist; bool valid;
            if (MODE == 0) { dist = tpos - 16 * key - 31; valid = key < lim; }
            else if (MODE == 1) { dist = tpos - key; valid = colsel && dist >= 0; }
            else { dist = tpos - key; valid = dist >= 0 && dist < 512; }
            const int bi = dist < 0 ? 0 : (dist > 128 ? 128 : dist);
            const float e = valid ? ex2(S[r] + bt[bi] - Mb2) : 0.f;
            pr[kt][r] = e; l += e;
        }
        if (MODE == 0) {
            const int blk = ((kb + kt * 16) >> 2) + g;
            atomicAdd(&impU[blk * 16 + c], pr[kt][0] + pr[kt][1] + pr[kt][2] + pr[kt][3]);
            atomicAdd(&impU[(blk + 1) * 16 + c], pr[kt][3]);
        }
    }
    const bf16x8 pb = pack8(pr[0][0], pr[0][1], pr[0][2], pr[0][3], pr[1][0], pr[1][1], pr[1][2], pr[1][3]);
#pragma unroll
    for (int dt = 0; dt < 4; ++dt) O[dt] = mfma16(vf[dt], pb, O[dt]);
}

DEV void nsa_item(const Params& p, char* smem, int item) {
    const int tid = tidx(), lane = tid & 63, w = tid >> 6, c = lane & 15, g = lane >> 4;
    const int bk = item >> 9, tq0 = (item & 511) * 32, b = bk >> 1, kvh = bk & 1;
    const int qi = c >> 2, hg = c & 3, h = kvh * 4 + hg;
    const int tw0 = tq0 + 4 * w, tpos = tw0 + qi;
    float* impU = (float*)(smem + NS_IMP + w * NS_IMPW);
    float* linv = (float*)(smem + NS_LINV) + w * 16;
    float* btab = (float*)(smem + NS_BTAB);
    unsigned long long* selw = (unsigned long long*)(smem + NS_SELW) + w * 20;
    __syncthreads();
    for (int idx = tid; idx < 4 * 129; idx += NTHR) {
        const int hh = idx / 129, dd = idx % 129;
        btab[idx] = p.in[I_RELB][(dd < 128 ? t5_bucket(dd) : 31) * 8 + kvh * 4 + hh] * LOG2E;
    }
    for (int idx = lane; idx < 257 * 16; idx += 64) impU[idx] = 0.f;
    const float mq = wave_max(fabsf(p.in[I_NSAQN][lane])), mk = wave_max(fabsf(p.in[I_NSAKN][lane]));
    const float mb = wave_max(fmaxf(fmaxf(fabsf(p.in[I_RELB][lane]), fabsf(p.in[I_RELB][64 + lane])), fmaxf(fabsf(p.in[I_RELB][128 + lane]), fabsf(p.in[I_RELB][192 + lane]))));
    const float Mb2 = (8.f * mq * mk + mb) * LOG2E;
    __syncthreads();
    const float* bt = btab + hg * 129;
    bf16x8 qf[2];
    {
        const bfraw* qp = (const bfraw*)(p.ws + O_QN) + ((size_t)(b * 8 + h) * TT + tpos) * 64 + 8 * g;
        qf[0] = ld8(qp); qf[1] = ld8(qp + 32);
    }
    const float* gp = (const float*)(p.ws + O_SM1) + (size_t)(b * TT + tpos) * 40 + h * 3;
    const float gt0 = sigmoidf_(gp[0]), gt1 = sigmoidf_(gp[1]), gt2 = sigmoidf_(gp[2]);
    f32x4 ot[4];
#pragma unroll
    for (int dt = 0; dt < 4; ++dt) ot[dt] = f32x4{0.f, 0.f, 0.f, 0.f};
    {
        const int ncnt = tpos >= 31 ? ((tpos - 31) >> 4) + 1 : 0;
        const int tmax = tw0 + 3;
        const int ncw = tmax >= 31 ? ((tmax - 31) >> 4) + 1 : 0;
        const bfraw* Kb = (const bfraw*)(p.ws + O_KCMP) + (size_t)bk * 1024 * 64;
        const bfraw* Vb = (const bfraw*)(p.ws + O_VCMPT) + (size_t)bk * 64 * 1024;
        f32x4 O[4]; float l = 0.f;
#pragma unroll
        for (int dt = 0; dt < 4; ++dt) O[dt] = f32x4{0.f, 0.f, 0.f, 0.f};
        for (int kb = 0; kb < ncw; kb += 32) nsa_step<0>(Kb, Vb, 1024, kb, qf, tpos, ncnt, true, bt, Mb2, O, l, impU, c, g);
        const float lt = grpx_sum(l);
        const float inv = lt > 0.f ? 1.f / lt : 0.f;
        if (g == 0) linv[c] = inv;
#pragma unroll
        for (int dt = 0; dt < 4; ++dt) ot[dt] += O[dt] * (gt0 * inv);
    }
    const int cur = tw0 >> 6;
    {
        unsigned long long un[4] = {0ull, 0ull, 0ull, 0ull};
#pragma unroll 1
        for (int q = 0; q < 4; ++q) {
            float v[4]; bool sel[4];
#pragma unroll
            for (int m = 0; m < 4; ++m) {
                const int s = lane + 64 * m;
                float a = -1.f;
                if (s <= cur) {
                    a = 0.f;
#pragma unroll
                    for (int hh = 0; hh < 4; ++hh) a += impU[s * 16 + q * 4 + hh] * linv[q * 4 + hh];
                }
                const bool forced = (s <= cur) && (s == 0 || s == cur || s == cur - 1);
                sel[m] = forced; v[m] = forced ? -1.f : a;
            }
            const int nforced = cur == 0 ? 1 : (cur == 1 ? 2 : 3);
            const int need = (cur + 1 < 16 ? cur + 1 : 16) - nforced;
            for (int itn = 0; itn < need; ++itn) {
                const float vmax = wave_max(fmaxf(fmaxf(v[0], v[1]), fmaxf(v[2], v[3])));
                if (!(vmax >= 0.f)) break;
                bool done = false;
#pragma unroll
                for (int m = 0; m < 4; ++m) {
                    const unsigned long long mk2 = __ballot(v[m] == vmax);
                    if (!done && mk2 != 0ull) {
                        const int ln = __builtin_ctzll(mk2);
                        if (lane == ln) { sel[m] = true; v[m] = -1.f; }
                        done = true;
                    }
                }
            }
#pragma unroll
            for (int m = 0; m < 4; ++m) {
                const unsigned long long bm = __ballot(sel[m]);
                if (lane == 0) selw[q * 4 + m] = bm;
                un[m] |= bm;
            }
        }
        if (lane == 0) {
#pragma unroll
            for (int m = 0; m < 4; ++m) selw[16 + m] = un[m];
        }
    }
    {
        const bfraw* Kb = (const bfraw*)(p.ws + O_KS) + (size_t)bk * TT * 64;
        const bfraw* Vb = (const bfraw*)(p.ws + O_VST) + (size_t)bk * 64 * TT;
        f32x4 O[4]; float l = 0.f;
#pragma unroll
        for (int dt = 0; dt < 4; ++dt) O[dt] = f32x4{0.f, 0.f, 0.f, 0.f};
#pragma unroll 1
        for (int m = 0; m < 4; ++m) {
            unsigned long long um = selw[16 + m];
            const unsigned long long mine = selw[qi * 4 + m];
            while (um) {
                const int bit = __builtin_ctzll(um);
                um &= um - 1ull;
                const bool colsel = (mine >> bit) & 1ull;
                const int k0 = (64 * m + bit) * 64;
                nsa_step<1>(Kb, Vb, TT, k0, qf, tpos, 0, colsel, bt, Mb2, O, l, impU, c, g);
                nsa_step<1>(Kb, Vb, TT, k0 + 32, qf, tpos, 0, colsel, bt, Mb2, O, l, impU, c, g);
            }
        }
        const float lt = grpx_sum(l);
        const float inv = lt > 0.f ? 1.f / lt : 0.f;
#pragma unroll
        for (int dt = 0; dt < 4; ++dt) ot[dt] += O[dt] * (gt1 * inv);
    }
    {
        const bfraw* Kb = (const bfraw*)(p.ws + O_KW) + (size_t)bk * TT * 64;
        const bfraw* Vb = (const bfraw*)(p.ws + O_VWT) + (size_t)bk * 64 * TT;
        f32x4 O[4]; float l = 0.f;
#pragma unroll
        for (int dt = 0; dt < 4; ++dt) O[dt] = f32x4{0.f, 0.f, 0.f, 0.f};
        int ks0 = tw0 - 511; if (ks0 < 0) ks0 = 0; ks0 &= ~31;
        for (int kb = ks0; kb <= tw0 + 3; kb += 32) nsa_step<2>(Kb, Vb, TT, kb, qf, tpos, 0, true, bt, Mb2, O, l, impU, c, g);
        const float lt = grpx_sum(l);
        const float inv = lt > 0.f ? 1.f / lt : 0.f;
#pragma unroll
        for (int dt = 0; dt < 4; ++dt) ot[dt] += O[dt] * (gt2 * inv);
    }
    bfraw* yp = (bfraw*)(p.ws + O_YCAT) + (size_t)(b * TT + tpos) * 1024 + h * 64 + 4 * g;
#pragma unroll
    for (int dt = 0; dt < 4; ++dt) st4bf(yp + dt * 16, ot[dt][0], ot[dt][1], ot[dt][2], ot[dt][3]);
    __syncthreads();
}
constexpr int N2_IMP = 71680, N2_BTAB = 138240, N2_SELW = 140320;
constexpr int N2_IMPW = 8 * 260;

template <int MODE>
DEV void nsa_tile(const bfraw* Kb, const bfraw* Vb, int key0, const bf16x8 (&qf)[2][2], const int (&tpos)[2], const int (&lim)[2], const bool (&colsel)[2],
                  const bool (&act)[2], const float* bt, bool far, float Mb2, const float (&pscale)[2], f32x4 (&O)[2][4], float (&l)[2], float* impq, int c, int g, int vld = 72, float* carry = nullptr) {
    bf16x8 pb[2][2];
    const float bfar = bt[128] - Mb2;
#pragma unroll
    for (int kt = 0; kt < 4; ++kt) {
        const bf16x8 k0 = ld8(&Kb[(kt * 16 + c) * 72 + g * 8]), k1 = ld8(&Kb[(kt * 16 + c) * 72 + 32 + g * 8]);
#pragma unroll
        for (int cg = 0; cg < 2; ++cg) {
            if (!act[cg]) continue;
            float e[4];
            if (far) {
                const float bi = (MODE == 2 && !colsel[cg]) ? -INFINITY : bfar;
                f32x4 S = mfma16(k0, qf[cg][0], f32x4{bi, bi, bi, bi});
                S = mfma16(k1, qf[cg][1], S);
#pragma unroll
                for (int r = 0; r < 4; ++r) { e[r] = ex2(S[r]); if (MODE == 1) e[r] *= pscale[cg]; l[cg] += e[r]; }
            } else {
                f32x4 S = mfma16(k0, qf[cg][0], f32x4{0.f, 0.f, 0.f, 0.f});
                S = mfma16(k1, qf[cg][1], S);
#pragma unroll
                for (int r = 0; r < 4; ++r) {
                    const int key = key0 + kt * 16 + 4 * g + r;
                    bool valid; int dist;
                    if (MODE <= 1) { dist = tpos[cg] - 16 * key - 31; valid = key < lim[cg]; }
                    else { dist = tpos[cg] - key; valid = (MODE == 2) ? (colsel[cg] && dist >= 0) : (dist >= 0 && dist < 512); }
                    const float bias = bt[dist < 0 ? 0 : (dist > 128 ? 128 : dist)] - Mb2;
                    e[r] = valid ? ex2(S[r] + bias) : 0.f;
                    if (MODE == 1) e[r] *= pscale[cg];
                    l[cg] += e[r];
                }
            }
            if (MODE == 1) {
                float a = (e[0] + e[1]) + (e[2] + e[3]), a3 = e[3];
                a += __shfl_xor(a, 1); a3 += __shfl_xor(a3, 1);
                a += __shfl_xor(a, 2); a3 += __shfl_xor(a3, 2);
                const float pu = __shfl_up(a3, 16), pw = __shfl(carry[cg], (c + 48) & 63);
                a += (g == 0) ? pw : pu;
                carry[cg] = a3;
                if ((c & 3) == 0) impq[(cg * 4 + (c >> 2)) * 260 + ((key0 + kt * 16) >> 2) + g] = a;
            }
            if (MODE != 0) {
                U4 t;
                if (kt & 1) { t.v = pb[cg][kt >> 1]; t.w[2] = pack2(e[0], e[1]); t.w[3] = pack2(e[2], e[3]); }
                else { t.w[0] = pack2(e[0], e[1]); t.w[1] = pack2(e[2], e[3]); t.w[2] = 0u; t.w[3] = 0u; }
                pb[cg][kt >> 1] = t.v;
            }
        }
    }
    if (MODE != 0) {
#pragma unroll
        for (int dt = 0; dt < 4; ++dt) {
            const bfraw* vp = &Vb[(dt * 16 + c) * vld + 4 * g];
            const bf16x8 v0 = ld4x2(vp, vp + 16), v1 = ld4x2(vp + 32, vp + 48);
#pragma unroll
            for (int cg = 0; cg < 2; ++cg) if (act[cg]) { O[cg][dt] = mfma16(v0, pb[cg][0], O[cg][dt]); O[cg][dt] = mfma16(v1, pb[cg][1], O[cg][dt]); }
        }
    }
}

DEV void nsa_item2(const Params& p, char* smem, int item) {
    const int tid = tidx(), lane = tid & 63, w = tid >> 6, c = lane & 15, g = lane >> 4;
    const int bk = item >> 8, cur = item & 255, Q0 = cur * 64, b = bk >> 1, kvh = bk & 1;
    const int hg = c & 3, h = kvh * 4 + hg;
    float* impq = (float*)(smem + N2_IMP) + w * N2_IMPW;
    float* btab = (float*)(smem + N2_BTAB);
    unsigned long long* selw = (unsigned long long*)(smem + N2_SELW) + w * 36;
    __syncthreads();
    for (int idx = tid; idx < 4 * 129; idx += NTHR) {
        const int hh = idx / 129, dd = idx % 129;
        btab[idx] = p.in[I_RELB][(dd < 128 ? t5_bucket(dd) : 31) * 8 + kvh * 4 + hh] * LOG2E;
    }
    for (int idx = lane; idx < N2_IMPW; idx += 64) impq[idx] = 0.f;
    const float mq = wave_max(fabsf(p.in[I_NSAQN][lane])), mk = wave_max(fabsf(p.in[I_NSAKN][lane]));
    const float mb = wave_max(fmaxf(fmaxf(fabsf(p.in[I_RELB][lane]), fabsf(p.in[I_RELB][64 + lane])), fmaxf(fabsf(p.in[I_RELB][128 + lane]), fabsf(p.in[I_RELB][192 + lane]))));
    const float Mb2 = (8.f * mq * mk + mb) * LOG2E;
    const float* bt = btab + hg * 129;
    int tpos[2]; bf16x8 qf[2][2];
    float* otl = impq;
#pragma unroll
    for (int cg = 0; cg < 2; ++cg) {
        tpos[cg] = Q0 + 8 * w + 4 * cg + (c >> 2);
        const bfraw* qp = (const bfraw*)(p.ws + O_QN) + ((size_t)(b * 8 + h) * TT + tpos[cg]) * 64 + 8 * g;
        qf[cg][0] = ld8(qp); qf[cg][1] = ld8(qp + 32);
    }
    const float* gbase = (const float*)(p.ws + O_SM1) + (size_t)b * TT * 40 + h * 3;
    const bool csel1[2] = {true, true};
    const float one2[2] = {1.f, 1.f};
    f32x4 Oc[2][4];
    {
        int lim[2];
#pragma unroll
        for (int cg = 0; cg < 2; ++cg) lim[cg] = tpos[cg] >= 31 ? ((tpos[cg] - 31) >> 4) + 1 : 0;
        const int ncb = ((Q0 + 32) >> 4) + 1, nct = (ncb + 63) >> 6;
        const bfraw* Kg = (const bfraw*)(p.ws + O_KCMP) + (size_t)bk * 1024 * 64;
        const bfraw* Vg = (const bfraw*)(p.ws + O_VCMPT) + (size_t)bk * 64 * 1024;
        float l[2] = {0.f, 0.f};
#pragma unroll
        for (int cg = 0; cg < 2; ++cg)
#pragma unroll
            for (int dt = 0; dt < 4; ++dt) Oc[cg][dt] = f32x4{0.f, 0.f, 0.f, 0.f};
        tile_stream<false, false>(smem, Kg, Vg, 1024, nullptr, nct, [](int t) { return t * 64; },
            [&](int t, const bfraw* Kb, const bfraw* Vb, const float*) { nsa_tile<0>(Kb, Vb, t * 64, qf, tpos, lim, csel1, csel1, bt, 1024 * t + 1039 + 128 <= Q0, Mb2, one2, Oc, l, impq, c, g); });
        float linv[2];
#pragma unroll
        for (int cg = 0; cg < 2; ++cg) { const float lt = grpx_sum(l[cg]); linv[cg] = lt > 0.f ? 1.f / lt : 0.f; l[cg] = 0.f; }
        float carry[2] = {0.f, 0.f};
        tile_stream<true, false>(smem, Kg, Vg, 1024, nullptr, nct, [](int t) { return t * 64; },
            [&](int t, const bfraw* Kb, const bfraw* Vb, const float*) { nsa_tile<1>(Kb, Vb, t * 64, qf, tpos, lim, csel1, csel1, bt, 1024 * t + 1039 + 128 <= Q0, Mb2, linv, Oc, l, impq, c, g, 72, carry); });
    }
    {
        unsigned long long un[4] = {0ull, 0ull, 0ull, 0ull};
        const int nforced = cur == 0 ? 1 : (cur == 1 ? 2 : 3);
        const int need = (cur + 1 < 16 ? cur + 1 : 16) - nforced;
#pragma unroll 1
        for (int q = 0; q < 8; ++q) {
            float v[4]; bool sel[4];
#pragma unroll
            for (int m = 0; m < 4; ++m) {
                const int s = lane + 64 * m;
                const bool inr = s <= cur;
                const bool forced = inr && (s == 0 || s == cur || s == cur - 1);
                sel[m] = forced; v[m] = (inr && !forced) ? impq[q * 260 + s] : -1.f;
            }
            for (int itn = 0; itn < need; ++itn) {
                const float vmax = wave_max(fmaxf(fmaxf(v[0], v[1]), fmaxf(v[2], v[3])));
                if (!(vmax >= 0.f)) break;
                bool done = false;
#pragma unroll
                for (int m = 0; m < 4; ++m) {
                    const unsigned long long mk2 = __ballot(v[m] == vmax);
                    if (!done && mk2 != 0ull) {
                        const int ln = __builtin_ctzll(mk2);
                        if (lane == ln) { sel[m] = true; v[m] = -1.f; }
                        done = true;
                    }
                }
            }
#pragma unroll
            for (int m = 0; m < 4; ++m) {
                const unsigned long long bm = __ballot(sel[m]);
                if (lane == 0) selw[q * 4 + m] = bm;
                un[m] |= bm;
            }
        }
        if (lane == 0) {
#pragma unroll
            for (int m = 0; m < 4; ++m) selw[32 + m] = un[m];
        }
    }
#pragma unroll
    for (int cg = 0; cg < 2; ++cg) {
        const float g0 = sigmoidf_(gbase[(size_t)tpos[cg] * 40 + 0]);
#pragma unroll
        for (int dt = 0; dt < 4; ++dt)
#pragma unroll
            for (int r = 0; r < 4; ++r) otl[((cg * 4 + dt) * 4 + r) * 64 + lane] = Oc[cg][dt][r] * g0;
    }
    {
        const bfraw* Kg = (const bfraw*)(p.ws + O_KS) + (size_t)bk * TT * 64;
        const bfraw* Vg = (const bfraw*)(p.ws + O_VST) + (size_t)bk * 64 * TT;
        f32x4 O[2][4]; float l[2] = {0.f, 0.f};
        const int lim0[2] = {0, 0};
#pragma unroll
        for (int cg = 0; cg < 2; ++cg)
#pragma unroll
            for (int dt = 0; dt < 4; ++dt) O[cg][dt] = f32x4{0.f, 0.f, 0.f, 0.f};
        tile_stream2(smem, Kg, Vg, TT, (cur + 2) >> 1, [](int t) { return t * 128; }, [&](int t) { return (2 * t + 1 <= cur ? 2 * t + 1 : cur) * 64; },
            [&](int t, const bfraw* Kb, const bfraw* Vb) {
#pragma unroll
                for (int u = 0; u < 2; ++u) {
                    const int s = 2 * t + u;
                    if (s > cur) continue;
                    const int m = s >> 6, bit = s & 63;
                    if ((selw[32 + m] >> bit) & 1ull) {
                        bool cs[2], ac[2];
                        cs[0] = (selw[(c >> 2) * 4 + m] >> bit) & 1ull;
                        cs[1] = (selw[(4 + (c >> 2)) * 4 + m] >> bit) & 1ull;
                        ac[0] = ((selw[0 + m] | selw[4 + m] | selw[8 + m] | selw[12 + m]) >> bit) & 1ull;
                        ac[1] = ((selw[16 + m] | selw[20 + m] | selw[24 + m] | selw[28 + m]) >> bit) & 1ull;
                        nsa_tile<2>(Kb + u * 64 * 72, Vb + u * 64, s * 64, qf, tpos, lim0, cs, ac, bt, cur - s >= 3, Mb2, one2, O, l, impq, c, g, 136);
                    }
                }
            });
#pragma unroll
        for (int cg = 0; cg < 2; ++cg) {
            const float lt = grpx_sum(l[cg]);
            const float sc = (lt > 0.f ? 1.f / lt : 0.f) * sigmoidf_(gbase[(size_t)tpos[cg] * 40 + 1]);
#pragma unroll
            for (int dt = 0; dt < 4; ++dt)
#pragma unroll
                for (int r = 0; r < 4; ++r) otl[((cg * 4 + dt) * 4 + r) * 64 + lane] += O[cg][dt][r] * sc;
        }
    }
    {
        const bfraw* Kg = (const bfraw*)(p.ws + O_KW) + (size_t)bk * TT * 64;
        const bfraw* Vg = (const bfraw*)(p.ws + O_VWT) + (size_t)bk * 64 * TT;
        f32x4 O[2][4]; float l[2] = {0.f, 0.f};
        const int lim0[2] = {0, 0};
#pragma unroll
        for (int cg = 0; cg < 2; ++cg)
#pragma unroll
            for (int dt = 0; dt < 4; ++dt) O[cg][dt] = f32x4{0.f, 0.f, 0.f, 0.f};
        const int j0 = cur >= 8 ? cur - 8 : 0;
        tile_stream<true, false>(smem, Kg, Vg, TT, nullptr, cur - j0 + 1, [&](int t) { return (j0 + t) * 64; },
            [&](int t, const bfraw* Kb, const bfraw* Vb, const float*) {
                const int j = j0 + t;
                nsa_tile<3>(Kb, Vb, j * 64, qf, tpos, lim0, csel1, csel1, bt, (cur - j >= 3) && (cur - j <= 6), Mb2, one2, O, l, impq, c, g);
            });
#pragma unroll
        for (int cg = 0; cg < 2; ++cg) {
            const float lt = grpx_sum(l[cg]);
            const float sc = (lt > 0.f ? 1.f / lt : 0.f) * sigmoidf_(gbase[(size_t)tpos[cg] * 40 + 2]);
            bfraw* yp = (bfraw*)(p.ws + O_YCAT) + (size_t)(b * TT + tpos[cg]) * 1024 + h * 64 + 4 * g;
#pragma unroll
            for (int dt = 0; dt < 4; ++dt) {
                const float* op = &otl[((cg * 4 + dt) * 4) * 64 + lane];
                st4bf(yp + dt * 16, op[0] + O[cg][dt][0] * sc, op[64] + O[cg][dt][1] * sc, op[128] + O[cg][dt][2] * sc, op[192] + O[cg][dt][3] * sc);
            }
        }
    }
    __syncthreads();
}
constexpr int SM_QSLOT = 148000, SM_BARW = 148016;
DEV int q_pop(unsigned* ctr, char* smem) {
    int* slot = (int*)(smem + SM_QSLOT);
    __syncthreads();
    if (tidx() == 0) *slot = (int)atomicAdd(ctr, 1u);
    __syncthreads();
    return *slot;
}

template <int P, int REP = 0> DEV void run_phase(const Params& p, char* smem) {
    unsigned* ctrs = (unsigned*)(p.ws + O_CNT);
    if constexpr (P == 0) {
        phase_prologue(p, smem);
    } else if constexpr (P == 1) {
        phase_norm1(p, p.in[I_X], 0);
    } else if constexpr (P == 2) {
        phase_inproj0(p, smem, ctrs + 512 + (2 * 3 + REP) * 8);
    } else if constexpr (P == 3) {
#ifdef DBG_NO_GDN
        for (int it = blockIdx.x; it < 16; it += gridDim.x) fox_cumsum_item(p, smem, it);
#else
        for (int it = blockIdx.x; it < 16 + 2048; it += gridDim.x) { if (it < 16) fox_cumsum_item(p, smem, it); else gdn_a_item(p, smem, it - 16); }
#endif
    } else if constexpr (P == 4) {
#if !defined(DBG_NO_GDN) && !defined(DBG_NO_SCAN)
        if (REP != 2 && blockIdx.x < 64) gdn_scan_item2(p, smem, blockIdx.x);
#endif
        for (;;) {
            const int it = q_pop(&ctrs[REP ? 4 + REP : 0], smem);
            if (it >= 1024) break;
            fox_item2(p, smem, it & 15, 63 - (it >> 4));
        }
    } else if constexpr (P == 5) {
        const int w = tidx() >> 6;
#ifdef DBG_NO_GDN
        for (size_t i = (size_t)blockIdx.x * NTHR + tidx(); i < (size_t)NT * 512; i += (size_t)gridDim.x * NTHR) ((bfraw*)(p.ws + O_YCAT))[(i >> 9) * 1024 + 512 + (i & 511)] = 0;
#elif defined(DBG_NO_GDNC)
#else
        for (int wi = blockIdx.x * 8 + w; wi < 8192; wi += gridDim.x * 8) gdn_c_witem(p, wi, REP != 0);
#endif
#ifdef DBG_NO_FOX
        for (size_t i = (size_t)blockIdx.x * NTHR + tidx(); i < (size_t)NT * 512; i += (size_t)gridDim.x * NTHR) ((bfraw*)(p.ws + O_YCAT))[(i >> 9) * 1024 + (i & 511)] = 0;
#endif
    } else if constexpr (P == 6 || P == 18) {
        constexpr int L = (P == 6) ? 0 : 1;
        phase_outproj(p, smem, L, ctrs + 512 + ((P == 6 ? 6 : 7) * 3 + REP) * 8);
        if (L == 0) phase_moe_convert(p, smem, L);
    } else if constexpr (P == 7 || P == 19) {
        phase_router(p, smem, (P == 7) ? 0 : 1, REP != 0);
    } else if constexpr (P == 8 || P == 11 || P == 20 || P == 23) {
        phase_moe1(p, smem, P >= 20 ? 1 : 0, (P == 8 || P == 20) ? 0 : 1);
        if constexpr (P == 11 || P == 23) { if (REP == 0) phase_combine(p, P >= 20 ? 1 : 0, 0, P < 20, false); }
    } else if constexpr (P == 9 || P == 12 || P == 21 || P == 24) {
        phase_moe2(p, smem, P >= 20 ? 1 : 0, (P == 9 || P == 21) ? 0 : 1);
    } else if constexpr (P == 10 || P == 13 || P == 22 || P == 25) {
        if constexpr (P == 13 || P == 25) phase_combine(p, P >= 20 ? 1 : 0, 1, P < 20, REP != 0);
    }
#ifdef HAVE_L1
    else if constexpr (P == 14) {
        phase_inproj1(p, smem, ctrs + 512 + (14 * 3 + REP) * 8);
    } else if constexpr (P == 15) {
        for (int it = blockIdx.x; it < 128 + 2048; it += gridDim.x) { if (it < 128) nsa_compress_item(p, smem, it); else gla_a_item(p, smem, it - 128); }
    } else if constexpr (P == 16) {
        for (;;) {
            const int it = q_pop(&ctrs[REP ? 8 + REP : 1], smem);
            constexpr int CVB = (MOECVT_ITEMS + 15) / 16;
            if (it >= 128 + 1024 + (REP ? 0 : CVB)) break;
            if (it >= 128 + 1024) {
                const int w = tidx() >> 6;
                float* tl = (float*)smem + w * (64 * 68);
#pragma unroll 1
                for (int u = 0; u < 2; ++u) { const int wi = (it - 1152) * 16 + u * 8 + w; if (wi < MOECVT_ITEMS) moe_convert_witem(p, tl, 1, wi); }
                continue;
            }
            if (REP && it < 128) continue;
            if (it < 128) gla_scan_item(p, it);
            else { const int f = it - 128; nsa_item2(p, smem, (f & 3) * 256 + 255 - (f >> 2)); }
        }
    } else if constexpr (P == 17) {
        const int w = tidx() >> 6;
        for (int wi = blockIdx.x * 8 + w; wi < 8192; wi += gridDim.x * 8) gla_c_witem(p, wi, REP != 0);
    }
#endif
}

template <int P, int PEND> DEV void run_range(const Params& p, char* smem, const XcdBarrier& bar) {
    constexpr bool kEmpty = (P == 10 || P == 22);
    if constexpr (!kEmpty) run_phase<P>(p, smem);
#ifdef REP_PHASE
    if constexpr (P == REP_PHASE) { xcd_barrier(bar); run_phase<P, 1>(p, smem); xcd_barrier(bar); run_phase<P, 2>(p, smem); }
#endif
    if constexpr (P + 1 < PEND) { if constexpr (!kEmpty) xcd_barrier(bar); run_range<P + 1, PEND>(p, smem, bar); }
}

#ifndef NPHASE
#define NPHASE 14
#endif

template <int P0, int P1>
__global__ void __launch_bounds__(512, 2) mk_kernel(Params p) {
    extern __shared__ __attribute__((aligned(16))) char smem[];
    if (tidx() == 0) *(uint4*)(smem + SM_BARW) = make_uint4(0u, 0u, 0u, 0u);
    __syncthreads();
    XcdBarrier bar = xcd_barrier_post((unsigned*)(p.ws + O_BAR), (volatile LAS unsigned*)(smem + SM_BARW));
    run_range<P0, P1>(p, smem, bar);
}

#ifdef DBG_SANITIZE
__global__ void k_sanitize(float* o, size_t n) { for (size_t i = (size_t)blockIdx.x * blockDim.x + tidx(); i < n; i += (size_t)gridDim.x * blockDim.x) { const float v = o[i]; if (!(fabsf(v) < 1e30f)) o[i] = 0.f; } }
#endif
template <int P> static void launch_one(const Params& p, int grid, hipStream_t stream) {
    hipFuncSetAttribute((const void*)mk_kernel<P, P + 1>, hipFuncAttributeMaxDynamicSharedMemorySize, SMEM_BYTES);
    mk_kernel<P, P + 1><<<grid, NTHR, SMEM_BYTES, stream>>>(p);
}
template <int P, int PEND> static void launch_seq(const Params& p, int grid, hipStream_t stream) {
    launch_one<P>(p, grid, stream);
    if constexpr (P + 1 < PEND) launch_seq<P + 1, PEND>(p, grid, stream);
}

extern "C" void kernel_launch(void* const* d_in, const int* in_sizes, int n_in, void* d_out, int out_size, void* d_ws, size_t ws_size, hipStream_t stream) {
    if (ws_size < WS_NEED || n_in < N_IN) return;
    Params p{};
    for (int i = 0; i < N_IN; ++i) p.in[i] = (const float*)d_in[i];
    p.out = (float*)d_out;
    p.ws = (char*)d_ws;
    hipMemsetAsync(d_ws, 0, ZERO_BYTES, stream);
#ifdef MULTI_LAUNCH
    launch_seq<0, NPHASE>(p, 256, stream);
#ifdef DBG_SANITIZE
    k_sanitize<<<1024, 256, 0, stream>>>(p.out, (size_t)NT * 1024);
#endif
#else
    static int grid = 0;
    if (!grid) {
        hipFuncSetAttribute((const void*)mk_kernel<0, NPHASE>, hipFuncAttributeMaxDynamicSharedMemorySize, SMEM_BYTES);
        int dev = 0, cus = 0, per_cu = 0;
        hipGetDevice(&dev);
        hipDeviceGetAttribute(&cus, hipDeviceAttributeMultiprocessorCount, dev);
        hipOccupancyMaxActiveBlocksPerMultiprocessor(&per_cu, (const void*)mk_kernel<0, NPHASE>, NTHR, SMEM_BYTES);
        grid = per_cu >= 1 ? cus : 0;
    }
    if (grid) mk_kernel<0, NPHASE><<<grid, NTHR, SMEM_BYTES, stream>>>(p);
#endif
}
```

```cpp
#define NPHASE 26
#include <hip/hip_runtime.h>
#include <stdint.h>

typedef unsigned short bfraw;
typedef __attribute__((ext_vector_type(8))) short bf16x8;
typedef __attribute__((ext_vector_type(4))) float f32x4;
#define DEV __device__ __forceinline__
#define LAS __attribute__((address_space(3)))

constexpr int NT = 32768, TT = 16384, DM = 1024;
constexpr float EPSF = 1e-6f;
constexpr float LOG2E = 1.4426950408889634f;
constexpr int NTHR = 512;
constexpr int SMEM_BYTES = 148480;

enum { I_X = 0, I_C, I_ADAW, I_ADAB, I_NMIX, I_NFFN, I_RELB, I_EVWIN, I_EVWOUT, I_FOXFB, I_FOXQN, I_FOXKN, I_GCONV, I_GALOG,
       I_GDTB, I_GON, I_ODWIN, I_ODWOUT, I_NSAQN, I_NSAKN, I_NSAPOS, I_CW1, I_CW2, I_GLAWG, I_GLABG, I_GLAON, I_ROUTER,
       I_MBIAS, I_MWG, I_MWU, I_MWD, I_SWG, I_SWU, I_SWD, N_IN };

struct Params {
    const float* in[N_IN];
    float* out;
    char* ws;
};

constexpr size_t MiB = 1048576;
constexpr size_t O_BAR = 0;
constexpr size_t O_CNT = 16384;
constexpr size_t O_MOD = 32768;
constexpr size_t ZERO_BYTES = 262144;
constexpr int NIN0 = 3840, NIN1 = 3072;
constexpr size_t O_WIN0 = ZERO_BYTES;
constexpr size_t O_WOUT0 = O_WIN0 + (size_t)NIN0 * 1024 * 2;
constexpr size_t O_WIN1 = O_WOUT0 + (size_t)1024 * 1024 * 2;
constexpr size_t O_WOUT1 = O_WIN1 + (size_t)NIN1 * 1024 * 2;
constexpr size_t O_WRT = O_WOUT1 + (size_t)1024 * 1024 * 2;
constexpr size_t O_W1T = O_WRT + (size_t)2 * 128 * 1024 * 2;
constexpr size_t O_W2T = O_W1T + (size_t)2 * 256 * 2048 * 2;
constexpr size_t O_BIAS1 = O_W2T + (size_t)2 * 64 * 256 * 2;
constexpr size_t O_PAIRW = O_BIAS1 + 4096;
constexpr size_t O_PLIST = O_PAIRW + (size_t)NT * 6 * 4;
constexpr size_t O_HBUF = O_PLIST + (size_t)2 * 64 * 16384 * 4;
constexpr size_t O_YCAT = O_HBUF + (size_t)NT * 1024 * 2;
constexpr size_t O_R = O_YCAT + (size_t)NT * 1024 * 2;
constexpr size_t O_WGU = O_R;
constexpr size_t O_WD = O_WGU + (size_t)65 * 512 * 1024 * 2;
constexpr size_t O_R2 = O_WD + (size_t)65 * 1024 * 256 * 2;
constexpr int HROWS = 98304 + 64 * 256 + 16384;
constexpr size_t O_H = O_R2;
constexpr size_t O_Y = O_H + (size_t)HROWS * 256 * 2;
constexpr size_t O_END_MOE = O_Y + (size_t)16384 * 7 * 1024 * 2;
constexpr size_t O_QF = O_R;
constexpr size_t O_KF = O_QF + (size_t)NT * 512 * 2;
constexpr size_t O_VFT = O_KF + (size_t)NT * 512 * 2;
constexpr size_t O_G0 = O_VFT + (size_t)NT * 512 * 2;
constexpr size_t O_GZ = O_G0 + (size_t)NT * 1536 * 2;
constexpr size_t O_SM0 = O_GZ + (size_t)NT * 512 * 2;
constexpr size_t O_CUMF = O_SM0 + (size_t)NT * 16 * 4;
constexpr size_t O_MBUF = O_CUMF + (size_t)16 * TT * 4;
constexpr size_t O_NS = O_MBUF + (size_t)2048 * 128 * 128 * 2;
constexpr size_t O_SB = O_NS + (size_t)2048 * 128 * 128 * 2;
constexpr size_t O_END_L0 = O_SB + (size_t)2048 * 128 * 128 * 2;
constexpr size_t O_QEFF = O_HBUF;
constexpr size_t O_QN = O_R2;
constexpr size_t O_KCR = O_QN + (size_t)NT * 512 * 2;
constexpr size_t O_VCR = O_KCR + (size_t)NT * 128 * 2;
constexpr size_t O_KS = O_VCR + (size_t)NT * 128 * 2;
constexpr size_t O_VST = O_KS + (size_t)NT * 128 * 2;
constexpr size_t O_KW = O_VST + (size_t)NT * 128 * 2;
constexpr size_t O_VWT = O_KW + (size_t)NT * 128 * 2;
constexpr size_t O_LQ = O_VWT + (size_t)NT * 128 * 2;
constexpr size_t O_LK = O_LQ + (size_t)NT * 256 * 2;
constexpr size_t O_LV = O_LK + (size_t)NT * 256 * 2;
constexpr size_t O_LR = O_LV + (size_t)NT * 512 * 2;
constexpr size_t O_SM1 = O_LR + (size_t)NT * 512 * 2;
constexpr size_t O_KCMP = O_SM1 + (size_t)NT * 40 * 4;
constexpr size_t O_VCMPT = O_KCMP + (size_t)4 * 1024 * 64 * 2;
constexpr size_t O_QD = O_VCMPT + (size_t)4 * 1024 * 64 * 2;
constexpr size_t O_AN = O_QD + (size_t)2048 * 64 * 64 * 2;
constexpr size_t O_ST = O_AN + (size_t)2048 * 64 * 4;
constexpr size_t O_END_L1 = O_ST + (size_t)2048 * 128 * 64 * 4;
constexpr size_t WS_NEED = (O_END_MOE > O_END_L0 ? (O_END_MOE > O_END_L1 ? O_END_MOE : O_END_L1) : (O_END_L0 > O_END_L1 ? O_END_L0 : O_END_L1));
static_assert(WS_NEED < (size_t)600 * MiB, "workspace too large");

DEV int tidx() { int t = threadIdx.x; asm volatile("" : "+v"(t)); return t; }
typedef __bf16 bf2_t __attribute__((ext_vector_type(2)));
typedef float f2_t __attribute__((ext_vector_type(2)));
DEV bfraw f2bf(float f) { return __builtin_bit_cast(bfraw, (__bf16)f); }
DEV float bf2f(bfraw b) { return __uint_as_float(((uint32_t)b) << 16); }
DEV uint32_t pack2(float lo, float hi) { f2_t f = {lo, hi}; return __builtin_bit_cast(uint32_t, __builtin_convertvector(f, bf2_t)); }
DEV float lo2f(uint32_t u) { return __uint_as_float(u << 16); }
DEV float hi2f(uint32_t u) { return __uint_as_float(u & 0xffff0000u); }
DEV f32x4 mfma16(bf16x8 a, bf16x8 b, f32x4 c) { return __builtin_amdgcn_mfma_f32_16x16x32_bf16(a, b, c, 0, 0, 0); }
DEV float sigmoidf_(float x) { return 1.f / (1.f + __expf(-x)); }
DEV float siluf_(float x) { return x / (1.f + __expf(-x)); }
DEV float softplusf_(float x) { return fmaxf(x, 0.f) + log1pf(__expf(-fabsf(x))); }
DEV float logsigmoidf_(float x) { return fminf(x, 0.f) - log1pf(__expf(-fabsf(x))); }
DEV float ex2(float x) { return __builtin_amdgcn_exp2f(x); }
DEV void vm_drain() { asm volatile("s_waitcnt vmcnt(0)" ::: "memory"); }
DEV void lds_barrier() { asm volatile("s_waitcnt lgkmcnt(0)" ::: "memory"); __builtin_amdgcn_s_barrier(); asm volatile("" ::: "memory"); }
DEV void block_sync_mem() { asm volatile("s_waitcnt vmcnt(0) lgkmcnt(0)" ::: "memory"); __syncthreads(); }
union U4 { uint4 u; bf16x8 v; uint32_t w[4]; };
union U2 { uint2 u; uint32_t w[2]; };
DEV bf16x8 ld8(const bfraw* p) { U4 t; t.u = *(const uint4*)p; return t.v; }
DEV bf16x8 ld4x2(const bfraw* p0, const bfraw* p1) { U4 t; uint2 a = *(const uint2*)p0, b = *(const uint2*)p1; t.w[0] = a.x; t.w[1] = a.y; t.w[2] = b.x; t.w[3] = b.y; return t.v; }
DEV bf16x8 pack8(float a0, float a1, float a2, float a3, float a4, float a5, float a6, float a7) {
    U4 t; t.w[0] = pack2(a0, a1); t.w[1] = pack2(a2, a3); t.w[2] = pack2(a4, a5); t.w[3] = pack2(a6, a7); return t.v; }
DEV void st4bf(bfraw* p, float a, float b, float c, float d) { uint2 v; v.x = pack2(a, b); v.y = pack2(c, d); *(uint2*)p = v; }
DEV float shx(float v, int m) { const int l = tidx(); return __int_as_float(__builtin_amdgcn_ds_bpermute(((l ^ m) & 63) << 2, __float_as_int(v))); }
DEV float wave_sum(float v) { for (int m = 32; m >= 1; m >>= 1) v += shx(v, m); return v; }
DEV float wave_max(float v) { for (int m = 32; m >= 1; m >>= 1) v = fmaxf(v, shx(v, m)); return v; }
DEV float grp16_sum(float v) { v += shx(v, 1); v += shx(v, 2); v += shx(v, 4); v += shx(v, 8); return v; }
DEV float grpx_sum(float v) { v += shx(v, 16); v += shx(v, 32); return v; }

#define XB_TMO      128
#define XB_XCNT(j)  (256  + 64 * (j))
#define XB_XSUB(j)  (1280 + 64 * (j))
#define XB_XGEN(j)  (2304 + 64 * (j))
#define XB_TOP      3328
#define XB_TOPGEN   3392
#define XCD_BAR_WORDS 3456
#define XB_SPIN_CAP (1u << 27)
DEV unsigned xb_ld(unsigned* p)              { return __hip_atomic_load(p, __ATOMIC_RELAXED, __HIP_MEMORY_SCOPE_AGENT); }
DEV unsigned xb_add(unsigned* p, unsigned v) { return __hip_atomic_fetch_add(p, v, __ATOMIC_RELAXED, __HIP_MEMORY_SCOPE_AGENT); }
DEV unsigned xb_xcc_id() { return (unsigned)__builtin_amdgcn_s_getreg((3 << 11) | 20) & 0xFu; }
#define XB_SPIN(cond, bar) do { unsigned _sp = 0; while (cond) { __builtin_amdgcn_s_sleep(1); \
    if ((++_sp & 255u) == 0u) { if (xb_ld(&(bar)[XB_TMO])) break; if (_sp > XB_SPIN_CAP) { atomicAdd(&(bar)[XB_TMO], 1u); break; } } } } while (0)
struct XcdBarrier { unsigned* bar; unsigned x; volatile LAS unsigned* st; };
DEV XcdBarrier xcd_barrier_post(unsigned* bar, volatile LAS unsigned* st) {
    XcdBarrier b; b.bar = bar; b.x = xb_xcc_id(); b.st = st;
    if (tidx() == 0) (void)xb_add(&bar[XB_XCNT(b.x)], 1u);
    return b;
}
DEV void xcd_barrier_complete(unsigned* bar, unsigned x, unsigned& nloc, unsigned& nx) {
    const unsigned G = gridDim.x * gridDim.y * gridDim.z;
    unsigned sum, cnt, mine, sp = 0u;
    for (;;) {
        sum = 0u; cnt = 0u; mine = 0u;
#pragma unroll
        for (unsigned j = 0; j < 16; ++j) { const unsigned c = xb_ld(&bar[XB_XCNT(j)]); sum += c; cnt += (c > 0u) ? 1u : 0u; mine = (j == x) ? c : mine; }
        if (sum == G) break;
        __builtin_amdgcn_s_sleep(1);
        if ((++sp & 255u) == 0u) { if (xb_ld(&bar[XB_TMO])) break; if (sp > XB_SPIN_CAP) { atomicAdd(&bar[XB_TMO], 1u); break; } }
    }
    nloc = mine > 0u ? mine : 1u; nx = cnt > 0u ? cnt : 1u;
}
DEV void xcd_barrier(const XcdBarrier& b) {
    asm volatile("s_waitcnt vmcnt(0)" ::: "memory");
    __syncthreads();
    if (tidx() == 0) {
        unsigned* bar = b.bar;
        __builtin_amdgcn_s_waitcnt(0);
        unsigned nloc = b.st[0], nx = b.st[1];
        if (nloc == 0u) { xcd_barrier_complete(bar, b.x, nloc, nx); b.st[0] = nloc; b.st[1] = nx; }
        const unsigned old = xb_add(&bar[XB_XSUB(b.x)], 1u);
        const unsigned gen = old / nloc;
        if (old + 1u == (gen + 1u) * nloc) {
            __builtin_amdgcn_fence(__ATOMIC_RELEASE, "agent");
            asm volatile("s_waitcnt vmcnt(0)" ::: "memory");
            const unsigned og = xb_add(&bar[XB_TOP], 1u);
            const unsigned tg = og / nx;
            if (og + 1u == (tg + 1u) * nx) xb_add(&bar[XB_TOPGEN], 1u);
            else XB_SPIN(xb_ld(&bar[XB_TOPGEN]) == tg, bar);
            __builtin_amdgcn_fence(__ATOMIC_ACQUIRE, "agent");
            xb_add(&bar[XB_XGEN(b.x)], 1u);
            asm volatile("s_waitcnt vmcnt(0)" ::: "memory");
        } else {
            XB_SPIN(xb_ld(&bar[XB_XGEN(b.x)]) == gen, bar);
            __builtin_amdgcn_fence(__ATOMIC_ACQUIRE, "agent");
            asm volatile("s_waitcnt vmcnt(0)" ::: "memory");
        }
    }
    __syncthreads();
}

template <class AP, class BP, class EPI>
DEV void gemm_tile(char* smem, int nk, int a_kstep, AP aptr, BP bptr, EPI epi) {
    bfraw* As = (bfraw*)smem; bfraw* Bs = As + 256 * 72;
    const int tid = tidx(), lane = tid & 63, w = tid >> 6, wr = w >> 1, wc = w & 1;
    const int seg = tid & 7, r0 = tid >> 3;
    const bfraw* pa[4]; const bfraw* pb[2];
#pragma unroll
    for (int i = 0; i < 4; ++i) pa[i] = aptr(r0 + 64 * i) + seg * 8;
#pragma unroll
    for (int i = 0; i < 2; ++i) pb[i] = bptr(r0 + 64 * i) + seg * 8;
    uint4 ra0 = *(const uint4*)pa[0], ra1 = *(const uint4*)pa[1], ra2 = *(const uint4*)pa[2], ra3 = *(const uint4*)pa[3];
    uint4 rb0 = *(const uint4*)pb[0], rb1 = *(const uint4*)pb[1];
    f32x4 acc[4][4];
#pragma unroll
    for (int i = 0; i < 4; ++i)
#pragma unroll
        for (int j = 0; j < 4; ++j) acc[i][j] = f32x4{0.f, 0.f, 0.f, 0.f};
    for (int kt = 0; kt < nk; ++kt) {
        __syncthreads();
        *(uint4*)&As[(r0) * 72 + seg * 8] = ra0;
        *(uint4*)&As[(r0 + 64) * 72 + seg * 8] = ra1;
        *(uint4*)&As[(r0 + 128) * 72 + seg * 8] = ra2;
        *(uint4*)&As[(r0 + 192) * 72 + seg * 8] = ra3;
        *(uint4*)&Bs[(r0) * 72 + seg * 8] = rb0;
        *(uint4*)&Bs[(r0 + 64) * 72 + seg * 8] = rb1;
        __syncthreads();
        if (kt + 1 < nk) {
            const size_t ao = (size_t)(kt + 1) * a_kstep, bo = (size_t)(kt + 1) * 64;
            ra0 = *(const uint4*)(pa[0] + ao); ra1 = *(const uint4*)(pa[1] + ao); ra2 = *(const uint4*)(pa[2] + ao); ra3 = *(const uint4*)(pa[3] + ao);
            rb0 = *(const uint4*)(pb[0] + bo); rb1 = *(const uint4*)(pb[1] + bo);
        }
#pragma unroll
        for (int ks = 0; ks < 2; ++ks) {
            bf16x8 af[4], bfr[4];
#pragma unroll
            for (int i = 0; i < 4; ++i) af[i] = ld8(&As[(wr * 64 + i * 16 + (lane & 15)) * 72 + ks * 32 + (lane >> 4) * 8]);
#pragma unroll
            for (int j = 0; j < 4; ++j) bfr[j] = ld8(&Bs[(wc * 64 + j * 16 + (lane & 15)) * 72 + ks * 32 + (lane >> 4) * 8]);
#pragma unroll
            for (int i = 0; i < 4; ++i)
#pragma unroll
                for (int j = 0; j < 4; ++j) acc[i][j] = mfma16(af[i], bfr[j], acc[i][j]);
        }
    }
    epi(acc, wr * 64, wc * 64, lane);
}

constexpr int GLD = 72;
constexpr int GBUF = 512 * GLD;
template <bool AFFA = true, bool SGB = true, class AP, class BP, class EPI>
DEV void gemm_tile2(char* smem, int nk, int a_kstep, AP aptr, BP bptr, EPI epi) {
    bfraw* As = (bfraw*)smem;
    const int tid = tidx(), lane = tid & 63, w = tid >> 6, wr = w >> 2, wc = w & 3;
    const int seg = tid & 7, r0 = tid >> 3;
    const bfraw* pa0 = aptr(r0) + seg * 8;
    const int ast = (int)(aptr(r0 + 64) - aptr(r0));
    const bfraw* pa1 = AFFA ? pa0 + ast : aptr(r0 + 64) + seg * 8; const bfraw* pa2 = AFFA ? pa0 + 2 * ast : aptr(r0 + 128) + seg * 8; const bfraw* pa3 = AFFA ? pa0 + 3 * ast : aptr(r0 + 192) + seg * 8;
    const bfraw* pb0 = bptr(r0) + seg * 8;
    const int bst = (int)(bptr(r0 + 64) - bptr(r0));
    uint4 ra0 = *(const uint4*)pa0, ra1 = *(const uint4*)pa1, ra2 = *(const uint4*)pa2, ra3 = *(const uint4*)pa3;
    uint4 rb0 = *(const uint4*)pb0, rb1 = *(const uint4*)(pb0 + bst), rb2 = *(const uint4*)(pb0 + 2 * bst), rb3 = *(const uint4*)(pb0 + 3 * bst);
    f32x4 acc[8][4];
#pragma unroll
    for (int i = 0; i < 8; ++i)
#pragma unroll
        for (int j = 0; j < 4; ++j) acc[i][j] = f32x4{0.f, 0.f, 0.f, 0.f};
    const int so = r0 * GLD + seg * 8;
    const int fo = (lane & 15) * GLD + (lane >> 4) * 8;
    lds_barrier();
    {
        bfraw* Aw = As + so;
        *(uint4*)&Aw[0] = ra0; *(uint4*)&Aw[64 * GLD] = ra1; *(uint4*)&Aw[128 * GLD] = ra2; *(uint4*)&Aw[192 * GLD] = ra3;
        *(uint4*)&Aw[256 * GLD] = rb0; *(uint4*)&Aw[320 * GLD] = rb1; *(uint4*)&Aw[384 * GLD] = rb2; *(uint4*)&Aw[448 * GLD] = rb3;
        const size_t ao = (size_t)a_kstep, bo = 64;
        __builtin_amdgcn_sched_barrier(0);
        ra0 = *(const uint4*)(pa0 + ao); __builtin_amdgcn_sched_barrier(0); rb0 = *(const uint4*)(pb0 + bo); __builtin_amdgcn_sched_barrier(0);
        ra1 = *(const uint4*)(pa1 + ao); __builtin_amdgcn_sched_barrier(0); rb1 = *(const uint4*)(pb0 + (bst + bo)); __builtin_amdgcn_sched_barrier(0);
        ra2 = *(const uint4*)(pa2 + ao); __builtin_amdgcn_sched_barrier(0); rb2 = *(const uint4*)(pb0 + (2 * bst + bo)); __builtin_amdgcn_sched_barrier(0);
        ra3 = *(const uint4*)(pa3 + ao); __builtin_amdgcn_sched_barrier(0); rb3 = *(const uint4*)(pb0 + (3 * bst + bo)); __builtin_amdgcn_sched_barrier(0);
    }
#define GT_WL(i, W, L)                                                                                                               \
    if (W) {                                                                                                                         \
        if (i == 0) { *(uint4*)&Aw[0] = ra0; if (L) ra0 = *(const uint4*)(pa0 + ao); }                                               \
        if (i == 1) { *(uint4*)&Aw[256 * GLD] = rb0; if (L) rb0 = *(const uint4*)(pb0 + bo); }                                       \
        if (i == 2) { *(uint4*)&Aw[64 * GLD] = ra1; if (L) ra1 = *(const uint4*)(pa1 + ao); }                                        \
        if (i == 3) { *(uint4*)&Aw[320 * GLD] = rb1; if (L) rb1 = *(const uint4*)(pb0 + (bst + bo)); }                               \
        if (i == 4) { *(uint4*)&Aw[128 * GLD] = ra2; if (L) ra2 = *(const uint4*)(pa2 + ao); }                                       \
        if (i == 5) { *(uint4*)&Aw[384 * GLD] = rb2; if (L) rb2 = *(const uint4*)(pb0 + (2 * bst + bo)); }                           \
        if (i == 6) { *(uint4*)&Aw[192 * GLD] = ra3; if (L) ra3 = *(const uint4*)(pa3 + ao); }                                       \
        if (i == 7) { *(uint4*)&Aw[448 * GLD] = rb3; if (L) rb3 = *(const uint4*)(pb0 + (3 * bst + bo)); }                           \
    }
#define GT_BODY(W, L)                                                                                                                \
    {                                                                                                                                \
        lds_barrier();                                                                                                               \
        const int cur = kt & 1;                                                                                                      \
        const bfraw* Ac = As + cur * GBUF + fo;                                                                                      \
        bfraw* Aw = As + (cur ^ 1) * GBUF + so;                                                                                      \
        const size_t ao = (size_t)(kt + 2) * a_kstep, bo = (size_t)(kt + 2) * 64;                                                    \
        _Pragma("unroll") for (int ks = 0; ks < 2; ++ks) {                                                                           \
            const bfraw* Ab = Ac + (wr * 128) * GLD + ks * 32;                                                                       \
            const bfraw* Bb = Ac + (256 + wc * 64) * GLD + ks * 32;                                                                  \
            bf16x8 bfr[4], af[8];                                                                                                    \
            _Pragma("unroll") for (int j = 0; j < 4; ++j) bfr[j] = ld8(Bb + j * 16 * GLD);                                           \
            af[0] = ld8(Ab); af[1] = ld8(Ab + 16 * GLD);                                                                             \
            _Pragma("unroll") for (int i = 0; i < 8; ++i) {                                                                          \
                _Pragma("unroll") for (int j = 0; j < 4; ++j) acc[i][j] = mfma16(bfr[j], af[i], acc[i][j]);                          \
                if (i + 2 < 8) af[i + 2] = ld8(Ab + (i + 2) * 16 * GLD);                                                             \
                if (ks == 1) { GT_WL(i, W, L) }                                                                                      \
            }                                                                                                                        \
            if (SGB) {                                                                                                               \
                __builtin_amdgcn_sched_group_barrier(0x100, 6, 0);                                                                   \
                _Pragma("unroll") for (int i = 0; i < 8; ++i) {                                                                      \
                    __builtin_amdgcn_sched_group_barrier(0x008, 4, 0);                                                               \
                    if (i + 2 < 8) __builtin_amdgcn_sched_group_barrier(0x100, 1, 0);                                                \
                    if (ks == 1 && W) __builtin_amdgcn_sched_group_barrier(0x200, 1, 0);                                             \
                    if (ks == 1 && W && L) __builtin_amdgcn_sched_group_barrier(0x020, 1, 0);                                        \
                }                                                                                                                    \
            }                                                                                                                        \
        }                                                                                                                            \
    }
    int kt = 0;
    for (; kt + 2 < nk; ++kt) GT_BODY(1, 1)
    GT_BODY(1, 0)
    ++kt;
    GT_BODY(0, 0)
#undef GT_BODY
#undef GT_WL
    epi(acc, wr * 128, wc * 64, lane);
}

DEV bool xq_next(unsigned* q, int nN, char* smem, int& mt, int& nt) {
    int* slot = (int*)(smem + 148000);
    __syncthreads();
    if (tidx() == 0) {
        const int T = 16 * nN, x0 = (int)xb_xcc_id() & 7;
        int res = -1;
        for (int k = 0; k < 8 && res < 0; ++k) {
            const int x = (x0 + k) & 7;
            if (xb_ld(&q[x]) < (unsigned)T) { const unsigned s = atomicAdd(&q[x], 1u); if (s < (unsigned)T) res = x * T + (int)s; }
        }
        *slot = res;
    }
    __syncthreads();
    const int res = *slot;
    if (res < 0) return false;
    const int T = 16 * nN, x = res / T, s = res % T, mg = s / (4 * nN), rem = s % (4 * nN);
    nt = rem >> 2; mt = x * 16 + mg * 4 + (rem & 3);
    return true;
}

DEV bool xs_tile(int nN, int rr, int& mt, int& nt) {
    const int T = 16 * nN;
    int G = (int)gridDim.x, bid = (int)blockIdx.x;
    asm volatile("" : "+s"(G), "+s"(bid));
    int gidx;
    if ((G & 7) == 0) { const int bpx = G >> 3, s = (bid >> 3) + bpx * rr; if (s >= T) return false; gidx = (bid & 7) * T + s; }
    else { gidx = bid + G * rr; if (gidx >= 8 * T) return false; }
    const int x = gidx / T, s = gidx % T, mg = s / (4 * nN), rem = s % (4 * nN);
    nt = __builtin_amdgcn_readfirstlane(rem >> 2); mt = __builtin_amdgcn_readfirstlane(x * 16 + mg * 4 + (rem & 3));
    return true;
}

template <class CM>
DEV void tr_tile_w(float* tl, const float* src, size_t ldsrc, bfraw* dst, size_t lddst, int k0, int n0, CM cmap) {
    const int lane = tidx() & 63;
    const int c4 = (lane & 15) * 4, r = lane >> 4;
    const int sc = cmap(n0 + c4);
    float4 v[16];
#pragma unroll
    for (int ps = 0; ps < 16; ++ps) v[ps] = sc >= 0 ? *(const float4*)(src + (size_t)(k0 + ps * 4 + r) * ldsrc + sc) : make_float4(0.f, 0.f, 0.f, 0.f);
#pragma unroll
    for (int ps = 0; ps < 16; ++ps) *(float4*)&tl[(ps * 4 + r) * 68 + c4] = v[ps];
    const int n = lane;
#pragma unroll
    for (int ks = 0; ks < 8; ++ks) {
        float q[8];
#pragma unroll
        for (int j = 0; j < 8; ++j) q[j] = tl[(ks * 8 + j) * 68 + n];
        uint4 o; o.x = pack2(q[0], q[1]); o.y = pack2(q[2], q[3]); o.z = pack2(q[4], q[5]); o.w = pack2(q[6], q[7]);
        *(uint4*)&dst[(size_t)(n0 + n) * lddst + k0 + ks * 8] = o;
    }
}
template <class CM>
DEV void tr_tile(char* smem, const float* src, size_t ldsrc, bfraw* dst, size_t lddst, int k0, int n0, CM cmap) {
    float* tl = (float*)smem;
    const int tid = tidx();
    {
        const int c = tid & 63, r = tid >> 6;
        const int sc = cmap(n0 + c);
#pragma unroll
        for (int ps = 0; ps < 8; ++ps) {
            const int k = ps * 8 + r;
            tl[k * 65 + c] = sc >= 0 ? src[(size_t)(k0 + k) * ldsrc + sc] : 0.f;
        }
    }
    __syncthreads();
    {
        const int n = tid >> 3, ks = tid & 7;
        float v[8];
#pragma unroll
        for (int q = 0; q < 8; ++q) v[q] = tl[(ks * 8 + q) * 65 + n];
        uint4 o; o.x = pack2(v[0], v[1]); o.y = pack2(v[2], v[3]); o.z = pack2(v[4], v[5]); o.w = pack2(v[6], v[7]);
        *(uint4*)&dst[(size_t)(n0 + n) * lddst + k0 + ks * 8] = o;
    }
    __syncthreads();
}
DEV int map_in0(int n) {
    if (n < 1536) return n;
    if (n < 3072) return 1544 + (n - 1536);
    if (n < 3584) return 3088 + (n - 3072);
    if (n < 3592) return 1536 + (n - 3584);
    if (n < 3596) return 3080 + (n - 3592);
    if (n < 3600) return 3084 + (n - 3596);
    return -1;
}
DEV int map_in1(int n) {
    if (n < 1280) return n;
    if (n < 1536) return 1304 + (n - 1280);
    if (n < 1792) return 1560 + (n - 1536);
    if (n < 2304) return 1816 + (n - 1792);
    if (n < 2816) return 2344 + (n - 2304);
    if (n < 2840) return 1280 + (n - 2816);
    if (n < 2856) return 2328 + (n - 2840);
    return -1;
}

DEV void prologue_item(const Params& p, char* smem, int item) {
    const int tid = tidx();
    {
        const int l = item / 96, nch = item % 96;
        const int n = nch * 64 + (tid & 63), kg = tid >> 6, k0 = kg * 128;
        const float* W = p.in[I_ADAW] + (size_t)l * 1024 * 6144;
        const float* c = p.in[I_C];
        float a0 = 0.f, a1 = 0.f;
#pragma unroll 8
        for (int k = 0; k < 128; ++k) {
            const float wv = W[(size_t)(k0 + k) * 6144 + n];
            a0 += siluf_(c[k0 + k]) * wv; a1 += siluf_(c[1024 + k0 + k]) * wv;
        }
        float* red = (float*)smem;
        __syncthreads();
        red[tid] = a0; red[512 + tid] = a1;
        __syncthreads();
        if (tid < 128) {
            const int bb = tid >> 6, nn = tid & 63;
            float sacc = p.in[I_ADAB][l * 6144 + nch * 64 + nn];
#pragma unroll
            for (int q = 0; q < 8; ++q) sacc += red[bb * 512 + q * 64 + nn];
            ((float*)(p.ws + O_MOD))[(l * 2 + bb) * 6144 + nch * 64 + nn] = sacc;
        }
        __syncthreads();
    }
}
constexpr int PRO_WITEMS = 960 + 256 + 768 + 256 + 64 + 256 + 8;
DEV void prologue_witem(const Params& p, float* tl, int item) {
    if (item < 960) { tr_tile_w(tl, p.in[I_EVWIN], 3600, (bfraw*)(p.ws + O_WIN0), 1024, (item % 16) * 64, (item / 16) * 64, [](int n) { return map_in0(n); }); return; }
    item -= 960;
    if (item < 256) { tr_tile_w(tl, p.in[I_EVWOUT], 1024, (bfraw*)(p.ws + O_WOUT0), 1024, (item % 16) * 64, (item / 16) * 64, [](int n) { return n; }); return; }
    item -= 256;
    if (item < 768) { tr_tile_w(tl, p.in[I_ODWIN], 2856, (bfraw*)(p.ws + O_WIN1), 1024, (item % 16) * 64, (item / 16) * 64, [](int n) { return map_in1(n); }); return; }
    item -= 768;
    if (item < 256) { tr_tile_w(tl, p.in[I_ODWOUT], 1024, (bfraw*)(p.ws + O_WOUT1), 1024, (item % 16) * 64, (item / 16) * 64, [](int n) { return n; }); return; }
    item -= 256;
    if (item < 64) {
        const int l = item / 32, rem = item % 32;
        tr_tile_w(tl, p.in[I_ROUTER] + (size_t)l * 1024 * 64, 64, (bfraw*)(p.ws + O_WRT) + (size_t)l * 128 * 1024, 1024, (rem % 16) * 64, (rem / 16) * 64, [](int n) { return n < 64 ? n : -1; });
        return;
    }
    item -= 64;
    if (item < 256) {
        const int wh = item / 128, rem = item % 128;
        tr_tile_w(tl, p.in[I_CW1] + (size_t)wh * 2048 * 256, 256, (bfraw*)(p.ws + O_W1T) + (size_t)wh * 256 * 2048, 2048, (rem % 32) * 64, (rem / 32) * 64, [](int n) { return n; });
        return;
    }
    item -= 256;
    { const int wh = item / 4, kt = item % 4;
      tr_tile_w(tl, p.in[I_CW2] + (size_t)wh * 256 * 64, 64, (bfraw*)(p.ws + O_W2T) + (size_t)wh * 64 * 256, 256, kt * 64, 0, [](int n) { return n; }); }
}
DEV void prologue_bias1(const Params& p, char* smem, int wh) {
    const int tid = tidx();
    const float* pos = p.in[I_NSAPOS] + wh * 2048;
    const float* w1 = p.in[I_CW1] + (size_t)wh * 2048 * 256;
    const int j = tid & 255, kh = tid >> 8;
    float a = 0.f;
    for (int kk = kh * 1024; kk < kh * 1024 + 1024; ++kk) a += pos[kk] * w1[(size_t)kk * 256 + j];
    float* red = (float*)smem;
    __syncthreads();
    if (kh == 1) red[j] = a;
    __syncthreads();
    if (kh == 0) ((float*)(p.ws + O_BIAS1))[wh * 256 + j] = a + red[j];
    __syncthreads();
}
DEV void phase_prologue(const Params& p, char* smem) {
    for (int it = blockIdx.x; it < 192 + 2; it += gridDim.x) { if (it < 192) prologue_item(p, smem, it); else prologue_bias1(p, smem, it - 192); }
    const int w = tidx() >> 6;
    float* tl = (float*)smem + w * (64 * 68);
    __syncthreads();
    for (int it = blockIdx.x * 8 + w; it < PRO_WITEMS; it += gridDim.x * 8) prologue_witem(p, tl, it);
    __syncthreads();
}

constexpr int MOECVT_ITEMS = 65 * 192;
DEV void moe_convert_witem(const Params& p, float* tl, int layer, int item) {
    const int e = item / 192, s = item % 192;
    bfraw* wgu = (bfraw*)(p.ws + O_WGU) + (size_t)e * 512 * 1024;
    bfraw* wd = (bfraw*)(p.ws + O_WD) + (size_t)e * 1024 * 256;
    const size_t eo = (size_t)(layer * 64 + e) * 1024 * 256, so = (size_t)layer * 1024 * 256;
    if (s < 64) {
        const float* src = e < 64 ? p.in[I_MWG] + eo : p.in[I_SWG] + so;
        tr_tile_w(tl, src, 256, wgu, 1024, (s % 16) * 64, (s / 16) * 64, [](int n) { return n; });
    } else if (s < 128) {
        const int s2 = s - 64;
        const float* src = e < 64 ? p.in[I_MWU] + eo : p.in[I_SWU] + so;
        tr_tile_w(tl, src, 256, wgu + (size_t)256 * 1024, 1024, (s2 % 16) * 64, (s2 / 16) * 64, [](int n) { return n; });
    } else {
        const int s2 = s - 128;
        const float* src = e < 64 ? p.in[I_MWD] + eo : p.in[I_SWD] + so;
        tr_tile_w(tl, src, 1024, wd, 256, (s2 % 4) * 64, (s2 / 4) * 64, [](int n) { return n; });
    }
}
DEV void phase_moe_convert(const Params& p, char* smem, int layer) {
    const int w = tidx() >> 6;
    float* tl = (float*)smem + w * (64 * 68);
    __syncthreads();
    for (int it = blockIdx.x * 8 + w; it < MOECVT_ITEMS; it += gridDim.x * 8) moe_convert_witem(p, tl, layer, it);
    __syncthreads();
}

DEV void norm_row(const float* xrow, const float* gain, const float* sc, const float* sh, bfraw* drow, int lane) {
    float4 v[4]; float ss = 0.f;
#pragma unroll
    for (int i = 0; i < 4; ++i) { v[i] = *(const float4*)(xrow + lane * 4 + 256 * i); ss += v[i].x * v[i].x + v[i].y * v[i].y + v[i].z * v[i].z + v[i].w * v[i].w; }
    ss = wave_sum(ss);
    const float rs = rsqrtf(ss * (1.f / 1024.f) + EPSF);
#pragma unroll
    for (int i = 0; i < 4; ++i) {
        const int c = lane * 4 + 256 * i;
        const float4 g = *(const float4*)(gain + c), s1 = *(const float4*)(sc + c), s0 = *(const float4*)(sh + c);
        st4bf(drow + c, v[i].x * rs * g.x * (1.f + s1.x) + s0.x, v[i].y * rs * g.y * (1.f + s1.y) + s0.y,
                        v[i].z * rs * g.z * (1.f + s1.z) + s0.z, v[i].w * rs * g.w * (1.f + s1.w) + s0.w);
    }
}
DEV const float* modp(const Params& p, int layer, int b, int chunk) { return (const float*)(p.ws + O_MOD) + (size_t)(layer * 2 + b) * 6144 + chunk * 1024; }

DEV void phase_norm1(const Params& p, const float* xsrc, int layer) {
    const int lane = tidx() & 63, w = tidx() >> 6;
    bfraw* hb = (bfraw*)(p.ws + O_HBUF);
    for (int row = blockIdx.x * 8 + w; row < NT; row += gridDim.x * 8) {
        const int b = row >> 14;
        norm_row(xsrc + (size_t)row * 1024, p.in[I_NMIX] + layer * 1024, modp(p, layer, b, 1), modp(p, layer, b, 0), hb + (size_t)row * 1024, lane);
    }
}

template <int NI>
DEV void epi2_headnorm(const f32x4 (&acc)[NI][4], int lane, const float* gain, float mul, bfraw* dst, size_t rstride) {
    const int c = lane & 15, g = lane >> 4;
    float4 gn[4];
#pragma unroll
    for (int j = 0; j < 4; ++j) { gn[j] = *(const float4*)(gain + j * 16 + 4 * g); gn[j].x *= mul; gn[j].y *= mul; gn[j].z *= mul; gn[j].w *= mul; }
#pragma unroll
    for (int i = 0; i < NI; ++i) {
        float ss = 0.f;
#pragma unroll
        for (int j = 0; j < 4; ++j) ss += acc[i][j][0] * acc[i][j][0] + acc[i][j][1] * acc[i][j][1] + acc[i][j][2] * acc[i][j][2] + acc[i][j][3] * acc[i][j][3];
        ss = grpx_sum(ss);
        const float rs = rsqrtf(ss * (1.f / 64.f) + EPSF);
        bfraw* d = dst + (size_t)(i * 16 + c) * rstride + 4 * g;
#pragma unroll
        for (int j = 0; j < 4; ++j) st4bf(d + j * 16, acc[i][j][0] * rs * gn[j].x, acc[i][j][1] * rs * gn[j].y, acc[i][j][2] * rs * gn[j].z, acc[i][j][3] * rs * gn[j].w);
    }
}
template <int NI>
DEV void epi2_store_bf16(const f32x4 (&acc)[NI][4], int lane, bfraw* dst, size_t rstride) {
    const int c = lane & 15, g = lane >> 4;
#pragma unroll
    for (int i = 0; i < NI; ++i) {
        bfraw* d = dst + (size_t)(i * 16 + c) * rstride + 4 * g;
#pragma unroll
        for (int j = 0; j < 4; ++j) st4bf(d + j * 16, acc[i][j][0], acc[i][j][1], acc[i][j][2], acc[i][j][3]);
    }
}
template <int NI>
DEV void epi2_store_T(const f32x4 (&acc)[NI][4], int lane, bfraw* dstT, size_t cstride) {
    const int c = lane & 15, g = lane >> 4;
#pragma unroll
    for (int i = 0; i < NI; ++i)
#pragma unroll
        for (int j = 0; j < 4; ++j)
#pragma unroll
            for (int r = 0; r < 4; ++r) dstT[(size_t)(j * 16 + 4 * g + r) * cstride + i * 16 + c] = f2bf(acc[i][j][r]);
}

DEV void phase_inproj0(const Params& p, char* smem, unsigned* xq) {
    const bfraw* A = (const bfraw*)(p.ws + O_HBUF);
    const bfraw* Bt = (const bfraw*)(p.ws + O_WIN0);
    constexpr int NTL = NIN0 / 256;
    for (int rr = 0;; ++rr) {
        int mt, nt;
        if (!xs_tile(NTL, rr, mt, nt)) break;
        const int m0 = __builtin_amdgcn_readfirstlane(mt * 256), n0 = __builtin_amdgcn_readfirstlane(nt * 256);
        gemm_tile2(smem, 16, 64,
            [&](int r) { return A + (size_t)(m0 + r) * 1024; },
            [&](int r) { return Bt + (size_t)(n0 + r) * 1024; },
            [&](const f32x4 (&acc)[8][4], int rb, int cbk, int lane) {
                const int cb = n0 + cbk;
                const int tok0 = m0 + rb;
                const int b = tok0 >> 14, t0 = tok0 & (TT - 1);
                if (cb < 512) {
                    const int hh = cb >> 6;
                    epi2_headnorm<8>(acc, lane, p.in[I_FOXQN], 0.125f * LOG2E, (bfraw*)(p.ws + O_QF) + ((size_t)(b * 8 + hh) * TT + t0) * 64, 64);
                } else if (cb < 1024) {
                    const int hh = (cb - 512) >> 6;
                    epi2_headnorm<8>(acc, lane, p.in[I_FOXKN], 1.f, (bfraw*)(p.ws + O_KF) + ((size_t)(b * 8 + hh) * TT + t0) * 64, 64);
                } else if (cb < 1536) {
                    const int hh = (cb - 1024) >> 6;
                    epi2_store_T<8>(acc, lane, (bfraw*)(p.ws + O_VFT) + (size_t)(b * 8 + hh) * 64 * TT + t0, TT);
                } else if (cb < 3072) {
                    epi2_store_bf16<8>(acc, lane, (bfraw*)(p.ws + O_G0) + (size_t)tok0 * 1536 + (cb - 1536), 1536);
                } else if (cb < 3584) {
                    epi2_store_bf16<8>(acc, lane, (bfraw*)(p.ws + O_GZ) + (size_t)tok0 * 512 + (cb - 3072), 512);
                } else if (cb == 3584) {
                    const int c = lane & 15, g = lane >> 4;
                    float* sm = (float*)(p.ws + O_SM0);
#pragma unroll
                    for (int i = 0; i < 8; ++i) *(float4*)&sm[(size_t)(tok0 + i * 16 + c) * 16 + 4 * g] = make_float4(acc[i][0][0], acc[i][0][1], acc[i][0][2], acc[i][0][3]);
                }
            });
    }
}

DEV void fox_cumsum_item(const Params& p, char* smem, int item) {
    const int b = item >> 3, h = item & 7, tid = tidx();
    const float* sm = (const float*)(p.ws + O_SM0);
    const float fb = p.in[I_FOXFB][h];
    float v[32]; float run = 0.f;
    const int tb = tid * 32;
#pragma unroll
    for (int i = 0; i < 32; ++i) { run += logsigmoidf_(sm[(size_t)(b * TT + tb + i) * 16 + h] + fb) * LOG2E; v[i] = run; }
    float* red = (float*)smem;
    __syncthreads();
    red[tid] = run;
    __syncthreads();
    if (tid < 64) {
        float s[8]; float a = 0.f;
#pragma unroll
        for (int i = 0; i < 8; ++i) { a += red[tid * 8 + i]; s[i] = a; }
        float incl = a;
        for (int m = 1; m < 64; m <<= 1) { const float o = __shfl_up(incl, m); if (tid >= m) incl += o; }
        const float excl = incl - a;
#pragma unroll
        for (int i = 0; i < 8; ++i) red[512 + tid * 8 + i] = excl + s[i] - red[tid * 8 + i];
    }
    __syncthreads();
    const float off = red[512 + tid];
    float* cf = (float*)(p.ws + O_CUMF) + (size_t)item * TT + tb;
#pragma unroll
    for (int i = 0; i < 32; ++i) cf[i] = v[i] + off;
    __syncthreads();
}
DEV void fox_item(const Params& p, int bh, int qb) {
    const int lane = tidx() & 63, w = tidx() >> 6, c = lane & 15, g = lane >> 4;
    const int b = bh >> 3, h = bh & 7;
    const bfraw* Q = (const bfraw*)(p.ws + O_QF) + (size_t)bh * TT * 64;
    const bfraw* K = (const bfraw*)(p.ws + O_KF) + (size_t)bh * TT * 64;
    const bfraw* VT = (const bfraw*)(p.ws + O_VFT) + (size_t)bh * 64 * TT;
    const float* cum = (const float*)(p.ws + O_CUMF) + (size_t)bh * TT;
    const float mq = wave_max(fabsf(p.in[I_FOXQN][lane])), mk = wave_max(fabsf(p.in[I_FOXKN][lane]));
    const float Mb2 = 8.f * mq * mk * LOG2E;
    const int q0w = qb * 256 + w * 32;
    int tq[2]; float cq[2]; bf16x8 qf[2][2]; f32x4 O[2][4]; float l[2];
#pragma unroll
    for (int cg = 0; cg < 2; ++cg) {
        tq[cg] = q0w + cg * 16 + c; cq[cg] = cum[tq[cg]] - Mb2; l[cg] = 0.f;
#pragma unroll
        for (int ks = 0; ks < 2; ++ks) qf[cg][ks] = ld8(Q + (size_t)tq[cg] * 64 + ks * 32 + g * 8);
#pragma unroll
        for (int dt = 0; dt < 4; ++dt) O[cg][dt] = f32x4{0.f, 0.f, 0.f, 0.f};
    }
    for (int kb = 0; kb <= q0w; kb += 32) {
        bf16x8 kf[2][2], vf[4]; float4 ck[2];
#pragma unroll
        for (int kt = 0; kt < 2; ++kt) {
#pragma unroll
            for (int ks = 0; ks < 2; ++ks) kf[kt][ks] = ld8(K + (size_t)(kb + kt * 16 + c) * 64 + ks * 32 + g * 8);
            ck[kt] = *(const float4*)(cum + kb + kt * 16 + 4 * g);
        }
#pragma unroll
        for (int dt = 0; dt < 4; ++dt) { const bfraw* vp = VT + (size_t)(dt * 16 + c) * TT + kb + 4 * g; vf[dt] = ld4x2(vp, vp + 16); }
        const bool diag = (kb == q0w);
#pragma unroll
        for (int cg = 0; cg < 2; ++cg) {
            float pr[2][4];
#pragma unroll
            for (int kt = 0; kt < 2; ++kt) {
                f32x4 S = mfma16(kf[kt][0], qf[cg][0], f32x4{0.f, 0.f, 0.f, 0.f});
                S = mfma16(kf[kt][1], qf[cg][1], S);
                const float ckv[4] = {ck[kt].x, ck[kt].y, ck[kt].z, ck[kt].w};
#pragma unroll
                for (int r = 0; r < 4; ++r) {
                    float e = ex2(S[r] + cq[cg] - ckv[r]);
                    if (diag && (kb + kt * 16 + 4 * g + r > tq[cg])) e = 0.f;
                    pr[kt][r] = e; l[cg] += e;
                }
            }
            const bf16x8 pb = pack8(pr[0][0], pr[0][1], pr[0][2], pr[0][3], pr[1][0], pr[1][1], pr[1][2], pr[1][3]);
#pragma unroll
            for (int dt = 0; dt < 4; ++dt) O[cg][dt] = mfma16(vf[dt], pb, O[cg][dt]);
        }
    }
    bfraw* yc = (bfraw*)(p.ws + O_YCAT);
#pragma unroll
    for (int cg = 0; cg < 2; ++cg) {
        const float inv = 1.f / grpx_sum(l[cg]);
        bfraw* d = yc + (size_t)(b * TT + tq[cg]) * 1024 + h * 64 + 4 * g;
#pragma unroll
        for (int dt = 0; dt < 4; ++dt) st4bf(d + dt * 16, O[cg][dt][0] * inv, O[cg][dt][1] * inv, O[cg][dt][2] * inv, O[cg][dt][3] * inv);
    }
}

constexpr int GA_XR = 0, GA_LM = 17408, GA_KB = 36864, GA_KDT = 54272, GA_ATT = 72704, GA_SM = 81920, GA_RHS = 83968, GA_RAW = 117760;
DEV float gdn_conv_at(const bfraw* G0, const float* cw, int b, int t, int col, float& x3, float& x2, float& x1) {
    const float x = bf2f(G0[(size_t)(b * TT + t) * 1536 + col]);
    const float y = cw[0 * 1536 + col] * x3 + cw[1 * 1536 + col] * x2 + cw[2 * 1536 + col] * x1 + cw[3 * 1536 + col] * x;
    x3 = x2; x2 = x1; x1 = x;
    return siluf_(y);
}
DEV int opaque_tid() { return tidx(); }
#define OPQ_TID() const int tid = opaque_tid(), lane = tid & 63, w = tid >> 6, c = lane & 15, g = lane >> 4; (void)lane; (void)w; (void)c; (void)g
DEV void gdn_a_item(const Params& p, char* smem, int item) {
    const int bh = item >> 8, n = item & 255, b = bh >> 2, h = bh & 3, t0 = n * 64;
    const bfraw* G0 = (const bfraw*)(p.ws + O_G0);
    const float* cw = p.in[I_GCONV];
    bfraw* qbuf = (bfraw*)(smem + GA_XR);
    float* Lm = (float*)(smem + GA_LM);
    bfraw* XT = (bfraw*)(smem + GA_XR);
    bfraw* kbuf = (bfraw*)(smem + GA_KB);
    bfraw* kdT = (bfraw*)(smem + GA_KDT);
    bfraw* att = (bfraw*)(smem + GA_ATT);
    float* gc = (float*)(smem + GA_SM);
    bfraw* rhs = (bfraw*)(smem + GA_RHS);
    float* beta = gc + 64; float* eg = gc + 128; float* ed = gc + 192;
    __syncthreads();
    bfraw* raw = (bfraw*)(smem + GA_RAW);
    for (int m = 0; m < 2; ++m) {
        {
            OPQ_TID();
            for (int ch = tid; ch < 67 * 16; ch += NTHR) {
                const int rr = ch >> 4, cc = (ch & 15) * 8, tt = t0 - 3 + rr;
                uint4 v = make_uint4(0u, 0u, 0u, 0u);
                if (tt >= 0) v = *(const uint4*)(G0 + (size_t)(b * TT + tt) * 1536 + m * 512 + h * 128 + cc);
                *(uint4*)&raw[rr * 128 + cc] = v;
            }
        }
        __syncthreads();
        {
            OPQ_TID();
            const int d = tid & 127, qt = tid >> 7, col = m * 512 + h * 128 + d, i0 = qt * 16;
            bfraw* dstb = m ? kbuf : qbuf;
            const float w0 = cw[col], w1 = cw[1536 + col], w2 = cw[2 * 1536 + col], w3 = cw[3 * 1536 + col];
            float x3 = bf2f(raw[(i0) * 128 + d]), x2 = bf2f(raw[(i0 + 1) * 128 + d]), x1 = bf2f(raw[(i0 + 2) * 128 + d]);
#pragma unroll 4
            for (int i = i0; i < i0 + 16; ++i) {
                const float x = bf2f(raw[(i + 3) * 128 + d]);
                dstb[i * 136 + d] = f2bf(siluf_(w0 * x3 + w1 * x2 + w2 * x1 + w3 * x));
                x3 = x2; x2 = x1; x1 = x;
            }
        }
        __syncthreads();
    }
    { OPQ_TID();
    if (w == 0) {
        const float* sm = (const float*)(p.ws + O_SM0) + (size_t)(b * TT + t0 + lane) * 16;
        const float gv = -__expf(p.in[I_GALOG][h]) * softplusf_(sm[8 + h] + p.in[I_GDTB][h]);
        float incl = gv;
        for (int m = 1; m < 64; m <<= 1) { const float o = __shfl_up(incl, m); if (lane >= m) incl += o; }
        const float gl = __shfl(incl, 63);
        gc[lane] = incl; beta[lane] = sigmoidf_(sm[12 + h]); eg[lane] = __expf(incl); ed[lane] = __expf(gl - incl);
        if (lane == 0) gc[256] = __expf(gl);
    } }
    __syncthreads();
    { OPQ_TID();
#pragma unroll 1
    for (int rr = 0; rr < 8; ++rr) {
        const int i = w * 8 + rr;
        uint32_t* qp = (uint32_t*)&qbuf[i * 136 + lane * 2];
        uint32_t* kp = (uint32_t*)&kbuf[i * 136 + lane * 2];
        const uint32_t qv = *qp, kv = *kp;
        const float q0 = lo2f(qv), q1 = hi2f(qv), k0 = lo2f(kv), k1 = hi2f(kv);
        const float qs = wave_sum(q0 * q0 + q1 * q1), ks = wave_sum(k0 * k0 + k1 * k1);
        const float qi = rsqrtf(qs + EPSF) * 0.08838834764831845f, ki = rsqrtf(ks + EPSF);
        *qp = pack2(q0 * qi, q1 * qi);
        *kp = pack2(k0 * ki, k1 * ki);
        const float e = ed[i];
        kdT[(lane * 2) * 72 + i] = f2bf(k0 * ki * e);
        kdT[(lane * 2 + 1) * 72 + i] = f2bf(k1 * ki * e);
    } }
    __syncthreads();
    {
        OPQ_TID();
        const int mat = w >> 2, ti = w & 3;
        const bfraw* Ab = mat ? qbuf : kbuf;
        f32x4 acc[4];
#pragma unroll
        for (int j = 0; j < 4; ++j) acc[j] = f32x4{0.f, 0.f, 0.f, 0.f};
#pragma unroll
        for (int ks = 0; ks < 4; ++ks) {
            const bf16x8 a = ld8(&Ab[(ti * 16 + c) * 136 + ks * 32 + g * 8]);
#pragma unroll
            for (int j = 0; j < 4; ++j) acc[j] = mfma16(a, ld8(&kbuf[(j * 16 + c) * 136 + ks * 32 + g * 8]), acc[j]);
        }
#pragma unroll
        for (int j = 0; j < 4; ++j)
#pragma unroll
            for (int r = 0; r < 4; ++r) {
                const int i = ti * 16 + 4 * g + r, jj = j * 16 + c;
                const float dec = __expf(gc[i] - gc[jj]);
                if (mat == 0) Lm[i * 64 + jj] = (i > jj) ? beta[i] * acc[j][r] * dec : 0.f;
                else att[i * 72 + jj] = f2bf((i >= jj) ? acc[j][r] * dec : 0.f);
            }
        const int i = tid >> 3, d0 = (tid & 7) * 16;
        const float e = eg[i];
        bfraw* qe = (bfraw*)(p.ws + O_QEFF) + ((size_t)item * 64 + i) * 128 + d0;
        U4 oa, ob;
#pragma unroll
        for (int q = 0; q < 4; ++q) {
            const uint32_t v = *(const uint32_t*)&qbuf[i * 136 + d0 + 2 * q]; oa.w[q] = pack2(lo2f(v) * e, hi2f(v) * e);
            const uint32_t v2 = *(const uint32_t*)&qbuf[i * 136 + d0 + 8 + 2 * q]; ob.w[q] = pack2(lo2f(v2) * e, hi2f(v2) * e);
        }
        *(uint4*)qe = oa.u; *(uint4*)(qe + 8) = ob.u;
    }
    lds_barrier();
    {
        OPQ_TID();
        for (int ch = tid; ch < 67 * 16; ch += NTHR) {
            const int rr = ch >> 4, cc = (ch & 15) * 8, tt = t0 - 3 + rr;
            uint4 v = make_uint4(0u, 0u, 0u, 0u);
            if (tt >= 0) v = *(const uint4*)(G0 + (size_t)(b * TT + tt) * 1536 + 1024 + h * 128 + cc);
            *(uint4*)&raw[rr * 128 + cc] = v;
        }
    }
    __syncthreads();
    {
        OPQ_TID();
        const int d = tid & 127, qt = tid >> 7, col = 1024 + h * 128 + d, i0 = qt * 16;
        const float w0 = cw[col], w1 = cw[1536 + col], w2 = cw[2 * 1536 + col], w3 = cw[3 * 1536 + col];
        float x3 = bf2f(raw[(i0) * 128 + d]), x2 = bf2f(raw[(i0 + 1) * 128 + d]), x1 = bf2f(raw[(i0 + 2) * 128 + d]);
#pragma unroll 4
        for (int i = i0; i < i0 + 16; ++i) {
            const float x = bf2f(raw[(i + 3) * 128 + d]);
            rhs[i * 264 + d] = f2bf(siluf_(w0 * x3 + w1 * x2 + w2 * x1 + w3 * x) * beta[i]);
            rhs[i * 264 + 128 + d] = f2bf(bf2f(kbuf[i * 136 + d]) * beta[i] * eg[i]);
            x3 = x2; x2 = x1; x1 = x;
        }
    }
    __syncthreads();
    float x[64];
    const int tid = opaque_tid();
    if (tid < 256) {
#pragma unroll
        for (int i = 0; i < 64; ++i) {
            float s = bf2f(rhs[i * 264 + tid]), s2 = 0.f;
            const float4* Lr = (const float4*)&Lm[i * 64];
#pragma unroll
            for (int j4 = 0; j4 < (i + 3) / 4; ++j4) {
                const float4 lv = Lr[j4];
                s -= lv.x * x[j4 * 4];
                if (j4 * 4 + 1 < i) s2 -= lv.y * x[j4 * 4 + 1];
                if (j4 * 4 + 2 < i) s -= lv.z * x[j4 * 4 + 2];
                if (j4 * 4 + 3 < i) s2 -= lv.w * x[j4 * 4 + 3];
            }
            s += s2;
            asm volatile("" : "+v"(s) :: "memory");
            x[i] = s;
        }
    }
    __syncthreads();
    if (tid < 256) {
#pragma unroll
        for (int q = 0; q < 8; ++q) {
            uint4 o; o.x = pack2(x[q * 8 + 0], x[q * 8 + 1]); o.y = pack2(x[q * 8 + 2], x[q * 8 + 3]); o.z = pack2(x[q * 8 + 4], x[q * 8 + 5]); o.w = pack2(x[q * 8 + 6], x[q * 8 + 7]);
            *(uint4*)&XT[tid * 72 + q * 8] = o;
        }
    }
    block_sync_mem();
    {
        OPQ_TID();
        f32x4 a3[4], a4[4];
#pragma unroll
        for (int it = 0; it < 4; ++it) { a3[it] = f32x4{0.f, 0.f, 0.f, 0.f}; a4[it] = f32x4{0.f, 0.f, 0.f, 0.f}; }
#pragma unroll
        for (int ks = 0; ks < 2; ++ks) {
            const bf16x8 aw = ld8(&XT[(128 + w * 16 + c) * 72 + ks * 32 + g * 8]);
            const bf16x8 au = ld8(&XT[(w * 16 + c) * 72 + ks * 32 + g * 8]);
#pragma unroll
            for (int it = 0; it < 4; ++it) {
                const bf16x8 bt = ld8(&att[(it * 16 + c) * 72 + ks * 32 + g * 8]);
                a3[it] = mfma16(aw, bt, a3[it]); a4[it] = mfma16(au, bt, a4[it]);
            }
        }
        bfraw* qe = (bfraw*)(p.ws + O_QEFF) + (size_t)item * 64 * 128;
        bfraw* yc = (bfraw*)(p.ws + O_YCAT);
#pragma unroll
        for (int it = 0; it < 4; ++it) {
            const int i = it * 16 + c, d = w * 16 + 4 * g;
            bfraw* qp = qe + (size_t)i * 128 + d;
            const uint2 qv = *(const uint2*)qp;
            st4bf(qp, lo2f(qv.x) - a3[it][0], hi2f(qv.x) - a3[it][1], lo2f(qv.y) - a3[it][2], hi2f(qv.y) - a3[it][3]);
            st4bf(yc + (size_t)(b * TT + t0 + i) * 1024 + 512 + h * 128 + d, a4[it][0], a4[it][1], a4[it][2], a4[it][3]);
        }
    }
    {
        OPQ_TID();
        const float egl = gc[256];
        bfraw* Mb = (bfraw*)(p.ws + O_MBUF) + (size_t)item * 16384;
        bfraw* Nb = (bfraw*)(p.ws + O_NS) + (size_t)item * 16384;
#pragma unroll 1
        for (int half = 0; half < 2; ++half) {
            f32x4 a5[4], a6[4];
#pragma unroll
            for (int q = 0; q < 4; ++q) { a5[q] = f32x4{0.f, 0.f, 0.f, 0.f}; a6[q] = f32x4{0.f, 0.f, 0.f, 0.f}; }
#pragma unroll
            for (int ks = 0; ks < 2; ++ks) {
                const bf16x8 aw = ld8(&XT[(128 + w * 16 + c) * 72 + ks * 32 + g * 8]);
                const bf16x8 ak = ld8(&kdT[(w * 16 + c) * 72 + ks * 32 + g * 8]);
#pragma unroll
                for (int q = 0; q < 4; ++q) {
                    const int tl = half * 4 + q;
                    a5[q] = mfma16(aw, ld8(&kdT[(tl * 16 + c) * 72 + ks * 32 + g * 8]), a5[q]);
                    a6[q] = mfma16(ak, ld8(&XT[(tl * 16 + c) * 72 + ks * 32 + g * 8]), a6[q]);
                }
            }
#pragma unroll
            for (int q = 0; q < 4; ++q) {
                const int tl = half * 4 + q;
                const int d = tl * 16 + c, dp = w * 16 + 4 * g;
                st4bf(Mb + (size_t)d * 128 + dp, (d == dp ? egl : 0.f) - a5[q][0], (d == dp + 1 ? egl : 0.f) - a5[q][1],
                      (d == dp + 2 ? egl : 0.f) - a5[q][2], (d == dp + 3 ? egl : 0.f) - a5[q][3]);
                const int e = tl * 16 + c, dd = w * 16 + 4 * g;
                st4bf(Nb + (size_t)e * 128 + dd, a6[q][0], a6[q][1], a6[q][2], a6[q][3]);
            }
        }
    }
    lds_barrier();
}

DEV void gdn_scan_item(const Params& p, int bh) {
    const int lane = tidx() & 63, w = tidx() >> 6, c = lane & 15, g = lane >> 4;
    const int e = w * 16 + c;
    f32x4 S[8];
#pragma unroll
    for (int dt = 0; dt < 8; ++dt) S[dt] = f32x4{0.f, 0.f, 0.f, 0.f};
    const bfraw* MB = (const bfraw*)(p.ws + O_MBUF) + (size_t)bh * 256 * 16384;
    bfraw* NB = (bfraw*)(p.ws + O_NS) + (size_t)bh * 256 * 16384;
    for (int n = 0; n < 256; ++n) {
        const bfraw* M = MB + (size_t)n * 16384;
        bfraw* N = NB + (size_t)n * 16384 + (size_t)e * 128 + 4 * g;
        bf16x8 bs[4];
#pragma unroll
        for (int s = 0; s < 4; ++s) bs[s] = pack8(S[2 * s][0], S[2 * s][1], S[2 * s][2], S[2 * s][3], S[2 * s + 1][0], S[2 * s + 1][1], S[2 * s + 1][2], S[2 * s + 1][3]);
        uint2 nf[8];
#pragma unroll
        for (int dt = 0; dt < 8; ++dt) nf[dt] = *(const uint2*)(N + dt * 16);
        asm volatile("s_waitcnt vmcnt(0)" ::: "memory");
#pragma unroll
        for (int dt = 0; dt < 8; ++dt) st4bf(N + dt * 16, S[dt][0], S[dt][1], S[dt][2], S[dt][3]);
#pragma unroll
        for (int dt = 0; dt < 8; ++dt) {
            f32x4 acc = f32x4{lo2f(nf[dt].x), hi2f(nf[dt].x), lo2f(nf[dt].y), hi2f(nf[dt].y)};
#pragma unroll
            for (int s = 0; s < 4; ++s) {
                const bfraw* mp = M + (size_t)(dt * 16 + c) * 128 + 32 * s + 4 * g;
                acc = mfma16(ld4x2(mp, mp + 16), bs[s], acc);
            }
            S[dt] = acc;
        }
    }
}

DEV void gdn_c_witem(const Params& p, int witem, bool dry = false) {
    const int lane = tidx() & 63, c = lane & 15, g = lane >> 4;
    const int item = witem >> 2, it = witem & 3;
    const int bh = item >> 8, n = item & 255, b = bh >> 2, h = bh & 3;
    const bfraw* Sb = (const bfraw*)(p.ws + O_SB) + (size_t)item * 16384;
    const bfraw* Qe = (const bfraw*)(p.ws + O_QEFF) + (size_t)item * 64 * 128;
    f32x4 acc[8];
#pragma unroll
    for (int et = 0; et < 8; ++et) acc[et] = f32x4{0.f, 0.f, 0.f, 0.f};
#pragma unroll
    for (int ks = 0; ks < 4; ++ks) {
        const bf16x8 bq = ld8(Qe + (size_t)(it * 16 + c) * 128 + ks * 32 + g * 8);
#pragma unroll
        for (int et = 0; et < 8; ++et) acc[et] = mfma16(ld8(Sb + (size_t)(et * 16 + c) * 128 + ks * 32 + g * 8), bq, acc[et]);
    }
    const int tok = b * TT + n * 64 + it * 16 + c;
    bfraw* yp = (bfraw*)(p.ws + O_YCAT) + (size_t)tok * 1024 + 512 + h * 128 + 4 * g;
    const bfraw* gz = (const bfraw*)(p.ws + O_GZ) + (size_t)tok * 512 + h * 128 + 4 * g;
    float ss = 0.f;
#pragma unroll
    for (int et = 0; et < 8; ++et) {
        const uint2 o0 = *(const uint2*)(yp + et * 16);
        acc[et][0] += lo2f(o0.x); acc[et][1] += hi2f(o0.x); acc[et][2] += lo2f(o0.y); acc[et][3] += hi2f(o0.y);
        ss += acc[et][0] * acc[et][0] + acc[et][1] * acc[et][1] + acc[et][2] * acc[et][2] + acc[et][3] * acc[et][3];
    }
    ss = grpx_sum(ss);
    const float rs = rsqrtf(ss * (1.f / 128.f) + EPSF);
#pragma unroll
    for (int et = 0; et < 8; ++et) {
        const uint2 zv = *(const uint2*)(gz + et * 16);
        const float4 gn = *(const float4*)(p.in[I_GON] + et * 16 + 4 * g);
        st4bf((dry ? (bfraw*)(p.ws + O_MBUF) + (size_t)tok * 1024 + 4 * g : yp) + et * 16, acc[et][0] * rs * gn.x * siluf_(lo2f(zv.x)), acc[et][1] * rs * gn.y * siluf_(hi2f(zv.x)),
                            acc[et][2] * rs * gn.z * siluf_(lo2f(zv.y)), acc[et][3] * rs * gn.w * siluf_(hi2f(zv.y)));
    }
}
constexpr int TS_K = 0, TS_V = 18432, TS_C = 36864;
template <bool WITHV, bool WITHC, class KEYOF, class BODY>
DEV void tile_stream(char* smem, const bfraw* Kg, const bfraw* Vg, size_t vstride, const float* Cg, int ntiles, KEYOF key_of, BODY body) {
    const int tid = tidx(), srow = tid >> 3, sseg = tid & 7;
    bfraw* Kl = (bfraw*)(smem + TS_K); bfraw* Vl = (bfraw*)(smem + TS_V); float* Cl = (float*)(smem + TS_C);
    if (ntiles <= 0) return;
    uint4 ka, va = make_uint4(0u, 0u, 0u, 0u), kb = make_uint4(0u, 0u, 0u, 0u), vb = make_uint4(0u, 0u, 0u, 0u);
    float4 ca = make_float4(0.f, 0.f, 0.f, 0.f), cb = make_float4(0.f, 0.f, 0.f, 0.f);
    auto ldt = [&](int t, uint4& rk, uint4& rv, float4& rc) {
        const int k0 = key_of(t);
        rk = *(const uint4*)(Kg + (size_t)(k0 + srow) * 64 + sseg * 8);
        if (WITHV) rv = *(const uint4*)(Vg + (size_t)srow * vstride + k0 + sseg * 8);
        if (WITHC) { if (tid < 16) rc = *(const float4*)(Cg + k0 + 4 * tid); }
    };
    auto stt = [&](int buf, const uint4& rk, const uint4& rv, const float4& rc) {
        *(uint4*)&Kl[buf * 64 * 72 + srow * 72 + sseg * 8] = rk;
        if (WITHV) *(uint4*)&Vl[buf * 64 * 72 + srow * 72 + sseg * 8] = rv;
        if (WITHC) { if (tid < 16) *(float4*)&Cl[buf * 64 + 4 * tid] = rc; }
    };
    __syncthreads();
    ldt(0, ka, va, ca);
    if (ntiles > 1) ldt(1, kb, vb, cb);
    stt(0, ka, va, ca);
    lds_barrier();
    for (int t = 0; t < ntiles; t += 2) {
        if (t + 2 < ntiles) ldt(t + 2, ka, va, ca);
        body(t, Kl, Vl, Cl);
        if (t + 1 < ntiles) stt(1, kb, vb, cb);
        lds_barrier();
        if (t + 1 >= ntiles) break;
        if (t + 3 < ntiles) ldt(t + 3, kb, vb, cb);
        body(t + 1, Kl + 64 * 72, Vl + 64 * 72, Cl + 64);
        if (t + 2 < ntiles) stt(0, ka, va, ca);
        lds_barrier();
    }
}

constexpr int TS2_K = 0, TS2_V = 36864, TS2_END = 71680;
template <class KEYOF, class KEYOF2, class BODY>
DEV void tile_stream2(char* smem, const bfraw* Kg, const bfraw* Vg, size_t vstride, int ntiles, KEYOF key_of, KEYOF2 key_of2, BODY body) {
    const int tid = tidx(), srow = tid >> 3, sseg = tid & 7;
    bfraw* Kl = (bfraw*)(smem + TS2_K); bfraw* Vl = (bfraw*)(smem + TS2_V);
    if (ntiles <= 0) return;
    uint4 ka0, ka1, va0, va1, kb0 = make_uint4(0u, 0u, 0u, 0u), kb1 = kb0, vb0 = kb0, vb1 = kb0;
#define TS2_LD(T, K0, K1, V0, V1) { const int a0 = key_of(T), a1 = key_of2(T); K0 = *(const uint4*)(Kg + (size_t)(a0 + srow) * 64 + sseg * 8); K1 = *(const uint4*)(Kg + (size_t)(a1 + srow) * 64 + sseg * 8); \
        V0 = *(const uint4*)(Vg + (size_t)srow * vstride + a0 + sseg * 8); V1 = *(const uint4*)(Vg + (size_t)srow * vstride + a1 + sseg * 8); }
#define TS2_ST(BUF, K0, K1, V0, V1) { bfraw* kp = Kl + (BUF) * 128 * 72 + srow * 72 + sseg * 8; *(uint4*)kp = K0; *(uint4*)(kp + 64 * 72) = K1; \
        bfraw* vp = Vl + (BUF) * 64 * 136 + srow * 136 + sseg * 8; *(uint4*)vp = V0; *(uint4*)(vp + 64) = V1; }
    __syncthreads();
    TS2_LD(0, ka0, ka1, va0, va1)
    if (ntiles > 1) TS2_LD(1, kb0, kb1, vb0, vb1)
    TS2_ST(0, ka0, ka1, va0, va1)
    lds_barrier();
    for (int t = 0; t < ntiles; t += 2) {
        if (t + 2 < ntiles) TS2_LD(t + 2, ka0, ka1, va0, va1)
        body(t, Kl, Vl);
        if (t + 1 < ntiles) TS2_ST(1, kb0, kb1, vb0, vb1)
        lds_barrier();
        if (t + 1 >= ntiles) break;
        if (t + 3 < ntiles) TS2_LD(t + 3, kb0, kb1, vb0, vb1)
        body(t + 1, Kl + 128 * 72, Vl + 64 * 136);
        if (t + 2 < ntiles) TS2_ST(0, ka0, ka1, va0, va1)
        lds_barrier();
    }
#undef TS2_LD
#undef TS2_ST
}

DEV void fox_item2(const Params& p, char* smem, int bh, int qb) {
    const int tid = tidx(), lane = tid & 63, w = tid >> 6, c = lane & 15, g = lane >> 4;
    const int b = bh >> 3, h = bh & 7;
    const bfraw* Q = (const bfraw*)(p.ws + O_QF) + (size_t)bh * TT * 64;
    const bfraw* K = (const bfraw*)(p.ws + O_KF) + (size_t)bh * TT * 64;
    const bfraw* VT = (const bfraw*)(p.ws + O_VFT) + (size_t)bh * 64 * TT;
    const float* cum = (const float*)(p.ws + O_CUMF) + (size_t)bh * TT;
    const float mq = wave_max(fabsf(p.in[I_FOXQN][lane])), mk = wave_max(fabsf(p.in[I_FOXKN][lane]));
    const float Mb2 = 8.f * mq * mk * LOG2E;
    const float thr = -(105.f + 16.f * mq * mk) * LOG2E;
    const int Q0 = qb * 256, q0w = Q0 + w * 32, jw = q0w >> 6, jmax = (Q0 >> 6) + 3;
    int* red = (int*)(smem + TS_C + 1024);
    __syncthreads();
    if (tid == 0) red[0] = 0;
    __syncthreads();
    {
        const float cq0 = cum[Q0];
        bool dead = false;
        if (tid <= jmax && tid < 256) dead = (cq0 - cum[64 * tid + 63] < thr);
        const unsigned long long bm = __ballot(dead);
        if (lane == 0 && bm) atomicMax(red, w * 64 + 64 - __builtin_clzll(bm));
    }
    __syncthreads();
    const int jmin = red[0];
    int tq[2]; float cq[2]; bf16x8 qf[2][2]; f32x4 O[2][4]; float l[2];
#pragma unroll
    for (int cg = 0; cg < 2; ++cg) {
        tq[cg] = q0w + cg * 16 + c; cq[cg] = cum[tq[cg]] - Mb2; l[cg] = 0.f;
#pragma unroll
        for (int ks = 0; ks < 2; ++ks) qf[cg][ks] = ld8(Q + (size_t)tq[cg] * 64 + ks * 32 + g * 8);
#pragma unroll
        for (int dt = 0; dt < 4; ++dt) O[cg][dt] = f32x4{0.f, 0.f, 0.f, 0.f};
    }
    tile_stream<true, true>(smem, K, VT, TT, cum, jmax - jmin + 1, [&](int t) { return (jmax - t) * 64; },
        [&](int t, const bfraw* Kb, const bfraw* Vb, const float* Cb) {
            const int j = jmax - t;
            if (j > jw) return;
            const bool diag = (j == jw);
            bf16x8 pb[2][2];
#pragma unroll
            for (int kt = 0; kt < 4; ++kt) {
                const bf16x8 k0 = ld8(&Kb[(kt * 16 + c) * 72 + g * 8]), k1 = ld8(&Kb[(kt * 16 + c) * 72 + 32 + g * 8]);
                const float4 ck = *(const float4*)&Cb[kt * 16 + 4 * g];
#pragma unroll
                for (int cg = 0; cg < 2; ++cg) {
                    f32x4 S = f32x4{cq[cg] - ck.x, cq[cg] - ck.y, cq[cg] - ck.z, cq[cg] - ck.w};
                    S = mfma16(k0, qf[cg][0], S);
                    S = mfma16(k1, qf[cg][1], S);
                    float e[4];
#pragma unroll
                    for (int r = 0; r < 4; ++r) {
                        e[r] = ex2(S[r]);
                        if (diag && (64 * j + kt * 16 + 4 * g + r > tq[cg])) e[r] = 0.f;
                        l[cg] += e[r];
                    }
                    U4 tt;
                    if (kt & 1) { tt.v = pb[cg][kt >> 1]; tt.w[2] = pack2(e[0], e[1]); tt.w[3] = pack2(e[2], e[3]); }
                    else { tt.w[0] = pack2(e[0], e[1]); tt.w[1] = pack2(e[2], e[3]); tt.w[2] = 0u; tt.w[3] = 0u; }
                    pb[cg][kt >> 1] = tt.v;
                }
            }
#pragma unroll
            for (int dt = 0; dt < 4; ++dt) {
                const bfraw* vp = &Vb[(dt * 16 + c) * 72 + 4 * g];
                const bf16x8 v0 = ld4x2(vp, vp + 16), v1 = ld4x2(vp + 32, vp + 48);
#pragma unroll
                for (int cg = 0; cg < 2; ++cg) { O[cg][dt] = mfma16(v0, pb[cg][0], O[cg][dt]); O[cg][dt] = mfma16(v1, pb[cg][1], O[cg][dt]); }
            }
        });
    bfraw* yc = (bfraw*)(p.ws + O_YCAT);
#pragma unroll
    for (int cg = 0; cg < 2; ++cg) {
        const float inv = 1.f / grpx_sum(l[cg]);
        bfraw* d = yc + (size_t)(b * TT + tq[cg]) * 1024 + h * 64 + 4 * g;
#pragma unroll
        for (int dt = 0; dt < 4; ++dt) st4bf(d + dt * 16, O[cg][dt][0] * inv, O[cg][dt][1] * inv, O[cg][dt][2] * inv, O[cg][dt][3] * inv);
    }
    __syncthreads();
}

constexpr int GS_STAGE = 34816 + 4352;
DEV void gdn_scan_item2(const Params& p, char* smem, int item) {
    const int tid = tidx(), lane = tid & 63, w = tid >> 6, c = lane & 15, g = lane >> 4;
    const int bh = item & 7, e0 = (item >> 3) * 16;
    const bfraw* MB = (const bfraw*)(p.ws + O_MBUF) + (size_t)bh * 256 * 16384;
    const bfraw* NB = (const bfraw*)(p.ws + O_NS) + (size_t)bh * 256 * 16384 + (size_t)e0 * 128;
    bfraw* SB = (bfraw*)(p.ws + O_SB) + (size_t)bh * 256 * 16384 + (size_t)e0 * 128;
    __syncthreads();
    if (w >= 4) {
        const int lt = tid - 256, lrow = lt >> 4, lcol = (lt & 15) * 8;
#define GS_LDR(N, R) { const bfraw* Mn = MB + (size_t)(N) * 16384 + (size_t)lrow * 128 + lcol; \
            R##m0 = *(const uint4*)(Mn + 0 * 128); R##m1 = *(const uint4*)(Mn + 16 * 128); R##m2 = *(const uint4*)(Mn + 32 * 128); R##m3 = *(const uint4*)(Mn + 48 * 128); R##m4 = *(const uint4*)(Mn + 64 * 128); R##m5 = *(const uint4*)(Mn + 80 * 128); R##m6 = *(const uint4*)(Mn + 96 * 128); R##m7 = *(const uint4*)(Mn + 112 * 128); \
            R##n = *(const uint4*)(NB + (size_t)(N) * 16384 + (size_t)lrow * 128 + lcol); }
#define GS_STR(STAGE, R) { bfraw* Mw = (bfraw*)(smem + (STAGE) * GS_STAGE) + lrow * 136 + lcol; \
            *(uint4*)(Mw + 0 * 136) = R##m0; *(uint4*)(Mw + 16 * 136) = R##m1; *(uint4*)(Mw + 32 * 136) = R##m2; *(uint4*)(Mw + 48 * 136) = R##m3; *(uint4*)(Mw + 64 * 136) = R##m4; *(uint4*)(Mw + 80 * 136) = R##m5; *(uint4*)(Mw + 96 * 136) = R##m6; *(uint4*)(Mw + 112 * 136) = R##m7; \
            *(uint4*)(Mw + 128 * 136) = R##n; }
        uint4 ram0, ram1, ram2, ram3, ram4, ram5, ram6, ram7, rbm0, rbm1, rbm2, rbm3, rbm4, rbm5, rbm6, rbm7, rcm0, rcm1, rcm2, rcm3, rcm4, rcm5, rcm6, rcm7, ran, rbn, rcn;
        GS_LDR(0, ra) GS_LDR(1, rb) GS_LDR(2, rc)
        GS_STR(0, ra)
        lds_barrier();
#define GS_IT(N, RCUR, RNEXT, STG) { const int n_ = (N); if (n_ < 256) { if (n_ + 3 < 256) GS_LDR(n_ + 3, RCUR) if (n_ + 1 < 256) GS_STR((STG) ^ 1, RNEXT) lds_barrier(); } }
        for (int n = 0; n < 256; n += 6) {
            GS_IT(n + 0, ra, rb, 0) GS_IT(n + 1, rb, rc, 1) GS_IT(n + 2, rc, ra, 0)
            GS_IT(n + 3, ra, rb, 1) GS_IT(n + 4, rb, rc, 0) GS_IT(n + 5, rc, ra, 1)
        }
#undef GS_IT
#undef GS_LDR
#undef GS_STR
    } else if (w == 0) {
        f32x4 S[8];
#pragma unroll
        for (int dt = 0; dt < 8; ++dt) S[dt] = f32x4{0.f, 0.f, 0.f, 0.f};
        lds_barrier();
        for (int n = 0; n < 256; ++n) {
            const bfraw* Mb = (const bfraw*)(smem + (n & 1) * GS_STAGE);
            const bfraw* Nl = Mb + 128 * 136;
            bfraw* Sn = SB + (size_t)n * 16384 + (size_t)c * 128 + 4 * g;
            bf16x8 bs[4];
#pragma unroll
            for (int s = 0; s < 4; ++s)
                bs[s] = pack8(S[2 * s][0], S[2 * s][1], S[2 * s][2], S[2 * s][3], S[2 * s + 1][0], S[2 * s + 1][1], S[2 * s + 1][2], S[2 * s + 1][3]);
#pragma unroll
            for (int dt = 0; dt < 8; ++dt) st4bf(Sn + dt * 16, S[dt][0], S[dt][1], S[dt][2], S[dt][3]);
#pragma unroll
            for (int dt = 0; dt < 8; ++dt) {
                const uint2 n0 = *(const uint2*)&Nl[c * 136 + dt * 16 + 4 * g];
                f32x4 a0 = f32x4{lo2f(n0.x), hi2f(n0.x), lo2f(n0.y), hi2f(n0.y)};
#pragma unroll
                for (int s = 0; s < 4; ++s) {
                    const bfraw* mp = &Mb[(dt * 16 + c) * 136 + 32 * s + 4 * g];
                    a0 = mfma16(ld4x2(mp, mp + 16), bs[s], a0);
                }
                S[dt] = a0;
            }
            lds_barrier();
        }
    } else {
        lds_barrier();
        for (int n = 0; n < 256; ++n) lds_barrier();
    }
}
DEV void phase_outproj(const Params& p, char* smem, int layer, unsigned* xq) {
    const bfraw* A = (const bfraw*)(p.ws + O_YCAT);
    const bfraw* Bt = (const bfraw*)(p.ws + (layer ? O_WOUT1 : O_WOUT0));
    const float* xin = layer ? p.out : p.in[I_X];
    for (int rr = 0;; ++rr) {
        int mt, nt;
        if (!xs_tile(4, rr, mt, nt)) break;
        const int m0 = mt * 256, n0 = nt * 256;
        gemm_tile2(smem, 16, 64,
            [&](int r) { return A + (size_t)(m0 + r) * 1024; },
            [&](int r) { return Bt + (size_t)(n0 + r) * 1024; },
            [&](const f32x4 (&acc)[8][4], int rb, int cbk, int lane) {
                const int c = lane & 15, g = lane >> 4, tok0 = m0 + rb, b = tok0 >> 14;
                const float* g1 = modp(p, layer, b, 2) + n0 + cbk + 4 * g;
#pragma unroll
                for (int j = 0; j < 4; ++j) {
                    const float4 gv = *(const float4*)(g1 + j * 16);
#pragma unroll
                    for (int i = 0; i < 8; ++i) {
                        const size_t o = (size_t)(tok0 + i * 16 + c) * 1024 + n0 + cbk + j * 16 + 4 * g;
                        const float4 xv = *(const float4*)(xin + o);
                        *(float4*)(p.out + o) = make_float4(xv.x + gv.x * acc[i][j][0], xv.y + gv.y * acc[i][j][1], xv.z + gv.z * acc[i][j][2], xv.w + gv.w * acc[i][j][3]);
                    }
                }
            });
    }
}

constexpr int RT_LG = 55296;
DEV void phase_router(const Params& p, char* smem, int layer, bool dry = false) {
    const int tid = tidx(), lane = tid & 63, w = tid >> 6;
    bfraw* hb = (bfraw*)(p.ws + O_HBUF);
    const bfraw* Wr = (const bfraw*)(p.ws + O_WRT) + (size_t)layer * 128 * 1024;
    float* lg = (float*)(smem + RT_LG);
    unsigned* cnts = (unsigned*)(p.ws + O_CNT) + 16 + layer * 128;
    float* pairw = (float*)(p.ws + O_PAIRW);
    int* plist = (int*)(p.ws + O_PLIST);
    for (int item = blockIdx.x; item < 256; item += gridDim.x) {
        const int m0 = item * 128, b = m0 >> 14;
        for (int rr = 0; rr < 16; ++rr) {
            const int row = m0 + w * 16 + rr;
            norm_row(p.out + (size_t)row * 1024, p.in[I_NFFN] + layer * 1024, modp(p, layer, b, 4), modp(p, layer, b, 3), hb + (size_t)row * 1024, lane);
        }
        block_sync_mem();
        gemm_tile(smem, 16, 64,
            [&](int r) { return hb + (size_t)(m0 + (r & 127)) * 1024; },
            [&](int r) { return Wr + (size_t)r * 1024; },
            [&](const f32x4 (&acc)[4][4], int rb, int cbk, int ln) {
                if (cbk == 0 && rb < 128) {
                    const int c = ln & 15, g = ln >> 4;
#pragma unroll
                    for (int i = 0; i < 4; ++i)
#pragma unroll
                        for (int j = 0; j < 4; ++j)
#pragma unroll
                            for (int r = 0; r < 4; ++r) lg[(rb + i * 16 + 4 * g + r) * 64 + j * 16 + c] = acc[i][j][r];
                }
            });
        __syncthreads();
        const float eb = p.in[I_MBIAS][layer * 64 + lane];
        const int grp = lane >> 3;
        for (int rr = 0; rr < 16; ++rr) {
            const int row = w * 16 + rr, tok = m0 + row;
            const float score = sigmoidf_(lg[row * 64 + lane]);
            const float biased = score + eb;
            float m1 = biased;
            m1 = fmaxf(m1, __shfl_xor(m1, 1)); m1 = fmaxf(m1, __shfl_xor(m1, 2)); m1 = fmaxf(m1, __shfl_xor(m1, 4));
            const unsigned long long eq = __ballot(biased == m1);
            const unsigned gm = (unsigned)(eq >> (grp * 8)) & 0xffu;
            const int first = __builtin_ctz(gm);
            float m2 = ((lane & 7) == first) ? -INFINITY : biased;
            m2 = fmaxf(m2, __shfl_xor(m2, 1)); m2 = fmaxf(m2, __shfl_xor(m2, 2)); m2 = fmaxf(m2, __shfl_xor(m2, 4));
            const float gs = m1 + m2;
            int grank = 0;
#pragma unroll
            for (int j = 0; j < 8; ++j) { const float gj = __shfl(gs, j * 8); grank += (gj > gs || (gj == gs && j < grp)) ? 1 : 0; }
            const bool gsel = grank < 4;
            const float v = gsel ? biased : -INFINITY;
            int er = 0;
#pragma unroll 8
            for (int j = 0; j < 64; ++j) { const float vj = __shfl(v, j); er += (vj > v || (vj == v && j < lane)) ? 1 : 0; }
            const bool sel = gsel && er < 6;
            const float ssum = wave_sum(sel ? score : 0.f);
            if (sel && !dry) {
                pairw[(size_t)tok * 6 + er] = score / ssum * 2.5f;
                const unsigned pos = atomicAdd(&cnts[b * 64 + lane], 1u);
                plist[(size_t)(b * 64 + lane) * 16384 + pos] = tok * 8 + er;
            }
        }
        __syncthreads();
    }
}

DEV void moe_tiles(const Params& p, char* smem, int layer, int hb, int* ts  ) {
    const unsigned* cnts = (const unsigned*)(p.ws + O_CNT) + 16 + layer * 128 + hb * 64;
    __syncthreads();
    if (tidx() == 0) {
        int a = 0;
        for (int e = 0; e < 64; ++e) { ts[e] = a; a += ((int)cnts[e] + 255) >> 8; }
        ts[64] = a; a += 64; ts[65] = a;
    }
    __syncthreads();
}
DEV int moe_find(const int* ts, int mt) { int e = 0; while (e < 64 && ts[e + 1] <= mt) ++e; return e; }
constexpr int MOE_TS = 147456;

DEV void phase_moe1(const Params& p, char* smem, int layer, int hb) {
    int* ts = (int*)(smem + MOE_TS);
    moe_tiles(p, smem, layer, hb, ts);
    const unsigned* cnts = (const unsigned*)(p.ws + O_CNT) + 16 + layer * 128 + hb * 64;
    const int* plist = (const int*)(p.ws + O_PLIST);
    const bfraw* hbuf = (const bfraw*)(p.ws + O_HBUF);
    const bfraw* wgu = (const bfraw*)(p.ws + O_WGU);
    bfraw* H = (bfraw*)(p.ws + O_H);
    const int total = ts[65];
    for (int item = blockIdx.x; item < total * 2; item += gridDim.x) {
        const int mt = item >> 1, nt = item & 1;
        const int e = moe_find(ts, mt), idx0 = (mt - ts[e]) * 256;
        const int cnt = e < 64 ? (int)cnts[e] : 16384;
        gemm_tile2<false>(smem, 16, 64,
            [&](int r) {
                const int idx = idx0 + r;
                int tok;
                if (e < 64) tok = idx < cnt ? (plist[(size_t)(hb * 64 + e) * 16384 + idx] >> 3) : 0;
                else tok = hb * 16384 + idx;
                return hbuf + (size_t)tok * 1024;
            },
            [&](int r) {
                const int hidden = nt * 128 + (r >> 6) * 32 + ((r >> 4) & 1) * 16 + (r & 15);
                return wgu + ((size_t)e * 512 + ((r >> 5) & 1) * 256 + hidden) * 1024;
            },
            [&](const f32x4 (&acc)[8][4], int rb, int cbk, int lane) {
                const int c = lane & 15, g = lane >> 4;
#pragma unroll
                for (int i = 0; i < 8; ++i) {
                    bfraw* hrow = H + (size_t)(mt * 256 + rb + i * 16 + c) * 256 + nt * 128 + (cbk >> 6) * 32 + 4 * g;
#pragma unroll
                    for (int jj = 0; jj < 2; ++jj)
                        st4bf(hrow + jj * 16, siluf_(acc[i][jj][0]) * acc[i][jj + 2][0], siluf_(acc[i][jj][1]) * acc[i][jj + 2][1],
                              siluf_(acc[i][jj][2]) * acc[i][jj + 2][2], siluf_(acc[i][jj][3]) * acc[i][jj + 2][3]);
                }
            });
    }
}

DEV void phase_moe2(const Params& p, char* smem, int layer, int hb) {
    int* ts = (int*)(smem + MOE_TS);
    moe_tiles(p, smem, layer, hb, ts);
    const unsigned* cnts = (const unsigned*)(p.ws + O_CNT) + 16 + layer * 128 + hb * 64;
    const int* plist = (const int*)(p.ws + O_PLIST);
    const float* pairw = (const float*)(p.ws + O_PAIRW);
    const bfraw* wd = (const bfraw*)(p.ws + O_WD);
    const bfraw* H = (const bfraw*)(p.ws + O_H);
    bfraw* Y = (bfraw*)(p.ws + O_Y);
    const int total = ts[65];
    for (int item = blockIdx.x; item < total * 4; item += gridDim.x) {
        const int mt = item >> 2, nt = item & 3;
        const int e = moe_find(ts, mt), idx0 = (mt - ts[e]) * 256;
        const int cnt = e < 64 ? (int)cnts[e] : 16384;
        gemm_tile2(smem, 4, 64,
            [&](int r) { return H + (size_t)(mt * 256 + r) * 256; },
            [&](int r) { return wd + ((size_t)e * 1024 + nt * 256 + r) * 256; },
            [&](const f32x4 (&acc)[8][4], int rb, int cbk, int lane) {
                const int c = lane & 15, g = lane >> 4;
                int yrow[8]; float wg[8];
                if (e < 64) {
                    const int* pl = plist + (size_t)(hb * 64 + e) * 16384;
                    int pr[8];
#pragma unroll
                    for (int i = 0; i < 8; ++i) pr[i] = pl[min(idx0 + rb + i * 16 + c, cnt - 1)];
#pragma unroll
                    for (int i = 0; i < 8; ++i) {
                        const int tok = pr[i] >> 3, j = pr[i] & 7;
                        wg[i] = pairw[(size_t)tok * 6 + j]; yrow[i] = (tok - hb * 16384) * 7 + j;
                    }
                } else {
#pragma unroll
                    for (int i = 0; i < 8; ++i) { wg[i] = 1.f; yrow[i] = (idx0 + rb + i * 16 + c) * 7 + 6; }
                }
#pragma unroll
                for (int i = 0; i < 8; ++i) {
                    const int idx = idx0 + rb + i * 16 + c;
                    if (idx < cnt) {
                        bfraw* yp = Y + (size_t)yrow[i] * 1024 + nt * 256 + cbk + 4 * g;
                        const float wgi = wg[i];
#pragma unroll
                        for (int j = 0; j < 4; ++j) st4bf(yp + j * 16, wgi * acc[i][j][0], wgi * acc[i][j][1], wgi * acc[i][j][2], wgi * acc[i][j][3]);
                    }
                }
            });
    }
}

DEV void phase_combine(const Params& p, int layer, int hb, bool next_norm, bool dry = false) {
    const int lane = tidx() & 63, w = tidx() >> 6;
    const bfraw* Y = (const bfraw*)(p.ws + O_Y);
    bfraw* hbuf = (bfraw*)(p.ws + O_HBUF);
    const float* g2 = modp(p, layer, hb, 5);
    for (int tl = blockIdx.x * 8 + w; tl < 16384; tl += gridDim.x * 8) {
        const int tok = hb * 16384 + tl;
        float* xr = p.out + (size_t)tok * 1024;
        float4 v[4]; float ss = 0.f;
#pragma unroll
        for (int i = 0; i < 4; ++i) {
            const int cix = lane * 4 + 256 * i;
            float s0 = 0.f, s1 = 0.f, s2 = 0.f, s3 = 0.f;
#pragma unroll
            for (int j = 0; j < 7; ++j) {
                const uint2 y = *(const uint2*)(Y + ((size_t)tl * 7 + j) * 1024 + cix);
                s0 += lo2f(y.x); s1 += hi2f(y.x); s2 += lo2f(y.y); s3 += hi2f(y.y);
            }
            const float4 x = *(const float4*)(xr + cix), gg = *(const float4*)(g2 + cix);
            v[i].x = x.x + gg.x * s0; v[i].y = x.y + gg.y * s1; v[i].z = x.z + gg.z * s2; v[i].w = x.w + gg.w * s3;
            *(float4*)(dry ? (float*)(p.ws + O_YCAT) + (size_t)(tl & 8191) * 1024 + cix : xr + cix) = v[i];
            ss += v[i].x * v[i].x + v[i].y * v[i].y + v[i].z * v[i].z + v[i].w * v[i].w;
        }
        if (next_norm) {
            ss = wave_sum(ss);
            const float rs = rsqrtf(ss * (1.f / 1024.f) + EPSF);
            const float* gain = p.in[I_NMIX] + (layer + 1) * 1024;
            const float* sc = modp(p, layer + 1, hb, 1); const float* sh = modp(p, layer + 1, hb, 0);
#pragma unroll
            for (int i = 0; i < 4; ++i) {
                const int cix = lane * 4 + 256 * i;
                const float4 gn = *(const float4*)(gain + cix), s1 = *(const float4*)(sc + cix), s0 = *(const float4*)(sh + cix);
                st4bf((dry ? (bfraw*)(p.ws + O_YCAT) : hbuf) + (size_t)tok * 1024 + cix, v[i].x * rs * gn.x * (1.f + s1.x) + s0.x, v[i].y * rs * gn.y * (1.f + s1.y) + s0.y,
                      v[i].z * rs * gn.z * (1.f + s1.z) + s0.z, v[i].w * rs * gn.w * (1.f + s1.w) + s0.w);
            }
        }
    }
}
#define HAVE_L1 1
DEV void phase_inproj1(const Params& p, char* smem, unsigned* xq) {
    const bfraw* A = (const bfraw*)(p.ws + O_HBUF);
    const bfraw* Bt = (const bfraw*)(p.ws + O_WIN1);
    constexpr int NTL = NIN1 / 256;
    for (int rr = 0;; ++rr) {
        int mt, nt;
        if (!xs_tile(NTL, rr, mt, nt)) break;
        const int m0 = __builtin_amdgcn_readfirstlane(mt * 256), n0 = __builtin_amdgcn_readfirstlane(nt * 256);
        gemm_tile2(smem, 16, 64,
            [&](int r) { return A + (size_t)(m0 + r) * 1024; },
            [&](int r) { return Bt + (size_t)(n0 + r) * 1024; },
            [&](const f32x4 (&acc)[8][4], int rb, int cbk, int lane) {
                const int cb = n0 + cbk, tok0 = m0 + rb, b = tok0 >> 14, t0 = tok0 & (TT - 1);
                if (cb < 512) {
                    epi2_headnorm<8>(acc, lane, p.in[I_NSAQN], 0.125f * LOG2E, (bfraw*)(p.ws + O_QN) + ((size_t)(b * 8 + (cb >> 6)) * TT + t0) * 64, 64);
                } else if (cb < 640) {
                    epi2_store_bf16<8>(acc, lane, (bfraw*)(p.ws + O_KCR) + (size_t)tok0 * 128 + (cb - 512), 128);
                } else if (cb < 768) {
                    epi2_store_bf16<8>(acc, lane, (bfraw*)(p.ws + O_VCR) + (size_t)tok0 * 128 + (cb - 640), 128);
                } else if (cb < 896) {
                    epi2_headnorm<8>(acc, lane, p.in[I_NSAKN], 1.f, (bfraw*)(p.ws + O_KS) + ((size_t)(b * 2 + ((cb - 768) >> 6)) * TT + t0) * 64, 64);
                } else if (cb < 1024) {
                    epi2_store_T<8>(acc, lane, (bfraw*)(p.ws + O_VST) + (size_t)(b * 2 + ((cb - 896) >> 6)) * 64 * TT + t0, TT);
                } else if (cb < 1152) {
                    epi2_headnorm<8>(acc, lane, p.in[I_NSAKN], 1.f, (bfraw*)(p.ws + O_KW) + ((size_t)(b * 2 + ((cb - 1024) >> 6)) * TT + t0) * 64, 64);
                } else if (cb < 1280) {
                    epi2_store_T<8>(acc, lane, (bfraw*)(p.ws + O_VWT) + (size_t)(b * 2 + ((cb - 1152) >> 6)) * 64 * TT + t0, TT);
                } else if (cb < 1536) {
                    epi2_store_bf16<8>(acc, lane, (bfraw*)(p.ws + O_LQ) + (size_t)tok0 * 256 + (cb - 1280), 256);
                } else if (cb < 1792) {
                    epi2_store_bf16<8>(acc, lane, (bfraw*)(p.ws + O_LK) + (size_t)tok0 * 256 + (cb - 1536), 256);
                } else if (cb < 2304) {
                    epi2_store_bf16<8>(acc, lane, (bfraw*)(p.ws + O_LV) + (size_t)tok0 * 512 + (cb - 1792), 512);
                } else if (cb < 2816) {
                    epi2_store_bf16<8>(acc, lane, (bfraw*)(p.ws + O_LR) + (size_t)tok0 * 512 + (cb - 2304), 512);
                } else if (cb == 2816) {
                    const int c = lane & 15, g = lane >> 4;
                    float* sm = (float*)(p.ws + O_SM1);
#pragma unroll
                    for (int j = 0; j < 3; ++j)
                        if (j * 16 + 4 * g < 40) {
#pragma unroll
                            for (int i = 0; i < 8; ++i) *(float4*)&sm[(size_t)(tok0 + i * 16 + c) * 40 + j * 16 + 4 * g] = make_float4(acc[i][j][0], acc[i][j][1], acc[i][j][2], acc[i][j][3]);
                        }
                }
            });
    }
}

constexpr int NC_H1 = 0;
DEV void nsa_compress_item(const Params& p, char* smem, int item) {
    const int tid = tidx(), lane = tid & 63, w = tid >> 6, c = lane & 15, g = lane >> 4;
    const int wh = item >> 6, rt = item & 63;
    const int R0 = rt * 64, bk = R0 >> 10, b = bk >> 1, kvh = bk & 1, nb0 = R0 & 1023;
    const bfraw* raw = (const bfraw*)(p.ws + (wh ? O_VCR : O_KCR));
    const bfraw* W1 = (const bfraw*)(p.ws + O_W1T) + (size_t)wh * 256 * 2048;
    const bfraw* W2 = (const bfraw*)(p.ws + O_W2T) + (size_t)wh * 64 * 256;
    bfraw* H1 = (bfraw*)(smem + NC_H1);
    __syncthreads();
    {
        const int wm = w & 3, wn = w >> 2;
        int n = nb0 + wm * 16 + c; if (n > 1022) n = 1022;
        const bfraw* arow = raw + ((size_t)b * TT + 16 * n) * 128 + kvh * 64 + 8 * g;
        const bfraw* brow = W1 + (size_t)(wn * 128 + c) * 2048 + 8 * g;
        f32x4 acc[8];
#pragma unroll
        for (int j = 0; j < 8; ++j) acc[j] = f32x4{0.f, 0.f, 0.f, 0.f};
#pragma unroll 2
        for (int ks = 0; ks < 64; ++ks) {
            const bf16x8 a = ld8(arow + (size_t)(ks >> 1) * 128 + (ks & 1) * 32);
#pragma unroll
            for (int j = 0; j < 8; ++j) acc[j] = mfma16(a, ld8(brow + (size_t)j * 16 * 2048 + ks * 32), acc[j]);
        }
        const float* b1 = (const float*)(p.ws + O_BIAS1) + wh * 256;
#pragma unroll
        for (int j = 0; j < 8; ++j) {
            const int col = wn * 128 + j * 16 + c;
            const float bb = b1[col];
#pragma unroll
            for (int r = 0; r < 4; ++r) H1[(wm * 16 + 4 * g + r) * 264 + col] = f2bf(siluf_(acc[j][r] + bb));
        }
    }
    __syncthreads();
    if (w < 4) {
        f32x4 acc[4];
#pragma unroll
        for (int j = 0; j < 4; ++j) acc[j] = f32x4{0.f, 0.f, 0.f, 0.f};
#pragma unroll
        for (int ks = 0; ks < 8; ++ks) {
            const bf16x8 a = ld8(&H1[(w * 16 + c) * 264 + ks * 32 + 8 * g]);
#pragma unroll
            for (int j = 0; j < 4; ++j) acc[j] = mfma16(a, ld8(W2 + (size_t)(j * 16 + c) * 256 + ks * 32 + 8 * g), acc[j]);
        }
        const int nrow = nb0 + w * 16 + 4 * g;
        if (wh == 0) {
            bfraw* kc = (bfraw*)(p.ws + O_KCMP) + (size_t)bk * 1024 * 64;
#pragma unroll
            for (int r = 0; r < 4; ++r) {
                float ss = 0.f;
#pragma unroll
                for (int j = 0; j < 4; ++j) ss += acc[j][r] * acc[j][r];
                ss = grp16_sum(ss);
                const float rs = (nrow + r < 1023) ? rsqrtf(ss * (1.f / 64.f) + EPSF) : 0.f;
#pragma unroll
                for (int j = 0; j < 4; ++j) kc[(size_t)(nrow + r) * 64 + j * 16 + c] = f2bf(acc[j][r] * rs * p.in[I_NSAKN][j * 16 + c]);
            }
        } else {
            bfraw* vc = (bfraw*)(p.ws + O_VCMPT) + (size_t)bk * 64 * 1024;
#pragma unroll
            for (int j = 0; j < 4; ++j)
                st4bf(vc + (size_t)(j * 16 + c) * 1024 + nrow, acc[j][0], acc[j][1], acc[j][2], (nrow + 3 < 1023) ? acc[j][3] : 0.f);
        }
    }
    __syncthreads();
}

constexpr int GL_G = 0, GL_QD = 16384, GL_KN = 25600, GL_AT = 34816, GL_VT = 44032, GL_KDT = 62464, GL_TOT = 71680;
DEV void gla_a_item(const Params& p, char* smem, int item) {
    const int bh = item >> 8, n = item & 255, b = bh >> 2, h = bh & 3, tok0 = b * TT + n * 64;
    float* G = (float*)(smem + GL_G);
    bfraw* qd = (bfraw*)(smem + GL_QD);
    bfraw* kn = (bfraw*)(smem + GL_KN);
    bfraw* at = (bfraw*)(smem + GL_AT);
    bfraw* vT = (bfraw*)(smem + GL_VT);
    bfraw* kdT = (bfraw*)(smem + GL_KDT);
    float* tot = (float*)(smem + GL_TOT);
    const float* sm1 = (const float*)(p.ws + O_SM1);
    __syncthreads();
    {
        OPQ_TID();
        const int d = tid & 63, ig = tid >> 6;
        float wu[16];
#pragma unroll
        for (int r = 0; r < 16; ++r) wu[r] = p.in[I_GLAWG][r * 256 + h * 64 + d];
        const float bg = p.in[I_GLABG][h * 64 + d];
        float run = 0.f;
#pragma unroll 1
        for (int ii = 0; ii < 8; ++ii) {
            const int i = ig * 8 + ii;
            const float* lg = sm1 + (size_t)(tok0 + i) * 40 + 24;
            float z = bg;
#pragma unroll
            for (int r = 0; r < 16; ++r) z += lg[r] * wu[r];
            run += logsigmoidf_(z) * (1.f / 16.f);
            G[i * 64 + d] = run;
        }
        tot[ig * 64 + d] = run;
    }
    __syncthreads();
    {
        OPQ_TID();
        const int d = tid & 63, ig = tid >> 6;
        float off = 0.f;
        for (int q = 0; q < ig; ++q) off += tot[q * 64 + d];
#pragma unroll 1
        for (int ii = 0; ii < 8; ++ii) G[(ig * 8 + ii) * 64 + d] += off;
    }
    __syncthreads();
    {
        OPQ_TID();
        const int i = tid >> 3, d0 = (tid & 7) * 8, e0 = (tid & 7) * 16;
        U4 qv, kv;
        qv.u = *(const uint4*)((const bfraw*)(p.ws + O_LQ) + (size_t)(tok0 + i) * 256 + h * 64 + d0);
        kv.u = *(const uint4*)((const bfraw*)(p.ws + O_LK) + (size_t)(tok0 + i) * 256 + h * 64 + d0);
        U4 qo, ko;
#pragma unroll
        for (int q = 0; q < 4; ++q) {
            const float g0 = G[i * 64 + d0 + 2 * q], g1 = G[i * 64 + d0 + 2 * q + 1];
            const float gl0 = G[63 * 64 + d0 + 2 * q], gl1 = G[63 * 64 + d0 + 2 * q + 1];
            const float q0 = lo2f(qv.w[q]), q1 = hi2f(qv.w[q]), k0 = lo2f(kv.w[q]), k1 = hi2f(kv.w[q]);
            qo.w[q] = pack2(q0 * 0.125f * __expf(g0), q1 * 0.125f * __expf(g1));
            ko.w[q] = pack2(k0 * __expf(-g0), k1 * __expf(-g1));
            kdT[(d0 + 2 * q) * 72 + i] = f2bf(k0 * __expf(gl0 - g0));
            kdT[(d0 + 2 * q + 1) * 72 + i] = f2bf(k1 * __expf(gl1 - g1));
        }
        *(uint4*)&qd[i * 72 + d0] = qo.u;
        *(uint4*)&kn[i * 72 + d0] = ko.u;
        *(uint4*)((bfraw*)(p.ws + O_QD) + ((size_t)item * 64 + i) * 64 + d0) = qo.u;
        const bfraw* vp = (const bfraw*)(p.ws + O_LV) + (size_t)(tok0 + i) * 512 + h * 128 + e0;
        U4 v0, v1; v0.u = *(const uint4*)vp; v1.u = *(const uint4*)(vp + 8);
#pragma unroll
        for (int q = 0; q < 4; ++q) {
            vT[(e0 + 2 * q) * 72 + i] = (bfraw)(v0.w[q] & 0xffffu); vT[(e0 + 2 * q + 1) * 72 + i] = (bfraw)(v0.w[q] >> 16);
            vT[(e0 + 8 + 2 * q) * 72 + i] = (bfraw)(v1.w[q] & 0xffffu); vT[(e0 + 8 + 2 * q + 1) * 72 + i] = (bfraw)(v1.w[q] >> 16);
        }
        if (tid < 64) ((float*)(p.ws + O_AN))[(size_t)item * 64 + tid] = __expf(G[63 * 64 + tid]);
    }
    __syncthreads();
    {
        OPQ_TID();
        const int ti = w >> 1, tj0 = (w & 1) * 2;
        f32x4 acc[2];
        acc[0] = f32x4{0.f, 0.f, 0.f, 0.f}; acc[1] = f32x4{0.f, 0.f, 0.f, 0.f};
#pragma unroll
        for (int ks = 0; ks < 2; ++ks) {
            const bf16x8 a = ld8(&qd[(ti * 16 + c) * 72 + ks * 32 + 8 * g]);
#pragma unroll
            for (int jt = 0; jt < 2; ++jt) acc[jt] = mfma16(a, ld8(&kn[((tj0 + jt) * 16 + c) * 72 + ks * 32 + 8 * g]), acc[jt]);
        }
#pragma unroll
        for (int jt = 0; jt < 2; ++jt)
#pragma unroll
            for (int r = 0; r < 4; ++r) {
                const int i = ti * 16 + 4 * g + r, j = (tj0 + jt) * 16 + c;
                at[i * 72 + j] = f2bf(i >= j ? acc[jt][r] : 0.f);
            }
    }
    __syncthreads();
    {
        OPQ_TID();
        f32x4 ao[4], ab[4];
#pragma unroll
        for (int q = 0; q < 4; ++q) { ao[q] = f32x4{0.f, 0.f, 0.f, 0.f}; ab[q] = f32x4{0.f, 0.f, 0.f, 0.f}; }
#pragma unroll
        for (int ks = 0; ks < 2; ++ks) {
            const bf16x8 ve = ld8(&vT[(w * 16 + c) * 72 + ks * 32 + 8 * g]);
#pragma unroll
            for (int q = 0; q < 4; ++q) {
                ao[q] = mfma16(ve, ld8(&at[(q * 16 + c) * 72 + ks * 32 + 8 * g]), ao[q]);
                ab[q] = mfma16(ld8(&kdT[(q * 16 + c) * 72 + ks * 32 + 8 * g]), ve, ab[q]);
            }
        }
        bfraw* yc = (bfraw*)(p.ws + O_YCAT);
        float* st = (float*)(p.ws + O_ST) + (size_t)item * 8192;
#pragma unroll
        for (int q = 0; q < 4; ++q) {
            st4bf(yc + (size_t)(tok0 + q * 16 + c) * 1024 + 512 + h * 128 + w * 16 + 4 * g, ao[q][0], ao[q][1], ao[q][2], ao[q][3]);
            *(float4*)(st + (size_t)(w * 16 + c) * 64 + q * 16 + 4 * g) = make_float4(ab[q][0], ab[q][1], ab[q][2], ab[q][3]);
        }
    }
    lds_barrier();
}

DEV void gla_scan_item(const Params& p, int item) {
    const int id = item * 512 + tidx(), bh = id >> 13, rem = id & 8191, d = rem & 63;
    float* st = (float*)(p.ws + O_ST) + (size_t)bh * 256 * 8192 + rem;
    const float* an = (const float*)(p.ws + O_AN) + (size_t)bh * 256 * 64 + d;
    float S = 0.f;
    for (int n0 = 0; n0 < 256; n0 += 8) {
        float bv[8], av[8];
#pragma unroll
        for (int q = 0; q < 8; ++q) { bv[q] = st[(size_t)(n0 + q) * 8192]; av[q] = an[(size_t)(n0 + q) * 64]; }
#pragma unroll
        for (int q = 0; q < 8; ++q) { st[(size_t)(n0 + q) * 8192] = S; S = av[q] * S + bv[q]; }
    }
}

DEV void gla_c_witem(const Params& p, int witem, bool dry = false) {
    const int lane = tidx() & 63, c = lane & 15, g = lane >> 4;
    const int item = witem >> 2, it = witem & 3;
    const int bh = item >> 8, n = item & 255, b = bh >> 2, h = bh & 3;
    const float* st = (const float*)(p.ws + O_ST) + (size_t)item * 8192;
    const bfraw* qd = (const bfraw*)(p.ws + O_QD) + (size_t)item * 4096;
    f32x4 acc[8];
#pragma unroll
    for (int et = 0; et < 8; ++et) acc[et] = f32x4{0.f, 0.f, 0.f, 0.f};
#pragma unroll
    for (int ks = 0; ks < 2; ++ks) {
        const bf16x8 bq = ld8(qd + (size_t)(it * 16 + c) * 64 + ks * 32 + 8 * g);
#pragma unroll
        for (int et = 0; et < 8; ++et) {
            const float* sp = st + (size_t)(et * 16 + c) * 64 + ks * 32 + 8 * g;
            const float4 s0 = *(const float4*)sp, s1 = *(const float4*)(sp + 4);
            acc[et] = mfma16(pack8(s0.x, s0.y, s0.z, s0.w, s1.x, s1.y, s1.z, s1.w), bq, acc[et]);
        }
    }
    const int tok = b * TT + n * 64 + it * 16 + c;
    bfraw* yp = (bfraw*)(p.ws + O_YCAT) + (size_t)tok * 1024 + 512 + h * 128 + 4 * g;
    const bfraw* lr = (const bfraw*)(p.ws + O_LR) + (size_t)tok * 512 + h * 128 + 4 * g;
    float ss = 0.f;
#pragma unroll
    for (int et = 0; et < 8; ++et) {
        const uint2 o0 = *(const uint2*)(yp + et * 16);
        acc[et][0] += lo2f(o0.x); acc[et][1] += hi2f(o0.x); acc[et][2] += lo2f(o0.y); acc[et][3] += hi2f(o0.y);
        ss += acc[et][0] * acc[et][0] + acc[et][1] * acc[et][1] + acc[et][2] * acc[et][2] + acc[et][3] * acc[et][3];
    }
    ss = grpx_sum(ss);
    const float rs = rsqrtf(ss * (1.f / 128.f) + EPSF);
#pragma unroll
    for (int et = 0; et < 8; ++et) {
        const uint2 zv = *(const uint2*)(lr + et * 16);
        const float4 gn = *(const float4*)(p.in[I_GLAON] + et * 16 + 4 * g);
        st4bf((dry ? (bfraw*)(p.ws + O_KS) + (size_t)tok * 128 + 4 * g : yp) + et * 16, acc[et][0] * rs * gn.x * siluf_(lo2f(zv.x)), acc[et][1] * rs * gn.y * siluf_(hi2f(zv.x)),
                            acc[et][2] * rs * gn.z * siluf_(lo2f(zv.y)), acc[et][3] * rs * gn.w * siluf_(hi2f(zv.y)));
    }
}
constexpr int NS_IMP = 0;
constexpr int NS_IMPW = 16448;
constexpr int NS_LINV = 131584;
constexpr int NS_BTAB = 132096;
constexpr int NS_SELW = 134400;
DEV int t5_bucket(int n) {
    if (n < 16) return n;
    int v = 16 + (int)(__logf((float)n * (1.f / 16.f)) / 2.0794415416798357f * 16.f);
    return v < 31 ? v : 31;
}
template <int MODE>
DEV void nsa_step(const bfraw* Kb, const bfraw* VTb, size_t vstride, int kb, const bf16x8 (&qf)[2], int tpos, int lim, bool colsel, const float* bt, float Mb2,
                  f32x4 (&O)[4], float& l, float* impU, int c, int g) {
    bf16x8 kf[2][2];
#pragma unroll
    for (int kt = 0; kt < 2; ++kt)
#pragma unroll
        for (int ks = 0; ks < 2; ++ks) kf[kt][ks] = ld8(Kb + (size_t)(kb + kt * 16 + c) * 64 + ks * 32 + 8 * g);
    bf16x8 vf[4];
#pragma unroll
    for (int dt = 0; dt < 4; ++dt) { const bfraw* vp = VTb + (size_t)(dt * 16 + c) * vstride + kb + 4 * g; vf[dt] = ld4x2(vp, vp + 16); }
    float pr[2][4];
#pragma unroll
    for (int kt = 0; kt < 2; ++kt) {
        f32x4 S = mfma16(kf[kt][0], qf[0], f32x4{0.f, 0.f, 0.f, 0.f});
        S = mfma16(kf[kt][1], qf[1], S);
#pragma unroll
        for (int r = 0; r < 4; ++r) {
            const int key = kb + kt * 16 + 4 * g + r;
            int dist; bool valid;
            if (MODE == 0) { dist = tpos - 16 * key - 31; valid = key < lim; }
            else if (MODE == 1) { dist = tpos - key; valid = colsel && dist >= 0; }
            else { dist = tpos - key; valid = dist >= 0 && dist < 512; }
            const int bi = dist < 0 ? 0 : (dist > 128 ? 128 : dist);
            const float e = valid ? ex2(S[r] + bt[bi] - Mb2) : 0.f;
            pr[kt][r] = e; l += e;
        }
        if (MODE == 0) {
            const int blk = ((kb + kt * 16) >> 2) + g;
            atomicAdd(&impU[blk * 16 + c], pr[kt][0] + pr[kt][1] + pr[kt][2] + pr[kt][3]);
            atomicAdd(&impU[(blk + 1) * 16 + c], pr[kt][3]);
        }
    }
    const bf16x8 pb = pack8(pr[0][0], pr[0][1], pr[0][2], pr[0][3], pr[1][0], pr[1][1], pr[1][2], pr[1][3]);
#pragma unroll
    for (int dt = 0; dt < 4; ++dt) O[dt] = mfma16(vf[dt], pb, O[dt]);
}

DEV void nsa_item(const Params& p, char* smem, int item) {
    const int tid = tidx(), lane = tid & 63, w = tid >> 6, c = lane & 15, g = lane >> 4;
    const int bk = item >> 9, tq0 = (item & 511) * 32, b = bk >> 1, kvh = bk & 1;
    const int qi = c >> 2, hg = c & 3, h = kvh * 4 + hg;
    const int tw0 = tq0 + 4 * w, tpos = tw0 + qi;
    float* impU = (float*)(smem + NS_IMP + w * NS_IMPW);
    float* linv = (float*)(smem + NS_LINV) + w * 16;
    float* btab = (float*)(smem + NS_BTAB);
    unsigned long long* selw = (unsigned long long*)(smem + NS_SELW) + w * 20;
    __syncthreads();
    for (int idx = tid; idx < 4 * 129; idx += NTHR) {
        const int hh = idx / 129, dd = idx % 129;
        btab[idx] = p.in[I_RELB][(dd < 128 ? t5_bucket(dd) : 31) * 8 + kvh * 4 + hh] * LOG2E;
    }
    for (int idx = lane; idx < 257 * 16; idx += 64) impU[idx] = 0.f;
    const float mq = wave_max(fabsf(p.in[I_NSAQN][lane])), mk = wave_max(fabsf(p.in[I_NSAKN][lane]));
    const float mb = wave_max(fmaxf(fmaxf(fabsf(p.in[I_RELB][lane]), fabsf(p.in[I_RELB][64 + lane])), fmaxf(fabsf(p.in[I_RELB][128 + lane]), fabsf(p.in[I_RELB][192 + lane]))));
    const float Mb2 = (8.f * mq * mk + mb) * LOG2E;
    __syncthreads();
    const float* bt = btab + hg * 129;
    bf16x8 qf[2];
    {
        const bfraw* qp = (const bfraw*)(p.ws + O_QN) + ((size_t)(b * 8 + h) * TT + tpos) * 64 + 8 * g;
        qf[0] = ld8(qp); qf[1] = ld8(qp + 32);
    }
    const float* gp = (const float*)(p.ws + O_SM1) + (size_t)(b * TT + tpos) * 40 + h * 3;
    const float gt0 = sigmoidf_(gp[0]), gt1 = sigmoidf_(gp[1]), gt2 = sigmoidf_(gp[2]);
    f32x4 ot[4];
#pragma unroll
    for (int dt = 0; dt < 4; ++dt) ot[dt] = f32x4{0.f, 0.f, 0.f, 0.f};
    {
        const int ncnt = tpos >= 31 ? ((tpos - 31) >> 4) + 1 : 0;
        const int tmax = tw0 + 3;
        const int ncw = tmax >= 31 ? ((tmax - 31) >> 4) + 1 : 0;
        const bfraw* Kb = (const bfraw*)(p.ws + O_KCMP) + (size_t)bk * 1024 * 64;
        const bfraw* Vb = (const bfraw*)(p.ws + O_VCMPT) + (size_t)bk * 64 * 1024;
        f32x4 O[4]; float l = 0.f;
#pragma unroll
        for (int dt = 0; dt < 4; ++dt) O[dt] = f32x4{0.f, 0.f, 0.f, 0.f};
        for (int kb = 0; kb < ncw; kb += 32) nsa_step<0>(Kb, Vb, 1024, kb, qf, tpos, ncnt, true, bt, Mb2, O, l, impU, c, g);
        const float lt = grpx_sum(l);
        const float inv = lt > 0.f ? 1.f / lt : 0.f;
        if (g == 0) linv[c] = inv;
#pragma unroll
        for (int dt = 0; dt < 4; ++dt) ot[dt] += O[dt] * (gt0 * inv);
    }
    const int cur = tw0 >> 6;
    {
        unsigned long long un[4] = {0ull, 0ull, 0ull, 0ull};
#pragma unroll 1
        for (int q = 0; q < 4; ++q) {
            float v[4]; bool sel[4];
#pragma unroll
            for (int m = 0; m < 4; ++m) {
                const int s = lane + 64 * m;
                float a = -1.f;
                if (s <= cur) {
                    a = 0.f;
#pragma unroll
                    for (int hh = 0; hh < 4; ++hh) a += impU[s * 16 + q * 4 + hh] * linv[q * 4 + hh];
                }
                const bool forced = (s <= cur) && (s == 0 || s == cur || s == cur - 1);
                sel[m] = forced; v[m] = forced ? -1.f : a;
            }
            const int nforced = cur == 0 ? 1 : (cur == 1 ? 2 : 3);
            const int need = (cur + 1 < 16 ? cur + 1 : 16) - nforced;
            for (int itn = 0; itn < need; ++itn) {
                const float vmax = wave_max(fmaxf(fmaxf(v[0], v[1]), fmaxf(v[2], v[3])));
                if (!(vmax >= 0.f)) break;
                bool done = false;
#pragma unroll
                for (int m = 0; m < 4; ++m) {
                    const unsigned long long mk2 = __ballot(v[m] == vmax);
                    if (!done && mk2 != 0ull) {
                        const int ln = __builtin_ctzll(mk2);
                        if (lane == ln) { sel[m] = true; v[m] = -1.f; }
                        done = true;
                    }
                }
            }
#pragma unroll
            for (int m = 0; m < 4; ++m) {
                const unsigned long long bm = __ballot(sel[m]);
                if (lane == 0) selw[q * 4 + m] = bm;
                un[m] |= bm;
            }
        }
        if (lane == 0) {
#pragma unroll
            for (int m = 0; m < 4; ++m) selw[16 + m] = un[m];
        }
    }
    {
        const bfraw* Kb = (const bfraw*)(p.ws + O_KS) + (size_t)bk * TT * 64;
        const bfraw* Vb = (const bfraw*)(p.ws + O_VST) + (size_t)bk * 64 * TT;
        f32x4 O[4]; float l = 0.f;
#pragma unroll
        for (int dt = 0; dt < 4; ++dt) O[dt] = f32x4{0.f, 0.f, 0.f, 0.f};
#pragma unroll 1
        for (int m = 0; m < 4; ++m) {
            unsigned long long um = selw[16 + m];
            const unsigned long long mine = selw[qi * 4 + m];
            while (um) {
                const int bit = __builtin_ctzll(um);
                um &= um - 1ull;
                const bool colsel = (mine >> bit) & 1ull;
                const int k0 = (64 * m + bit) * 64;
                nsa_step<1>(Kb, Vb, TT, k0, qf, tpos, 0, colsel, bt, Mb2, O, l, impU, c, g);
                nsa_step<1>(Kb, Vb, TT, k0 + 32, qf, tpos, 0, colsel, bt, Mb2, O, l, impU, c, g);
            }
        }
        const float lt = grpx_sum(l);
        const float inv = lt > 0.f ? 1.f / lt : 0.f;
#pragma unroll
        for (int dt = 0; dt < 4; ++dt) ot[dt] += O[dt] * (gt1 * inv);
    }
    {
        const bfraw* Kb = (const bfraw*)(p.ws + O_KW) + (size_t)bk * TT * 64;
        const bfraw* Vb = (const bfraw*)(p.ws + O_VWT) + (size_t)bk * 64 * TT;
        f32x4 O[4]; float l = 0.f;
#pragma unroll
        for (int dt = 0; dt < 4; ++dt) O[dt] = f32x4{0.f, 0.f, 0.f, 0.f};
        int ks0 = tw0 - 511; if (ks0 < 0) ks0 = 0; ks0 &= ~31;
        for (int kb = ks0; kb <= tw0 + 3; kb += 32) nsa_step<2>(Kb, Vb, TT, kb, qf, tpos, 0, true, bt, Mb2, O, l, impU, c, g);
        const float lt = grpx_sum(l);
        const float inv = lt > 0.f ? 1.f / lt : 0.f;
#pragma unroll
        for (int dt = 0; dt < 4; ++dt) ot[dt] += O[dt] * (gt2 * inv);
    }
    bfraw* yp = (bfraw*)(p.ws + O_YCAT) + (size_t)(b * TT + tpos) * 1024 + h * 64 + 4 * g;
#pragma unroll
    for (int dt = 0; dt < 4; ++dt) st4bf(yp + dt * 16, ot[dt][0], ot[dt][1], ot[dt][2], ot[dt][3]);
    __syncthreads();
}
constexpr int N2_IMP = 71680, N2_BTAB = 138240, N2_SELW = 140320;
constexpr int N2_IMPW = 8 * 260;

template <int MODE>
DEV void nsa_tile(const bfraw* Kb, const bfraw* Vb, int key0, const bf16x8 (&qf)[2][2], const int (&tpos)[2], const int (&lim)[2], const bool (&colsel)[2],
                  const bool (&act)[2], const float* bt, bool far, float Mb2, const float (&pscale)[2], f32x4 (&O)[2][4], float (&l)[2], float* impq, int c, int g, int vld = 72, float* carry = nullptr) {
    bf16x8 pb[2][2];
    const float bfar = bt[128] - Mb2;
#pragma unroll
    for (int kt = 0; kt < 4; ++kt) {
        const bf16x8 k0 = ld8(&Kb[(kt * 16 + c) * 72 + g * 8]), k1 = ld8(&Kb[(kt * 16 + c) * 72 + 32 + g * 8]);
#pragma unroll
        for (int cg = 0; cg < 2; ++cg) {
            if (!act[cg]) continue;
            float e[4];
            if (far) {
                const float bi = (MODE == 2 && !colsel[cg]) ? -INFINITY : bfar;
                f32x4 S = mfma16(k0, qf[cg][0], f32x4{bi, bi, bi, bi});
                S = mfma16(k1, qf[cg][1], S);
#pragma unroll
                for (int r = 0; r < 4; ++r) { e[r] = ex2(S[r]); if (MODE == 1) e[r] *= pscale[cg]; l[cg] += e[r]; }
            } else {
                f32x4 S = mfma16(k0, qf[cg][0], f32x4{0.f, 0.f, 0.f, 0.f});
                S = mfma16(k1, qf[cg][1], S);
#pragma unroll
                for (int r = 0; r < 4; ++r) {
                    const int key = key0 + kt * 16 + 4 * g + r;
                    bool valid; int dist;
                    if (MODE <= 1) { dist = tpos[cg] - 16 * key - 31; valid = key < lim[cg]; }
                    else { dist = tpos[cg] - key; valid = (MODE == 2) ? (colsel[cg] && dist >= 0) : (dist >= 0 && dist < 512); }
                    const float bias = bt[dist < 0 ? 0 : (dist > 128 ? 128 : dist)] - Mb2;
                    e[r] = valid ? ex2(S[r] + bias) : 0.f;
                    if (MODE == 1) e[r] *= pscale[cg];
                    l[cg] += e[r];
                }
            }
            if (MODE == 1) {
                float a = (e[0] + e[1]) + (e[2] + e[3]), a3 = e[3];
                a += __shfl_xor(a, 1); a3 += __shfl_xor(a3, 1);
                a += __shfl_xor(a, 2); a3 += __shfl_xor(a3, 2);
                const float pu = __shfl_up(a3, 16), pw = __shfl(carry[cg], (c + 48) & 63);
                a += (g == 0) ? pw : pu;
                carry[cg] = a3;
                if ((c & 3) == 0) impq[(cg * 4 + (c >> 2)) * 260 + ((key0 + kt * 16) >> 2) + g] = a;
            }
            if (MODE != 0) {
                U4 t;
                if (kt & 1) { t.v = pb[cg][kt >> 1]; t.w[2] = pack2(e[0], e[1]); t.w[3] = pack2(e[2], e[3]); }
                else { t.w[0] = pack2(e[0], e[1]); t.w[1] = pack2(e[2], e[3]); t.w[2] = 0u; t.w[3] = 0u; }
                pb[cg][kt >> 1] = t.v;
            }
        }
    }
    if (MODE != 0) {
#pragma unroll
        for (int dt = 0; dt < 4; ++dt) {
            const bfraw* vp = &Vb[(dt * 16 + c) * vld + 4 * g];
            const bf16x8 v0 = ld4x2(vp, vp + 16), v1 = ld4x2(vp + 32, vp + 48);
#pragma unroll
            for (int cg = 0; cg < 2; ++cg) if (act[cg]) { O[cg][dt] = mfma16(v0, pb[cg][0], O[cg][dt]); O[cg][dt] = mfma16(v1, pb[cg][1], O[cg][dt]); }
        }
    }
}

DEV void nsa_item2(const Params& p, char* smem, int item) {
    const int tid = tidx(), lane = tid & 63, w = tid >> 6, c = lane & 15, g = lane >> 4;
    const int bk = item >> 8, cur = item & 255, Q0 = cur * 64, b = bk >> 1, kvh = bk & 1;
    const int hg = c & 3, h = kvh * 4 + hg;
    float* impq = (float*)(smem + N2_IMP) + w * N2_IMPW;
    float* btab = (float*)(smem + N2_BTAB);
    unsigned long long* selw = (unsigned long long*)(smem + N2_SELW) + w * 36;
    __syncthreads();
    for (int idx = tid; idx < 4 * 129; idx += NTHR) {
        const int hh = idx / 129, dd = idx % 129;
        btab[idx] = p.in[I_RELB][(dd < 128 ? t5_bucket(dd) : 31) * 8 + kvh * 4 + hh] * LOG2E;
    }
    for (int idx = lane; idx < N2_IMPW; idx += 64) impq[idx] = 0.f;
    const float mq = wave_max(fabsf(p.in[I_NSAQN][lane])), mk = wave_max(fabsf(p.in[I_NSAKN][lane]));
    const float mb = wave_max(fmaxf(fmaxf(fabsf(p.in[I_RELB][lane]), fabsf(p.in[I_RELB][64 + lane])), fmaxf(fabsf(p.in[I_RELB][128 + lane]), fabsf(p.in[I_RELB][192 + lane]))));
    const float Mb2 = (8.f * mq * mk + mb) * LOG2E;
    const float* bt = btab + hg * 129;
    int tpos[2]; bf16x8 qf[2][2];
    float* otl = impq;
#pragma unroll
    for (int cg = 0; cg < 2; ++cg) {
        tpos[cg] = Q0 + 8 * w + 4 * cg + (c >> 2);
        const bfraw* qp = (const bfraw*)(p.ws + O_QN) + ((size_t)(b * 8 + h) * TT + tpos[cg]) * 64 + 8 * g;
        qf[cg][0] = ld8(qp); qf[cg][1] = ld8(qp + 32);
    }
    const float* gbase = (const float*)(p.ws + O_SM1) + (size_t)b * TT * 40 + h * 3;
    const bool csel1[2] = {true, true};
    const float one2[2] = {1.f, 1.f};
    f32x4 Oc[2][4];
    {
        int lim[2];
#pragma unroll
        for (int cg = 0; cg < 2; ++cg) lim[cg] = tpos[cg] >= 31 ? ((tpos[cg] - 31) >> 4) + 1 : 0;
        const int ncb = ((Q0 + 32) >> 4) + 1, nct = (ncb + 63) >> 6;
        const bfraw* Kg = (const bfraw*)(p.ws + O_KCMP) + (size_t)bk * 1024 * 64;
        const bfraw* Vg = (const bfraw*)(p.ws + O_VCMPT) + (size_t)bk * 64 * 1024;
        float l[2] = {0.f, 0.f};
#pragma unroll
        for (int cg = 0; cg < 2; ++cg)
#pragma unroll
            for (int dt = 0; dt < 4; ++dt) Oc[cg][dt] = f32x4{0.f, 0.f, 0.f, 0.f};
        tile_stream<false, false>(smem, Kg, Vg, 1024, nullptr, nct, [](int t) { return t * 64; },
            [&](int t, const bfraw* Kb, const bfraw* Vb, const float*) { nsa_tile<0>(Kb, Vb, t * 64, qf, tpos, lim, csel1, csel1, bt, 1024 * t + 1039 + 128 <= Q0, Mb2, one2, Oc, l, impq, c, g); });
        float linv[2];
#pragma unroll
        for (int cg = 0; cg < 2; ++cg) { const float lt = grpx_sum(l[cg]); linv[cg] = lt > 0.f ? 1.f / lt : 0.f; l[cg] = 0.f; }
        float carry[2] = {0.f, 0.f};
        tile_stream<true, false>(smem, Kg, Vg, 1024, nullptr, nct, [](int t) { return t * 64; },
            [&](int t, const bfraw* Kb, const bfraw* Vb, const float*) { nsa_tile<1>(Kb, Vb, t * 64, qf, tpos, lim, csel1, csel1, bt, 1024 * t + 1039 + 128 <= Q0, Mb2, linv, Oc, l, impq, c, g, 72, carry); });
    }
    {
        unsigned long long un[4] = {0ull, 0ull, 0ull, 0ull};
        const int nforced = cur == 0 ? 1 : (cur == 1 ? 2 : 3);
        const int need = (cur + 1 < 16 ? cur + 1 : 16) - nforced;
#pragma unroll 1
        for (int q = 0; q < 8; ++q) {
            float v[4]; bool sel[4];
#pragma unroll
            for (int m = 0; m < 4; ++m) {
                const int s = lane + 64 * m;
                const bool inr = s <= cur;
                const bool forced = inr && (s == 0 || s == cur || s == cur - 1);
                sel[m] = forced; v[m] = (inr && !forced) ? impq[q * 260 + s] : -1.f;
            }
            for (int itn = 0; itn < need; ++itn) {
                const float vmax = wave_max(fmaxf(fmaxf(v[0], v[1]), fmaxf(v[2], v[3])));
                if (!(vmax >= 0.f)) break;
                bool done = false;
#pragma unroll
                for (int m = 0; m < 4; ++m) {
                    const unsigned long long mk2 = __ballot(v[m] == vmax);
                    if (!done && mk2 != 0ull) {
                        const int ln = __builtin_ctzll(mk2);
                        if (lane == ln) { sel[m] = true; v[m] = -1.f; }
                        done = true;
                    }
                }
            }
#pragma unroll
            for (int m = 0; m < 4; ++m) {
                const unsigned long long bm = __ballot(sel[m]);
                if (lane == 0) selw[q * 4 + m] = bm;
                un[m] |= bm;
            }
        }
        if (lane == 0) {
#pragma unroll
            for (int m = 0; m < 4; ++m) selw[32 + m] = un[m];
        }
    }
#pragma unroll
    for (int cg = 0; cg < 2; ++cg) {
        const float g0 = sigmoidf_(gbase[(size_t)tpos[cg] * 40 + 0]);
#pragma unroll
        for (int dt = 0; dt < 4; ++dt)
#pragma unroll
            for (int r = 0; r < 4; ++r) otl[((cg * 4 + dt) * 4 + r) * 64 + lane] = Oc[cg][dt][r] * g0;
    }
    {
        const bfraw* Kg = (const bfraw*)(p.ws + O_KS) + (size_t)bk * TT * 64;
        const bfraw* Vg = (const bfraw*)(p.ws + O_VST) + (size_t)bk * 64 * TT;
        f32x4 O[2][4]; float l[2] = {0.f, 0.f};
        const int lim0[2] = {0, 0};
#pragma unroll
        for (int cg = 0; cg < 2; ++cg)
#pragma unroll
            for (int dt = 0; dt < 4; ++dt) O[cg][dt] = f32x4{0.f, 0.f, 0.f, 0.f};
        tile_stream2(smem, Kg, Vg, TT, (cur + 2) >> 1, [](int t) { return t * 128; }, [&](int t) { return (2 * t + 1 <= cur ? 2 * t + 1 : cur) * 64; },
            [&](int t, const bfraw* Kb, const bfraw* Vb) {
#pragma unroll
                for (int u = 0; u < 2; ++u) {
                    const int s = 2 * t + u;
                    if (s > cur) continue;
                    const int m = s >> 6, bit = s & 63;
                    if ((selw[32 + m] >> bit) & 1ull) {
                        bool cs[2], ac[2];
                        cs[0] = (selw[(c >> 2) * 4 + m] >> bit) & 1ull;
                        cs[1] = (selw[(4 + (c >> 2)) * 4 + m] >> bit) & 1ull;
                        ac[0] = ((selw[0 + m] | selw[4 + m] | selw[8 + m] | selw[12 + m]) >> bit) & 1ull;
                        ac[1] = ((selw[16 + m] | selw[20 + m] | selw[24 + m] | selw[28 + m]) >> bit) & 1ull;
                        nsa_tile<2>(Kb + u * 64 * 72, Vb + u * 64, s * 64, qf, tpos, lim0, cs, ac, bt, cur - s >= 3, Mb2, one2, O, l, impq, c, g, 136);
                    }
                }
            });
#pragma unroll
        for (int cg = 0; cg < 2; ++cg) {
            const float lt = grpx_sum(l[cg]);
            const float sc = (lt > 0.f ? 1.f / lt : 0.f) * sigmoidf_(gbase[(size_t)tpos[cg] * 40 + 1]);
#pragma unroll
            for (int dt = 0; dt < 4; ++dt)
#pragma unroll
                for (int r = 0; r < 4; ++r) otl[((cg * 4 + dt) * 4 + r) * 64 + lane] += O[cg][dt][r] * sc;
        }
    }
    {
        const bfraw* Kg = (const bfraw*)(p.ws + O_KW) + (size_t)bk * TT * 64;
        const bfraw* Vg = (const bfraw*)(p.ws + O_VWT) + (size_t)bk * 64 * TT;
        f32x4 O[2][4]; float l[2] = {0.f, 0.f};
        const int lim0[2] = {0, 0};
#pragma unroll
        for (int cg = 0; cg < 2; ++cg)
#pragma unroll
            for (int dt = 0; dt < 4; ++dt) O[cg][dt] = f32x4{0.f, 0.f, 0.f, 0.f};
        const int j0 = cur >= 8 ? cur - 8 : 0;
        tile_stream<true, false>(smem, Kg, Vg, TT, nullptr, cur - j0 + 1, [&](int t) { return (j0 + t) * 64; },
            [&](int t, const bfraw* Kb, const bfraw* Vb, const float*) {
                const int j = j0 + t;
                nsa_tile<3>(Kb, Vb, j * 64, qf, tpos, lim0, csel1, csel1, bt, (cur - j >= 3) && (cur - j <= 6), Mb2, one2, O, l, impq, c, g);
            });
#pragma unroll
        for (int cg = 0; cg < 2; ++cg) {
            const float lt = grpx_sum(l[cg]);
            const float sc = (lt > 0.f ? 1.f / lt : 0.f) * sigmoidf_(gbase[(size_t)tpos[cg] * 40 + 2]);
            bfraw* yp = (bfraw*)(p.ws + O_YCAT) + (size_t)(b * TT + tpos[cg]) * 1024 + h * 64 + 4 * g;
#pragma unroll
            for (int dt = 0; dt < 4; ++dt) {
                const float* op = &otl[((cg * 4 + dt) * 4) * 64 + lane];
                st4bf(yp + dt * 16, op[0] + O[cg][dt][0] * sc, op[64] + O[cg][dt][1] * sc, op[128] + O[cg][dt][2] * sc, op[192] + O[cg][dt][3] * sc);
            }
        }
    }
    __syncthreads();
}
constexpr int SM_QSLOT = 148000, SM_BARW = 148016;
DEV int q_pop(unsigned* ctr, char* smem) {
    int* slot = (int*)(smem + SM_QSLOT);
    __syncthreads();
    if (tidx() == 0) *slot = (int)atomicAdd(ctr, 1u);
    __syncthreads();
    return *slot;
}

template <int P, int REP = 0> DEV void run_phase(const Params& p, char* smem) {
    unsigned* ctrs = (unsigned*)(p.ws + O_CNT);
    if constexpr (P == 0) {
        phase_prologue(p, smem);
    } else if constexpr (P == 1) {
        phase_norm1(p, p.in[I_X], 0);
    } else if constexpr (P == 2) {
        phase_inproj0(p, smem, ctrs + 512 + (2 * 3 + REP) * 8);
    } else if constexpr (P == 3) {
#ifdef DBG_NO_GDN
        for (int it = blockIdx.x; it < 16; it += gridDim.x) fox_cumsum_item(p, smem, it);
#else
        for (int it = blockIdx.x; it < 16 + 2048; it += gridDim.x) { if (it < 16) fox_cumsum_item(p, smem, it); else gdn_a_item(p, smem, it - 16); }
#endif
    } else if constexpr (P == 4) {
#if !defined(DBG_NO_GDN) && !defined(DBG_NO_SCAN)
        if (REP != 2 && blockIdx.x < 64) gdn_scan_item2(p, smem, blockIdx.x);
#endif
        for (;;) {
            const int it = q_pop(&ctrs[REP ? 4 + REP : 0], smem);
            if (it >= 1024) break;
            fox_item2(p, smem, it & 15, 63 - (it >> 4));
        }
    } else if constexpr (P == 5) {
        const int w = tidx() >> 6;
#ifdef DBG_NO_GDN
        for (size_t i = (size_t)blockIdx.x * NTHR + tidx(); i < (size_t)NT * 512; i += (size_t)gridDim.x * NTHR) ((bfraw*)(p.ws + O_YCAT))[(i >> 9) * 1024 + 512 + (i & 511)] = 0;
#elif defined(DBG_NO_GDNC)
#else
        for (int wi = blockIdx.x * 8 + w; wi < 8192; wi += gridDim.x * 8) gdn_c_witem(p, wi, REP != 0);
#endif
#ifdef DBG_NO_FOX
        for (size_t i = (size_t)blockIdx.x * NTHR + tidx(); i < (size_t)NT * 512; i += (size_t)gridDim.x * NTHR) ((bfraw*)(p.ws + O_YCAT))[(i >> 9) * 1024 + (i & 511)] = 0;
#endif
    } else if constexpr (P == 6 || P == 18) {
        constexpr int L = (P == 6) ? 0 : 1;
        phase_outproj(p, smem, L, ctrs + 512 + ((P == 6 ? 6 : 7) * 3 + REP) * 8);
        if (L == 0) phase_moe_convert(p, smem, L);
    } else if constexpr (P == 7 || P == 19) {
        phase_router(p, smem, (P == 7) ? 0 : 1, REP != 0);
    } else if constexpr (P == 8 || P == 11 || P == 20 || P == 23) {
        phase_moe1(p, smem, P >= 20 ? 1 : 0, (P == 8 || P == 20) ? 0 : 1);
        if constexpr (P == 11 || P == 23) { if (REP == 0) phase_combine(p, P >= 20 ? 1 : 0, 0, P < 20, false); }
    } else if constexpr (P == 9 || P == 12 || P == 21 || P == 24) {
        phase_moe2(p, smem, P >= 20 ? 1 : 0, (P == 9 || P == 21) ? 0 : 1);
    } else if constexpr (P == 10 || P == 13 || P == 22 || P == 25) {
        if constexpr (P == 13 || P == 25) phase_combine(p, P >= 20 ? 1 : 0, 1, P < 20, REP != 0);
    }
#ifdef HAVE_L1
    else if constexpr (P == 14) {
        phase_inproj1(p, smem, ctrs + 512 + (14 * 3 + REP) * 8);
    } else if constexpr (P == 15) {
        if (gridDim.x == 256) {
            const int b = blockIdx.x;
            if (b < 128) { nsa_compress_item(p, smem, b); for (int k = 0; k < 7; ++k) gla_a_item(p, smem, b * 7 + k); }
            else { for (int k = 0; k < 9; ++k) gla_a_item(p, smem, 896 + (b - 128) * 9 + k); }
        } else
        for (int it = blockIdx.x; it < 128 + 2048; it += gridDim.x) { if (it < 128) nsa_compress_item(p, smem, it); else gla_a_item(p, smem, it - 128); }
    } else if constexpr (P == 16) {
        for (;;) {
            const int it = q_pop(&ctrs[REP ? 8 + REP : 1], smem);
            constexpr int CVB = (MOECVT_ITEMS + 15) / 16;
            if (it >= 128 + 1024 + (REP ? 0 : CVB)) break;
            if (it >= 128 + 1024) {
                const int w = tidx() >> 6;
                float* tl = (float*)smem + w * (64 * 68);
#pragma unroll 1
                for (int u = 0; u < 2; ++u) { const int wi = (it - 1152) * 16 + u * 8 + w; if (wi < MOECVT_ITEMS) moe_convert_witem(p, tl, 1, wi); }
                continue;
            }
            if (REP && it < 128) continue;
            if (it < 128) gla_scan_item(p, it);
            else { const int f = it - 128; nsa_item2(p, smem, (f & 3) * 256 + 255 - (f >> 2)); }
        }
    } else if constexpr (P == 17) {
        const int w = tidx() >> 6;
        for (int wi = blockIdx.x * 8 + w; wi < 8192; wi += gridDim.x * 8) gla_c_witem(p, wi, REP != 0);
    }
#endif
}

template <int P, int PEND> DEV void run_range(const Params& p, char* smem, const XcdBarrier& bar) {
    constexpr bool kEmpty = (P == 10 || P == 22);
    if constexpr (!kEmpty) run_phase<P>(p, smem);
#ifdef REP_PHASE
    if constexpr (P == REP_PHASE) { xcd_barrier(bar); run_phase<P, 1>(p, smem); xcd_barrier(bar); run_phase<P, 2>(p, smem); }
#endif
    if constexpr (P + 1 < PEND) { if constexpr (!kEmpty) xcd_barrier(bar); run_range<P + 1, PEND>(p, smem, bar); }
}

#ifndef NPHASE
#define NPHASE 14
#endif

template <int P0, int P1>
__global__ void __launch_bounds__(512, 2) mk_kernel(Params p) {
    extern __shared__ __attribute__((aligned(16))) char smem[];
    if (tidx() == 0) *(uint4*)(smem + SM_BARW) = make_uint4(0u, 0u, 0u, 0u);
    __syncthreads();
    XcdBarrier bar = xcd_barrier_post((unsigned*)(p.ws + O_BAR), (volatile LAS unsigned*)(smem + SM_BARW));
    run_range<P0, P1>(p, smem, bar);
}

#ifdef DBG_SANITIZE
__global__ void k_sanitize(float* o, size_t n) { for (size_t i = (size_t)blockIdx.x * blockDim.x + tidx(); i < n; i += (size_t)gridDim.x * blockDim.x) { const float v = o[i]; if (!(fabsf(v) < 1e30f)) o[i] = 0.f; } }
#endif
template <int P> static void launch_one(const Params& p, int grid, hipStream_t stream) {
    hipFuncSetAttribute((const void*)mk_kernel<P, P + 1>, hipFuncAttributeMaxDynamicSharedMemorySize, SMEM_BYTES);
    mk_kernel<P, P + 1><<<grid, NTHR, SMEM_BYTES, stream>>>(p);
}
template <int P, int PEND> static void launch_seq(const Params& p, int grid, hipStream_t stream) {
    launch_one<P>(p, grid, stream);
    if constexpr (P + 1 < PEND) launch_seq<P + 1, PEND>(p, grid, stream);
}

extern "C" void kernel_launch(void* const* d_in, const int* in_sizes, int n_in, void* d_out, int out_size, void* d_ws, size_t ws_size, hipStream_t stream) {
    if (ws_size < WS_NEED || n_in < N_IN) return;
    Params p{};
    for (int i = 0; i < N_IN; ++i) p.in[i] = (const float*)d_in[i];
    p.out = (float*)d_out;
    p.ws = (char*)d_ws;
    hipMemsetAsync(d_ws, 0, ZERO_BYTES, stream);
#ifdef MULTI_LAUNCH
    launch_seq<0, NPHASE>(p, 256, stream);
#ifdef DBG_SANITIZE
    k_sanitize<<<1024, 256, 0, stream>>>(p.out, (size_t)NT * 1024);
#endif
#else
    static int grid = 0;
    if (!grid) {
        hipFuncSetAttribute((const void*)mk_kernel<0, NPHASE>, hipFuncAttributeMaxDynamicSharedMemorySize, SMEM_BYTES);
        int dev = 0, cus = 0, per_cu = 0;
        hipGetDevice(&dev);
        hipDeviceGetAttribute(&cus, hipDeviceAttributeMultiprocessorCount, dev);
        hipOccupancyMaxActiveBlocksPerMultiprocessor(&per_cu, (const void*)mk_kernel<0, NPHASE>, NTHR, SMEM_BYTES);
        grid = per_cu >= 1 ? cus : 0;
    }
    if (grid) mk_kernel<0, NPHASE><<<grid, NTHR, SMEM_BYTES, stream>>>(p);
#endif
}
```

```cpp
#define NPHASE 26
#include <hip/hip_runtime.h>
#include <stdint.h>

typedef unsigned short bfraw;
typedef __attribute__((ext_vector_type(8))) short bf16x8;
typedef __attribute__((ext_vector_type(4))) float f32x4;
#define DEV __device__ __forceinline__
#define LAS __attribute__((address_space(3)))

constexpr int NT = 32768, TT = 16384, DM = 1024;
constexpr float EPSF = 1e-6f;
constexpr float LOG2E = 1.4426950408889634f;
constexpr int NTHR = 512;
constexpr int SMEM_BYTES = 148480;

enum { I_X = 0, I_C, I_ADAW, I_ADAB, I_NMIX, I_NFFN, I_RELB, I_EVWIN, I_EVWOUT, I_FOXFB, I_FOXQN, I_FOXKN, I_GCONV, I_GALOG,
       I_GDTB, I_GON, I_ODWIN, I_ODWOUT, I_NSAQN, I_NSAKN, I_NSAPOS, I_CW1, I_CW2, I_GLAWG, I_GLABG, I_GLAON, I_ROUTER,
       I_MBIAS, I_MWG, I_MWU, I_MWD, I_SWG, I_SWU, I_SWD, N_IN };

struct Params {
    const float* in[N_IN];
    float* out;
    char* ws;
};

constexpr size_t MiB = 1048576;
constexpr size_t O_BAR = 0;
constexpr size_t O_CNT = 16384;
constexpr size_t O_MOD = 32768;
constexpr size_t ZERO_BYTES = 262144;
constexpr int NIN0 = 3840, NIN1 = 3072;
constexpr size_t O_WIN0 = ZERO_BYTES;
constexpr size_t O_WOUT0 = O_WIN0 + (size_t)NIN0 * 1024 * 2;
constexpr size_t O_WIN1 = O_WOUT0 + (size_t)1024 * 1024 * 2;
constexpr size_t O_WOUT1 = O_WIN1 + (size_t)NIN1 * 1024 * 2;
constexpr size_t O_WRT = O_WOUT1 + (size_t)1024 * 1024 * 2;
constexpr size_t O_W1T = O_WRT + (size_t)2 * 128 * 1024 * 2;
constexpr size_t O_W2T = O_W1T + (size_t)2 * 256 * 2048 * 2;
constexpr size_t O_BIAS1 = O_W2T + (size_t)2 * 64 * 256 * 2;
constexpr size_t O_PAIRW = O_BIAS1 + 4096;
constexpr size_t O_PLIST = O_PAIRW + (size_t)NT * 6 * 4;
constexpr size_t O_HBUF = O_PLIST + (size_t)2 * 64 * 16384 * 4;
constexpr size_t O_YCAT = O_HBUF + (size_t)NT * 1024 * 2;
constexpr size_t O_R = O_YCAT + (size_t)NT * 1024 * 2;
constexpr size_t O_WGU = O_R;
constexpr size_t O_WD = O_WGU + (size_t)65 * 512 * 1024 * 2;
constexpr size_t O_R2 = O_WD + (size_t)65 * 1024 * 256 * 2;
constexpr int HROWS = 98304 + 64 * 256 + 16384;
constexpr size_t O_H = O_R2;
constexpr size_t O_Y = O_H + (size_t)HROWS * 256 * 2;
constexpr size_t O_END_MOE = O_Y + (size_t)16384 * 7 * 1024 * 2;
constexpr size_t O_QF = O_R;
constexpr size_t O_KF = O_QF + (size_t)NT * 512 * 2;
constexpr size_t O_VFT = O_KF + (size_t)NT * 512 * 2;
constexpr size_t O_G0 = O_VFT + (size_t)NT * 512 * 2;
constexpr size_t O_GZ = O_G0 + (size_t)NT * 1536 * 2;
constexpr size_t O_SM0 = O_GZ + (size_t)NT * 512 * 2;
constexpr size_t O_CUMF = O_SM0 + (size_t)NT * 16 * 4;
constexpr size_t O_MBUF = O_CUMF + (size_t)16 * TT * 4;
constexpr size_t O_NS = O_MBUF + (size_t)2048 * 128 * 128 * 2;
constexpr size_t O_SB = O_NS + (size_t)2048 * 128 * 128 * 2;
constexpr size_t O_END_L0 = O_SB + (size_t)2048 * 128 * 128 * 2;
constexpr size_t O_QEFF = O_HBUF;
constexpr size_t O_QN = O_R2;
constexpr size_t O_KCR = O_QN + (size_t)NT * 512 * 2;
constexpr size_t O_VCR = O_KCR + (size_t)NT * 128 * 2;
constexpr size_t O_KS = O_VCR + (size_t)NT * 128 * 2;
constexpr size_t O_VST = O_KS + (size_t)NT * 128 * 2;
constexpr size_t O_KW = O_VST + (size_t)NT * 128 * 2;
constexpr size_t O_VWT = O_KW + (size_t)NT * 128 * 2;
constexpr size_t O_LQ = O_VWT + (size_t)NT * 128 * 2;
constexpr size_t O_LK = O_LQ + (size_t)NT * 256 * 2;
constexpr size_t O_LV = O_LK + (size_t)NT * 256 * 2;
constexpr size_t O_LR = O_LV + (size_t)NT * 512 * 2;
constexpr size_t O_SM1 = O_LR + (size_t)NT * 512 * 2;
constexpr size_t O_KCMP = O_SM1 + (size_t)NT * 40 * 4;
constexpr size_t O_VCMPT = O_KCMP + (size_t)4 * 1024 * 64 * 2;
constexpr size_t O_QD = O_VCMPT + (size_t)4 * 1024 * 64 * 2;
constexpr size_t O_AN = O_QD + (size_t)2048 * 64 * 64 * 2;
constexpr size_t O_ST = O_AN + (size_t)2048 * 64 * 4;
constexpr size_t O_END_L1 = O_ST + (size_t)2048 * 128 * 64 * 4;
constexpr size_t WS_NEED = (O_END_MOE > O_END_L0 ? (O_END_MOE > O_END_L1 ? O_END_MOE : O_END_L1) : (O_END_L0 > O_END_L1 ? O_END_L0 : O_END_L1));
static_assert(WS_NEED < (size_t)600 * MiB, "workspace too large");

DEV int tidx() { int t = threadIdx.x; asm volatile("" : "+v"(t)); return t; }
typedef __bf16 bf2_t __attribute__((ext_vector_type(2)));
typedef float f2_t __attribute__((ext_vector_type(2)));
DEV bfraw f2bf(float f) { return __builtin_bit_cast(bfraw, (__bf16)f); }
DEV float bf2f(bfraw b) { return __uint_as_float(((uint32_t)b) << 16); }
DEV uint32_t pack2(float lo, float hi) { f2_t f = {lo, hi}; return __builtin_bit_cast(uint32_t, __builtin_convertvector(f, bf2_t)); }
DEV float lo2f(uint32_t u) { return __uint_as_float(u << 16); }
DEV float hi2f(uint32_t u) { return __uint_as_float(u & 0xffff0000u); }
DEV f32x4 mfma16(bf16x8 a, bf16x8 b, f32x4 c) { return __builtin_amdgcn_mfma_f32_16x16x32_bf16(a, b, c, 0, 0, 0); }
DEV float sigmoidf_(float x) { return 1.f / (1.f + __expf(-x)); }
DEV float siluf_(float x) { return x / (1.f + __expf(-x)); }
DEV float softplusf_(float x) { return fmaxf(x, 0.f) + log1pf(__expf(-fabsf(x))); }
DEV float logsigmoidf_(float x) { return fminf(x, 0.f) - log1pf(__expf(-fabsf(x))); }
DEV float ex2(float x) { return __builtin_amdgcn_exp2f(x); }
DEV void vm_drain() { asm volatile("s_waitcnt vmcnt(0)" ::: "memory"); }
DEV void lds_barrier() { asm volatile("s_waitcnt lgkmcnt(0)" ::: "memory"); __builtin_amdgcn_s_barrier(); asm volatile("" ::: "memory"); }
DEV void block_sync_mem() { asm volatile("s_waitcnt vmcnt(0) lgkmcnt(0)" ::: "memory"); __syncthreads(); }
union U4 { uint4 u; bf16x8 v; uint32_t w[4]; };
union U2 { uint2 u; uint32_t w[2]; };
DEV bf16x8 ld8(const bfraw* p) { U4 t; t.u = *(const uint4*)p; return t.v; }
DEV bf16x8 ld4x2(const bfraw* p0, const bfraw* p1) { U4 t; uint2 a = *(const uint2*)p0, b = *(const uint2*)p1; t.w[0] = a.x; t.w[1] = a.y; t.w[2] = b.x; t.w[3] = b.y; return t.v; }
DEV bf16x8 pack8(float a0, float a1, float a2, float a3, float a4, float a5, float a6, float a7) {
    U4 t; t.w[0] = pack2(a0, a1); t.w[1] = pack2(a2, a3); t.w[2] = pack2(a4, a5); t.w[3] = pack2(a6, a7); return t.v; }
DEV void st4bf(bfraw* p, float a, float b, float c, float d) { uint2 v; v.x = pack2(a, b); v.y = pack2(c, d); *(uint2*)p = v; }
DEV float shx(float v, int m) { const int l = tidx(); return __int_as_float(__builtin_amdgcn_ds_bpermute(((l ^ m) & 63) << 2, __float_as_int(v))); }
DEV float wave_sum(float v) { for (int m = 32; m >= 1; m >>= 1) v += shx(v, m); return v; }
DEV float wave_max(float v) { for (int m = 32; m >= 1; m >>= 1) v = fmaxf(v, shx(v, m)); return v; }
DEV float grp16_sum(float v) { v += shx(v, 1); v += shx(v, 2); v += shx(v, 4); v += shx(v, 8); return v; }
DEV float grpx_sum(float v) { v += shx(v, 16); v += shx(v, 32); return v; }

#define XB_TMO      128
#define XB_XCNT(j)  (256  + 64 * (j))
#define XB_XSUB(j)  (1280 + 64 * (j))
#define XB_XGEN(j)  (2304 + 64 * (j))
#define XB_TOP      3328
#define XB_TOPGEN   3392
#define XCD_BAR_WORDS 3456
#define XB_SPIN_CAP (1u << 27)
DEV unsigned xb_ld(unsigned* p)              { return __hip_atomic_load(p, __ATOMIC_RELAXED, __HIP_MEMORY_SCOPE_AGENT); }
DEV unsigned xb_add(unsigned* p, unsigned v) { return __hip_atomic_fetch_add(p, v, __ATOMIC_RELAXED, __HIP_MEMORY_SCOPE_AGENT); }
DEV unsigned xb_xcc_id() { return (unsigned)__builtin_amdgcn_s_getreg((3 << 11) | 20) & 0xFu; }
#define XB_SPIN(cond, bar) do { unsigned _sp = 0; while (cond) { __builtin_amdgcn_s_sleep(1); \
    if ((++_sp & 255u) == 0u) { if (xb_ld(&(bar)[XB_TMO])) break; if (_sp > XB_SPIN_CAP) { atomicAdd(&(bar)[XB_TMO], 1u); break; } } } } while (0)
struct XcdBarrier { unsigned* bar; unsigned x; volatile LAS unsigned* st; };
DEV XcdBarrier xcd_barrier_post(unsigned* bar, volatile LAS unsigned* st) {
    XcdBarrier b; b.bar = bar; b.x = xb_xcc_id(); b.st = st;
    if (tidx() == 0) (void)xb_add(&bar[XB_XCNT(b.x)], 1u);
    return b;
}
DEV void xcd_barrier_complete(unsigned* bar, unsigned x, unsigned& nloc, unsigned& nx) {
    const unsigned G = gridDim.x * gridDim.y * gridDim.z;
    unsigned sum, cnt, mine, sp = 0u;
    for (;;) {
        sum = 0u; cnt = 0u; mine = 0u;
#pragma unroll
        for (unsigned j = 0; j < 16; ++j) { const unsigned c = xb_ld(&bar[XB_XCNT(j)]); sum += c; cnt += (c > 0u) ? 1u : 0u; mine = (j == x) ? c : mine; }
        if (sum == G) break;
        __builtin_amdgcn_s_sleep(1);
        if ((++sp & 255u) == 0u) { if (xb_ld(&bar[XB_TMO])) break; if (sp > XB_SPIN_CAP) { atomicAdd(&bar[XB_TMO], 1u); break; } }
    }
    nloc = mine > 0u ? mine : 1u; nx = cnt > 0u ? cnt : 1u;
}
DEV void xcd_barrier(const XcdBarrier& b) {
    asm volatile("s_waitcnt vmcnt(0)" ::: "memory");
    __syncthreads();
    if (tidx() == 0) {
        unsigned* bar = b.bar;
        __builtin_amdgcn_s_waitcnt(0);
        unsigned nloc = b.st[0], nx = b.st[1];
        if (nloc == 0u) { xcd_barrier_complete(bar, b.x, nloc, nx); b.st[0] = nloc; b.st[1] = nx; }
        const unsigned old = xb_add(&bar[XB_XSUB(b.x)], 1u);
        const unsigned gen = old / nloc;
        if (old + 1u == (gen + 1u) * nloc) {
            __builtin_amdgcn_fence(__ATOMIC_RELEASE, "agent");
            asm volatile("s_waitcnt vmcnt(0)" ::: "memory");
            const unsigned og = xb_add(&bar[XB_TOP], 1u);
            const unsigned tg = og / nx;
            if (og + 1u == (tg + 1u) * nx) xb_add(&bar[XB_TOPGEN], 1u);
            else XB_SPIN(xb_ld(&bar[XB_TOPGEN]) == tg, bar);
            __builtin_amdgcn_fence(__ATOMIC_ACQUIRE, "agent");
            xb_add(&bar[XB_XGEN(b.x)], 1u);
            asm volatile("s_waitcnt vmcnt(0)" ::: "memory");
        } else {
            XB_SPIN(xb_ld(&bar[XB_XGEN(b.x)]) == gen, bar);
            __builtin_amdgcn_fence(__ATOMIC_ACQUIRE, "agent");
            asm volatile("s_waitcnt vmcnt(0)" ::: "memory");
        }
    }
    __syncthreads();
}

template <class AP, class BP, class EPI>
DEV void gemm_tile(char* smem, int nk, int a_kstep, AP aptr, BP bptr, EPI epi) {
    bfraw* As = (bfraw*)smem; bfraw* Bs = As + 256 * 72;
    const int tid = tidx(), lane = tid & 63, w = tid >> 6, wr = w >> 1, wc = w & 1;
    const int seg = tid & 7, r0 = tid >> 3;
    const bfraw* pa[4]; const bfraw* pb[2];
#pragma unroll
    for (int i = 0; i < 4; ++i) pa[i] = aptr(r0 + 64 * i) + seg * 8;
#pragma unroll
    for (int i = 0; i < 2; ++i) pb[i] = bptr(r0 + 64 * i) + seg * 8;
    uint4 ra0 = *(const uint4*)pa[0], ra1 = *(const uint4*)pa[1], ra2 = *(const uint4*)pa[2], ra3 = *(const uint4*)pa[3];
    uint4 rb0 = *(const uint4*)pb[0], rb1 = *(const uint4*)pb[1];
    f32x4 acc[4][4];
#pragma unroll
    for (int i = 0; i < 4; ++i)
#pragma unroll
        for (int j = 0; j < 4; ++j) acc[i][j] = f32x4{0.f, 0.f, 0.f, 0.f};
    for (int kt = 0; kt < nk; ++kt) {
        __syncthreads();
        *(uint4*)&As[(r0) * 72 + seg * 8] = ra0;
        *(uint4*)&As[(r0 + 64) * 72 + seg * 8] = ra1;
        *(uint4*)&As[(r0 + 128) * 72 + seg * 8] = ra2;
        *(uint4*)&As[(r0 + 192) * 72 + seg * 8] = ra3;
        *(uint4*)&Bs[(r0) * 72 + seg * 8] = rb0;
        *(uint4*)&Bs[(r0 + 64) * 72 + seg * 8] = rb1;
        __syncthreads();
        if (kt + 1 < nk) {
            const size_t ao = (size_t)(kt + 1) * a_kstep, bo = (size_t)(kt + 1) * 64;
            ra0 = *(const uint4*)(pa[0] + ao); ra1 = *(const uint4*)(pa[1] + ao); ra2 = *(const uint4*)(pa[2] + ao); ra3 = *(const uint4*)(pa[3] + ao);
            rb0 = *(const uint4*)(pb[0] + bo); rb1 = *(const uint4*)(pb[1] + bo);
        }
#pragma unroll
        for (int ks = 0; ks < 2; ++ks) {
            bf16x8 af[4], bfr[4];
#pragma unroll
            for (int i = 0; i < 4; ++i) af[i] = ld8(&As[(wr * 64 + i * 16 + (lane & 15)) * 72 + ks * 32 + (lane >> 4) * 8]);
#pragma unroll
            for (int j = 0; j < 4; ++j) bfr[j] = ld8(&Bs[(wc * 64 + j * 16 + (lane & 15)) * 72 + ks * 32 + (lane >> 4) * 8]);
#pragma unroll
            for (int i = 0; i < 4; ++i)
#pragma unroll
                for (int j = 0; j < 4; ++j) acc[i][j] = mfma16(af[i], bfr[j], acc[i][j]);
        }
    }
    epi(acc, wr * 64, wc * 64, lane);
}

constexpr int GLD = 72;
constexpr int GBUF = 512 * GLD;
template <bool AFFA = true, bool SGB = true, class AP, class BP, class EPI>
DEV void gemm_tile2(char* smem, int nk, int a_kstep, AP aptr, BP bptr, EPI epi) {
    bfraw* As = (bfraw*)smem;
    const int tid = tidx(), lane = tid & 63, w = tid >> 6, wr = w >> 2, wc = w & 3;
    const int seg = tid & 7, r0 = tid >> 3;
    const bfraw* pa0 = aptr(r0) + seg * 8;
    const int ast = (int)(aptr(r0 + 64) - aptr(r0));
    const bfraw* pa1 = AFFA ? pa0 + ast : aptr(r0 + 64) + seg * 8; const bfraw* pa2 = AFFA ? pa0 + 2 * ast : aptr(r0 + 128) + seg * 8; const bfraw* pa3 = AFFA ? pa0 + 3 * ast : aptr(r0 + 192) + seg * 8;
    const bfraw* pb0 = bptr(r0) + seg * 8;
    const int bst = (int)(bptr(r0 + 64) - bptr(r0));
    uint4 ra0 = *(const uint4*)pa0, ra1 = *(const uint4*)pa1, ra2 = *(const uint4*)pa2, ra3 = *(const uint4*)pa3;
    uint4 rb0 = *(const uint4*)pb0, rb1 = *(const uint4*)(pb0 + bst), rb2 = *(const uint4*)(pb0 + 2 * bst), rb3 = *(const uint4*)(pb0 + 3 * bst);
    f32x4 acc[8][4];
#pragma unroll
    for (int i = 0; i < 8; ++i)
#pragma unroll
        for (int j = 0; j < 4; ++j) acc[i][j] = f32x4{0.f, 0.f, 0.f, 0.f};
    const int so = r0 * GLD + seg * 8;
    const int fo = (lane & 15) * GLD + (lane >> 4) * 8;
    lds_barrier();
    {
        bfraw* Aw = As + so;
        *(uint4*)&Aw[0] = ra0; *(uint4*)&Aw[64 * GLD] = ra1; *(uint4*)&Aw[128 * GLD] = ra2; *(uint4*)&Aw[192 * GLD] = ra3;
        *(uint4*)&Aw[256 * GLD] = rb0; *(uint4*)&Aw[320 * GLD] = rb1; *(uint4*)&Aw[384 * GLD] = rb2; *(uint4*)&Aw[448 * GLD] = rb3;
        const size_t ao = (size_t)a_kstep, bo = 64;
        __builtin_amdgcn_sched_barrier(0);
        ra0 = *(const uint4*)(pa0 + ao); __builtin_amdgcn_sched_barrier(0); rb0 = *(const uint4*)(pb0 + bo); __builtin_amdgcn_sched_barrier(0);
        ra1 = *(const uint4*)(pa1 + ao); __builtin_amdgcn_sched_barrier(0); rb1 = *(const uint4*)(pb0 + (bst + bo)); __builtin_amdgcn_sched_barrier(0);
        ra2 = *(const uint4*)(pa2 + ao); __builtin_amdgcn_sched_barrier(0); rb2 = *(const uint4*)(pb0 + (2 * bst + bo)); __builtin_amdgcn_sched_barrier(0);
        ra3 = *(const uint4*)(pa3 + ao); __builtin_amdgcn_sched_barrier(0); rb3 = *(const uint4*)(pb0 + (3 * bst + bo)); __builtin_amdgcn_sched_barrier(0);
    }
#define GT_WL(i, W, L)                                                                                                               \
    if (W) {                                                                                                                         \
        if (i == 0) { *(uint4*)&Aw[0] = ra0; if (L) ra0 = *(const uint4*)(pa0 + ao); }                                               \
        if (i == 1) { *(uint4*)&Aw[256 * GLD] = rb0; if (L) rb0 = *(const uint4*)(pb0 + bo); }                                       \
        if (i == 2) { *(uint4*)&Aw[64 * GLD] = ra1; if (L) ra1 = *(const uint4*)(pa1 + ao); }                                        \
        if (i == 3) { *(uint4*)&Aw[320 * GLD] = rb1; if (L) rb1 = *(const uint4*)(pb0 + (bst + bo)); }                               \
        if (i == 4) { *(uint4*)&Aw[128 * GLD] = ra2; if (L) ra2 = *(const uint4*)(pa2 + ao); }                                       \
        if (i == 5) { *(uint4*)&Aw[384 * GLD] = rb2; if (L) rb2 = *(const uint4*)(pb0 + (2 * bst + bo)); }                           \
        if (i == 6) { *(uint4*)&Aw[192 * GLD] = ra3; if (L) ra3 = *(const uint4*)(pa3 + ao); }                                       \
        if (i == 7) { *(uint4*)&Aw[448 * GLD] = rb3; if (L) rb3 = *(const uint4*)(pb0 + (3 * bst + bo)); }                           \
    }
#define GT_BODY(W, L)                                                                                                                \
    {                                                                                                                                \
        lds_barrier();                                                                                                               \
        const int cur = kt & 1;                                                                                                      \
        const bfraw* Ac = As + cur * GBUF + fo;                                                                                      \
        bfraw* Aw = As + (cur ^ 1) * GBUF + so;                                                                                      \
        const size_t ao = (size_t)(kt + 2) * a_kstep, bo = (size_t)(kt + 2) * 64;                                                    \
        _Pragma("unroll") for (int ks = 0; ks < 2; ++ks) {                                                                           \
            const bfraw* Ab = Ac + (wr * 128) * GLD + ks * 32;                                                                       \
            const bfraw* Bb = Ac + (256 + wc * 64) * GLD + ks * 32;                                                                  \
            bf16x8 bfr[4], af[8];                                                                                                    \
            _Pragma("unroll") for (int j = 0; j < 4; ++j) bfr[j] = ld8(Bb + j * 16 * GLD);                                           \
            af[0] = ld8(Ab); af[1] = ld8(Ab + 16 * GLD);                                                                             \
            _Pragma("unroll") for (int i = 0; i < 8; ++i) {                                                                          \
                _Pragma("unroll") for (int j = 0; j < 4; ++j) acc[i][j] = mfma16(bfr[j], af[i], acc[i][j]);                          \
                if (i + 2 < 8) af[i + 2] = ld8(Ab + (i + 2) * 16 * GLD);                                                             \
                if (ks == 1) { GT_WL(i, W, L) }                                                                                      \
            }                                                                                                                        \
            if (SGB) {                                                                                                               \
                __builtin_amdgcn_sched_group_barrier(0x100, 6, 0);                                                                   \
                _Pragma("unroll") for (int i = 0; i < 8; ++i) {                                                                      \
                    __builtin_amdgcn_sched_group_barrier(0x008, 4, 0);                                                               \
                    if (i + 2 < 8) __builtin_amdgcn_sched_group_barrier(0x100, 1, 0);                                                \
                    if (ks == 1 && W) __builtin_amdgcn_sched_group_barrier(0x200, 1, 0);                                             \
                    if (ks == 1 && W && L) __builtin_amdgcn_sched_group_barrier(0x020, 1, 0);                                        \
                }                                                                                                                    \
            }                                                                                                                        \
        }                                                                                                                            \
    }
    int kt = 0;
    for (; kt + 2 < nk; ++kt) GT_BODY(1, 1)
    GT_BODY(1, 0)
    ++kt;
    GT_BODY(0, 0)
#undef GT_BODY
#undef GT_WL
    epi(acc, wr * 128, wc * 64, lane);
}

DEV bool xq_next(unsigned* q, int nN, char* smem, int& mt, int& nt) {
    int* slot = (int*)(smem + 148000);
    __syncthreads();
    if (tidx() == 0) {
        const int T = 16 * nN, x0 = (int)xb_xcc_id() & 7;
        int res = -1;
        for (int k = 0; k < 8 && res < 0; ++k) {
            const int x = (x0 + k) & 7;
            if (xb_ld(&q[x]) < (unsigned)T) { const unsigned s = atomicAdd(&q[x], 1u); if (s < (unsigned)T) res = x * T + (int)s; }
        }
        *slot = res;
    }
    __syncthreads();
    const int res = *slot;
    if (res < 0) return false;
    const int T = 16 * nN, x = res / T, s = res % T, mg = s / (4 * nN), rem = s % (4 * nN);
    nt = rem >> 2; mt = x * 16 + mg * 4 + (rem & 3);
    return true;
}

DEV bool xs_tile(int nN, int rr, int& mt, int& nt) {
    const int T = 16 * nN;
    int G = (int)gridDim.x, bid = (int)blockIdx.x;
    asm volatile("" : "+s"(G), "+s"(bid));
    int gidx;
    if ((G & 7) == 0) { const int bpx = G >> 3, s = (bid >> 3) + bpx * rr; if (s >= T) return false; gidx = (bid & 7) * T + s; }
    else { gidx = bid + G * rr; if (gidx >= 8 * T) return false; }
    const int x = gidx / T, s = gidx % T, mg = s / (4 * nN), rem = s % (4 * nN);
    nt = __builtin_amdgcn_readfirstlane(rem >> 2); mt = __builtin_amdgcn_readfirstlane(x * 16 + mg * 4 + (rem & 3));
    return true;
}

template <class CM>
DEV void tr_tile_w(float* tl, const float* src, size_t ldsrc, bfraw* dst, size_t lddst, int k0, int n0, CM cmap) {
    const int lane = tidx() & 63;
    const int c4 = (lane & 15) * 4, r = lane >> 4;
    const int sc = cmap(n0 + c4);
    float4 v[16];
#pragma unroll
    for (int ps = 0; ps < 16; ++ps) v[ps] = sc >= 0 ? *(const float4*)(src + (size_t)(k0 + ps * 4 + r) * ldsrc + sc) : make_float4(0.f, 0.f, 0.f, 0.f);
#pragma unroll
    for (int ps = 0; ps < 16; ++ps) *(float4*)&tl[(ps * 4 + r) * 68 + c4] = v[ps];
    const int n = lane;
#pragma unroll
    for (int ks = 0; ks < 8; ++ks) {
        float q[8];
#pragma unroll
        for (int j = 0; j < 8; ++j) q[j] = tl[(ks * 8 + j) * 68 + n];
        uint4 o; o.x = pack2(q[0], q[1]); o.y = pack2(q[2], q[3]); o.z = pack2(q[4], q[5]); o.w = pack2(q[6], q[7]);
        *(uint4*)&dst[(size_t)(n0 + n) * lddst + k0 + ks * 8] = o;
    }
}
template <class CM>
DEV void tr_tile(char* smem, const float* src, size_t ldsrc, bfraw* dst, size_t lddst, int k0, int n0, CM cmap) {
    float* tl = (float*)smem;
    const int tid = tidx();
    {
        const int c = tid & 63, r = tid >> 6;
        const int sc = cmap(n0 + c);
#pragma unroll
        for (int ps = 0; ps < 8; ++ps) {
            const int k = ps * 8 + r;
            tl[k * 65 + c] = sc >= 0 ? src[(size_t)(k0 + k) * ldsrc + sc] : 0.f;
        }
    }
    __syncthreads();
    {
        const int n = tid >> 3, ks = tid & 7;
        float v[8];
#pragma unroll
        for (int q = 0; q < 8; ++q) v[q] = tl[(ks * 8 + q) * 65 + n];
        uint4 o; o.x = pack2(v[0], v[1]); o.y = pack2(v[2], v[3]); o.z = pack2(v[4], v[5]); o.w = pack2(v[6], v[7]);
        *(uint4*)&dst[(size_t)(n0 + n) * lddst + k0 + ks * 8] = o;
    }
    __syncthreads();
}
DEV int map_in0(int n) {
    if (n < 1536) return n;
    if (n < 3072) return 1544 + (n - 1536);
    if (n < 3584) return 3088 + (n - 3072);
    if (n < 3592) return 1536 + (n - 3584);
    if (n < 3596) return 3080 + (n - 3592);
    if (n < 3600) return 3084 + (n - 3596);
    return -1;
}
DEV int map_in1(int n) {
    if (n < 1280) return n;
    if (n < 1536) return 1304 + (n - 1280);
    if (n < 1792) return 1560 + (n - 1536);
    if (n < 2304) return 1816 + (n - 1792);
    if (n < 2816) return 2344 + (n - 2304);
    if (n < 2840) return 1280 + (n - 2816);
    if (n < 2856) return 2328 + (n - 2840);
    return -1;
}

DEV void prologue_item(const Params& p, char* smem, int item) {
    const int tid = tidx();
    {
        const int l = item / 96, nch = item % 96;
        const int n = nch * 64 + (tid & 63), kg = tid >> 6, k0 = kg * 128;
        const float* W = p.in[I_ADAW] + (size_t)l * 1024 * 6144;
        const float* c = p.in[I_C];
        float a0 = 0.f, a1 = 0.f;
#pragma unroll 8
        for (int k = 0; k < 128; ++k) {
            const float wv = W[(size_t)(k0 + k) * 6144 + n];
            a0 += siluf_(c[k0 + k]) * wv; a1 += siluf_(c[1024 + k0 + k]) * wv;
        }
        float* red = (float*)smem;
        __syncthreads();
        red[tid] = a0; red[512 + tid] = a1;
        __syncthreads();
        if (tid < 128) {
            const int bb = tid >> 6, nn = tid & 63;
            float sacc = p.in[I_ADAB][l * 6144 + nch * 64 + nn];
#pragma unroll
            for (int q = 0; q < 8; ++q) sacc += red[bb * 512 + q * 64 + nn];
            ((float*)(p.ws + O_MOD))[(l * 2 + bb) * 6144 + nch * 64 + nn] = sacc;
        }
        __syncthreads();
    }
}
constexpr int PRO_WITEMS = 960 + 256 + 768 + 256 + 64 + 256 + 8;
DEV void prologue_witem(const Params& p, float* tl, int item) {
    if (item < 960) { tr_tile_w(tl, p.in[I_EVWIN], 3600, (bfraw*)(p.ws + O_WIN0), 1024, (item % 16) * 64, (item / 16) * 64, [](int n) { return map_in0(n); }); return; }
    item -= 960;
    if (item < 256) { tr_tile_w(tl, p.in[I_EVWOUT], 1024, (bfraw*)(p.ws + O_WOUT0), 1024, (item % 16) * 64, (item / 16) * 64, [](int n) { return n; }); return; }
    item -= 256;
    if (item < 768) { tr_tile_w(tl, p.in[I_ODWIN], 2856, (bfraw*)(p.ws + O_WIN1), 1024, (item % 16) * 64, (item / 16) * 64, [](int n) { return map_in1(n); }); return; }
    item -= 768;
    if (item < 256) { tr_tile_w(tl, p.in[I_ODWOUT], 1024, (bfraw*)(p.ws + O_WOUT1), 1024, (item % 16) * 64, (item / 16) * 64, [](int n) { return n; }); return; }
    item -= 256;
    if (item < 64) {
        const int l = item / 32, rem = item % 32;
        tr_tile_w(tl, p.in[I_ROUTER] + (size_t)l * 1024 * 64, 64, (bfraw*)(p.ws + O_WRT) + (size_t)l * 128 * 1024, 1024, (rem % 16) * 64, (rem / 16) * 64, [](int n) { return n < 64 ? n : -1; });
        return;
    }
    item -= 64;
    if (item < 256) {
        const int wh = item / 128, rem = item % 128;
        tr_tile_w(tl, p.in[I_CW1] + (size_t)wh * 2048 * 256, 256, (bfraw*)(p.ws + O_W1T) + (size_t)wh * 256 * 2048, 2048, (rem % 32) * 64, (rem / 32) * 64, [](int n) { return n; });
        return;
    }
    item -= 256;
    { const int wh = item / 4, kt = item % 4;
      tr_tile_w(tl, p.in[I_CW2] + (size_t)wh * 256 * 64, 64, (bfraw*)(p.ws + O_W2T) + (size_t)wh * 64 * 256, 256, kt * 64, 0, [](int n) { return n; }); }
}
DEV void prologue_bias1(const Params& p, char* smem, int wh) {
    const int tid = tidx();
    const float* pos = p.in[I_NSAPOS] + wh * 2048;
    const float* w1 = p.in[I_CW1] + (size_t)wh * 2048 * 256;
    const int j = tid & 255, kh = tid >> 8;
    float a = 0.f;
    for (int kk = kh * 1024; kk < kh * 1024 + 1024; ++kk) a += pos[kk] * w1[(size_t)kk * 256 + j];
    float* red = (float*)smem;
    __syncthreads();
    if (kh == 1) red[j] = a;
    __syncthreads();
    if (kh == 0) ((float*)(p.ws + O_BIAS1))[wh * 256 + j] = a + red[j];
    __syncthreads();
}
DEV void phase_prologue(const Params& p, char* smem) {
    for (int it = blockIdx.x; it < 192 + 2; it += gridDim.x) { if (it < 192) prologue_item(p, smem, it); else prologue_bias1(p, smem, it - 192); }
    const int w = tidx() >> 6;
    float* tl = (float*)smem + w * (64 * 68);
    __syncthreads();
    for (int it = blockIdx.x * 8 + w; it < PRO_WITEMS; it += gridDim.x * 8) prologue_witem(p, tl, it);
    __syncthreads();
}

constexpr int MOECVT_ITEMS = 65 * 192;
DEV void moe_convert_witem(const Params& p, float* tl, int layer, int item) {
    const int e = item / 192, s = item % 192;
    bfraw* wgu = (bfraw*)(p.ws + O_WGU) + (size_t)e * 512 * 1024;
    bfraw* wd = (bfraw*)(p.ws + O_WD) + (size_t)e * 1024 * 256;
    const size_t eo = (size_t)(layer * 64 + e) * 1024 * 256, so = (size_t)layer * 1024 * 256;
    if (s < 64) {
        const float* src = e < 64 ? p.in[I_MWG] + eo : p.in[I_SWG] + so;
        tr_tile_w(tl, src, 256, wgu, 1024, (s % 16) * 64, (s / 16) * 64, [](int n) { return n; });
    } else if (s < 128) {
        const int s2 = s - 64;
        const float* src = e < 64 ? p.in[I_MWU] + eo : p.in[I_SWU] + so;
        tr_tile_w(tl, src, 256, wgu + (size_t)256 * 1024, 1024, (s2 % 16) * 64, (s2 / 16) * 64, [](int n) { return n; });
    } else {
        const int s2 = s - 128;
        const float* src = e < 64 ? p.in[I_MWD] + eo : p.in[I_SWD] + so;
        tr_tile_w(tl, src, 1024, wd, 256, (s2 % 4) * 64, (s2 / 4) * 64, [](int n) { return n; });
    }
}
DEV void phase_moe_convert(const Params& p, char* smem, int layer) {
    const int w = tidx() >> 6;
    float* tl = (float*)smem + w * (64 * 68);
    __syncthreads();
    for (int it = blockIdx.x * 8 + w; it < MOECVT_ITEMS; it += gridDim.x * 8) moe_convert_witem(p, tl, layer, it);
    __syncthreads();
}

DEV void norm_row(const float* xrow, const float* gain, const float* sc, const float* sh, bfraw* drow, int lane) {
    float4 v[4]; float ss = 0.f;
#pragma unroll
    for (int i = 0; i < 4; ++i) { v[i] = *(const float4*)(xrow + lane * 4 + 256 * i); ss += v[i].x * v[i].x + v[i].y * v[i].y + v[i].z * v[i].z + v[i].w * v[i].w; }
    ss = wave_sum(ss);
    const float rs = rsqrtf(ss * (1.f / 1024.f) + EPSF);
#pragma unroll
    for (int i = 0; i < 4; ++i) {
        const int c = lane * 4 + 256 * i;
        const float4 g = *(const float4*)(gain + c), s1 = *(const float4*)(sc + c), s0 = *(const float4*)(sh + c);
        st4bf(drow + c, v[i].x * rs * g.x * (1.f + s1.x) + s0.x, v[i].y * rs * g.y * (1.f + s1.y) + s0.y,
                        v[i].z * rs * g.z * (1.f + s1.z) + s0.z, v[i].w * rs * g.w * (1.f + s1.w) + s0.w);
    }
}
DEV const float* modp(const Params& p, int layer, int b, int chunk) { return (const float*)(p.ws + O_MOD) + (size_t)(layer * 2 + b) * 6144 + chunk * 1024; }

DEV void phase_norm1(const Params& p, const float* xsrc, int layer) {
    const int lane = tidx() & 63, w = tidx() >> 6;
    bfraw* hb = (bfraw*)(p.ws + O_HBUF);
    for (int row = blockIdx.x * 8 + w; row < NT; row += gridDim.x * 8) {
        const int b = row >> 14;
        norm_row(xsrc + (size_t)row * 1024, p.in[I_NMIX] + layer * 1024, modp(p, layer, b, 1), modp(p, layer, b, 0), hb + (size_t)row * 1024, lane);
    }
}

template <int NI>
DEV void epi2_headnorm(const f32x4 (&acc)[NI][4], int lane, const float* gain, float mul, bfraw* dst, size_t rstride) {
    const int c = lane & 15, g = lane >> 4;
    float4 gn[4];
#pragma unroll
    for (int j = 0; j < 4; ++j) { gn[j] = *(const float4*)(gain + j * 16 + 4 * g); gn[j].x *= mul; gn[j].y *= mul; gn[j].z *= mul; gn[j].w *= mul; }
#pragma unroll
    for (int i = 0; i < NI; ++i) {
        float ss = 0.f;
#pragma unroll
        for (int j = 0; j < 4; ++j) ss += acc[i][j][0] * acc[i][j][0] + acc[i][j][1] * acc[i][j][1] + acc[i][j][2] * acc[i][j][2] + acc[i][j][3] * acc[i][j][3];
        ss = grpx_sum(ss);
        const float rs = rsqrtf(ss * (1.f / 64.f) + EPSF);
        bfraw* d = dst + (size_t)(i * 16 + c) * rstride + 4 * g;
#pragma unroll
        for (int j = 0; j < 4; ++j) st4bf(d + j * 16, acc[i][j][0] * rs * gn[j].x, acc[i][j][1] * rs * gn[j].y, acc[i][j][2] * rs * gn[j].z, acc[i][j][3] * rs * gn[j].w);
    }
}
template <int NI>
DEV void epi2_store_bf16(const f32x4 (&acc)[NI][4], int lane, bfraw* dst, size_t rstride) {
    const int c = lane & 15, g = lane >> 4;
#pragma unroll
    for (int i = 0; i < NI; ++i) {
        bfraw* d = dst + (size_t)(i * 16 + c) * rstride + 4 * g;
#pragma unroll
        for (int j = 0; j < 4; ++j) st4bf(d + j * 16, acc[i][j][0], acc[i][j][1], acc[i][j][2], acc[i][j][3]);
    }
}
template <int NI>
DEV void epi2_store_T(const f32x4 (&acc)[NI][4], int lane, bfraw* dstT, size_t cstride) {
    const int c = lane & 15, g = lane >> 4;
#pragma unroll
    for (int i = 0; i < NI; ++i)
#pragma unroll
        for (int j = 0; j < 4; ++j)
#pragma unroll
            for (int r = 0; r < 4; ++r) dstT[(size_t)(j * 16 + 4 * g + r) * cstride + i * 16 + c] = f2bf(acc[i][j][r]);
}

DEV void phase_inproj0(const Params& p, char* smem, unsigned* xq) {
    const bfraw* A = (const bfraw*)(p.ws + O_HBUF);
    const bfraw* Bt = (const bfraw*)(p.ws + O_WIN0);
    constexpr int NTL = NIN0 / 256;
    for (int rr = 0;; ++rr) {
        int mt, nt;
        if (!xs_tile(NTL, rr, mt, nt)) break;
        const int m0 = __builtin_amdgcn_readfirstlane(mt * 256), n0 = __builtin_amdgcn_readfirstlane(nt * 256);
        gemm_tile2(smem, 16, 64,
            [&](int r) { return A + (size_t)(m0 + r) * 1024; },
            [&](int r) { return Bt + (size_t)(n0 + r) * 1024; },
            [&](const f32x4 (&acc)[8][4], int rb, int cbk, int lane) {
                const int cb = n0 + cbk;
                const int tok0 = m0 + rb;
                const int b = tok0 >> 14, t0 = tok0 & (TT - 1);
                if (cb < 512) {
                    const int hh = cb >> 6;
                    epi2_headnorm<8>(acc, lane, p.in[I_FOXQN], 0.125f * LOG2E, (bfraw*)(p.ws + O_QF) + ((size_t)(b * 8 + hh) * TT + t0) * 64, 64);
                } else if (cb < 1024) {
                    const int hh = (cb - 512) >> 6;
                    epi2_headnorm<8>(acc, lane, p.in[I_FOXKN], 1.f, (bfraw*)(p.ws + O_KF) + ((size_t)(b * 8 + hh) * TT + t0) * 64, 64);
                } else if (cb < 1536) {
                    const int hh = (cb - 1024) >> 6;
                    epi2_store_T<8>(acc, lane, (bfraw*)(p.ws + O_VFT) + (size_t)(b * 8 + hh) * 64 * TT + t0, TT);
                } else if (cb < 3072) {
                    epi2_store_bf16<8>(acc, lane, (bfraw*)(p.ws + O_G0) + (size_t)tok0 * 1536 + (cb - 1536), 1536);
                } else if (cb < 3584) {
                    epi2_store_bf16<8>(acc, lane, (bfraw*)(p.ws + O_GZ) + (size_t)tok0 * 512 + (cb - 3072), 512);
                } else if (cb == 3584) {
                    const int c = lane & 15, g = lane >> 4;
                    float* sm = (float*)(p.ws + O_SM0);
#pragma unroll
                    for (int i = 0; i < 8; ++i) *(float4*)&sm[(size_t)(tok0 + i * 16 + c) * 16 + 4 * g] = make_float4(acc[i][0][0], acc[i][0][1], acc[i][0][2], acc[i][0][3]);
                }
            });
    }
}

DEV void fox_cumsum_item(const Params& p, char* smem, int item) {
    const int b = item >> 3, h = item & 7, tid = tidx();
    const float* sm = (const float*)(p.ws + O_SM0);
    const float fb = p.in[I_FOXFB][h];
    float v[32]; float run = 0.f;
    const int tb = tid * 32;
#pragma unroll
    for (int i = 0; i < 32; ++i) { run += logsigmoidf_(sm[(size_t)(b * TT + tb + i) * 16 + h] + fb) * LOG2E; v[i] = run; }
    float* red = (float*)smem;
    __syncthreads();
    red[tid] = run;
    __syncthreads();
    if (tid < 64) {
        float s[8]; float a = 0.f;
#pragma unroll
        for (int i = 0; i < 8; ++i) { a += red[tid * 8 + i]; s[i] = a; }
        float incl = a;
        for (int m = 1; m < 64; m <<= 1) { const float o = __shfl_up(incl, m); if (tid >= m) incl += o; }
        const float excl = incl - a;
#pragma unroll
        for (int i = 0; i < 8; ++i) red[512 + tid * 8 + i] = excl + s[i] - red[tid * 8 + i];
    }
    __syncthreads();
    const float off = red[512 + tid];
    float* cf = (float*)(p.ws + O_CUMF) + (size_t)item * TT + tb;
#pragma unroll
    for (int i = 0; i < 32; ++i) cf[i] = v[i] + off;
    __syncthreads();
}
DEV void fox_item(const Params& p, int bh, int qb) {
    const int lane = tidx() & 63, w = tidx() >> 6, c = lane & 15, g = lane >> 4;
    const int b = bh >> 3, h = bh & 7;
    const bfraw* Q = (const bfraw*)(p.ws + O_QF) + (size_t)bh * TT * 64;
    const bfraw* K = (const bfraw*)(p.ws + O_KF) + (size_t)bh * TT * 64;
    const bfraw* VT = (const bfraw*)(p.ws + O_VFT) + (size_t)bh * 64 * TT;
    const float* cum = (const float*)(p.ws + O_CUMF) + (size_t)bh * TT;
    const float mq = wave_max(fabsf(p.in[I_FOXQN][lane])), mk = wave_max(fabsf(p.in[I_FOXKN][lane]));
    const float Mb2 = 8.f * mq * mk * LOG2E;
    const int q0w = qb * 256 + w * 32;
    int tq[2]; float cq[2]; bf16x8 qf[2][2]; f32x4 O[2][4]; float l[2];
#pragma unroll
    for (int cg = 0; cg < 2; ++cg) {
        tq[cg] = q0w + cg * 16 + c; cq[cg] = cum[tq[cg]] - Mb2; l[cg] = 0.f;
#pragma unroll
        for (int ks = 0; ks < 2; ++ks) qf[cg][ks] = ld8(Q + (size_t)tq[cg] * 64 + ks * 32 + g * 8);
#pragma unroll
        for (int dt = 0; dt < 4; ++dt) O[cg][dt] = f32x4{0.f, 0.f, 0.f, 0.f};
    }
    for (int kb = 0; kb <= q0w; kb += 32) {
        bf16x8 kf[2][2], vf[4]; float4 ck[2];
#pragma unroll
        for (int kt = 0; kt < 2; ++kt) {
#pragma unroll
            for (int ks = 0; ks < 2; ++ks) kf[kt][ks] = ld8(K + (size_t)(kb + kt * 16 + c) * 64 + ks * 32 + g * 8);
            ck[kt] = *(const float4*)(cum + kb + kt * 16 + 4 * g);
        }
#pragma unroll
        for (int dt = 0; dt < 4; ++dt) { const bfraw* vp = VT + (size_t)(dt * 16 + c) * TT + kb + 4 * g; vf[dt] = ld4x2(vp, vp + 16); }
        const bool diag = (kb == q0w);
#pragma unroll
        for (int cg = 0; cg < 2; ++cg) {
            float pr[2][4];
#pragma unroll
            for (int kt = 0; kt < 2; ++kt) {
                f32x4 S = mfma16(kf[kt][0], qf[cg][0], f32x4{0.f, 0.f, 0.f, 0.f});
                S = mfma16(kf[kt][1], qf[cg][1], S);
                const float ckv[4] = {ck[kt].x, ck[kt].y, ck[kt].z, ck[kt].w};
#pragma unroll
                for (int r = 0; r < 4; ++r) {
                    float e = ex2(S[r] + cq[cg] - ckv[r]);
                    if (diag && (kb + kt * 16 + 4 * g + r > tq[cg])) e = 0.f;
                    pr[kt][r] = e; l[cg] += e;
                }
            }
            const bf16x8 pb = pack8(pr[0][0], pr[0][1], pr[0][2], pr[0][3], pr[1][0], pr[1][1], pr[1][2], pr[1][3]);
#pragma unroll
            for (int dt = 0; dt < 4; ++dt) O[cg][dt] = mfma16(vf[dt], pb, O[cg][dt]);
        }
    }
    bfraw* yc = (bfraw*)(p.ws + O_YCAT);
#pragma unroll
    for (int cg = 0; cg < 2; ++cg) {
        const float inv = 1.f / grpx_sum(l[cg]);
        bfraw* d = yc + (size_t)(b * TT + tq[cg]) * 1024 + h * 64 + 4 * g;
#pragma unroll
        for (int dt = 0; dt < 4; ++dt) st4bf(d + dt * 16, O[cg][dt][0] * inv, O[cg][dt][1] * inv, O[cg][dt][2] * inv, O[cg][dt][3] * inv);
    }
}

constexpr int GA_XR = 0, GA_LM = 17408, GA_KB = 36864, GA_KDT = 54272, GA_ATT = 72704, GA_SM = 81920, GA_RHS = 83968, GA_RAW = 117760;
DEV float gdn_conv_at(const bfraw* G0, const float* cw, int b, int t, int col, float& x3, float& x2, float& x1) {
    const float x = bf2f(G0[(size_t)(b * TT + t) * 1536 + col]);
    const float y = cw[0 * 1536 + col] * x3 + cw[1 * 1536 + col] * x2 + cw[2 * 1536 + col] * x1 + cw[3 * 1536 + col] * x;
    x3 = x2; x2 = x1; x1 = x;
    return siluf_(y);
}
DEV int opaque_tid() { return tidx(); }
#define OPQ_TID() const int tid = opaque_tid(), lane = tid & 63, w = tid >> 6, c = lane & 15, g = lane >> 4; (void)lane; (void)w; (void)c; (void)g
DEV void gdn_a_item(const Params& p, char* smem, int item) {
    const int bh = item >> 8, n = item & 255, b = bh >> 2, h = bh & 3, t0 = n * 64;
    const bfraw* G0 = (const bfraw*)(p.ws + O_G0);
    const float* cw = p.in[I_GCONV];
    bfraw* qbuf = (bfraw*)(smem + GA_XR);
    float* Lm = (float*)(smem + GA_LM);
    bfraw* XT = (bfraw*)(smem + GA_XR);
    bfraw* kbuf = (bfraw*)(smem + GA_KB);
    bfraw* kdT = (bfraw*)(smem + GA_KDT);
    bfraw* att = (bfraw*)(smem + GA_ATT);
    float* gc = (float*)(smem + GA_SM);
    bfraw* rhs = (bfraw*)(smem + GA_RHS);
    float* beta = gc + 64; float* eg = gc + 128; float* ed = gc + 192;
    __syncthreads();
    bfraw* raw = (bfraw*)(smem + GA_RAW);
    for (int m = 0; m < 2; ++m) {
        {
            OPQ_TID();
            for (int ch = tid; ch < 67 * 16; ch += NTHR) {
                const int rr = ch >> 4, cc = (ch & 15) * 8, tt = t0 - 3 + rr;
                uint4 v = make_uint4(0u, 0u, 0u, 0u);
                if (tt >= 0) v = *(const uint4*)(G0 + (size_t)(b * TT + tt) * 1536 + m * 512 + h * 128 + cc);
                *(uint4*)&raw[rr * 128 + cc] = v;
            }
        }
        __syncthreads();
        {
            OPQ_TID();
            const int d = tid & 127, qt = tid >> 7, col = m * 512 + h * 128 + d, i0 = qt * 16;
            bfraw* dstb = m ? kbuf : qbuf;
            const float w0 = cw[col], w1 = cw[1536 + col], w2 = cw[2 * 1536 + col], w3 = cw[3 * 1536 + col];
            float x3 = bf2f(raw[(i0) * 128 + d]), x2 = bf2f(raw[(i0 + 1) * 128 + d]), x1 = bf2f(raw[(i0 + 2) * 128 + d]);
#pragma unroll 4
            for (int i = i0; i < i0 + 16; ++i) {
                const float x = bf2f(raw[(i + 3) * 128 + d]);
                dstb[i * 136 + d] = f2bf(siluf_(w0 * x3 + w1 * x2 + w2 * x1 + w3 * x));
                x3 = x2; x2 = x1; x1 = x;
            }
        }
        __syncthreads();
    }
    { OPQ_TID();
    if (w == 0) {
        const float* sm = (const float*)(p.ws + O_SM0) + (size_t)(b * TT + t0 + lane) * 16;
        const float gv = -__expf(p.in[I_GALOG][h]) * softplusf_(sm[8 + h] + p.in[I_GDTB][h]);
        float incl = gv;
        for (int m = 1; m < 64; m <<= 1) { const float o = __shfl_up(incl, m); if (lane >= m) incl += o; }
        const float gl = __shfl(incl, 63);
        gc[lane] = incl; beta[lane] = sigmoidf_(sm[12 + h]); eg[lane] = __expf(incl); ed[lane] = __expf(gl - incl);
        if (lane == 0) gc[256] = __expf(gl);
    } }
    __syncthreads();
    { OPQ_TID();
#pragma unroll 1
    for (int rr = 0; rr < 8; ++rr) {
        const int i = w * 8 + rr;
        uint32_t* qp = (uint32_t*)&qbuf[i * 136 + lane * 2];
        uint32_t* kp = (uint32_t*)&kbuf[i * 136 + lane * 2];
        const uint32_t qv = *qp, kv = *kp;
        const float q0 = lo2f(qv), q1 = hi2f(qv), k0 = lo2f(kv), k1 = hi2f(kv);
        const float qs = wave_sum(q0 * q0 + q1 * q1), ks = wave_sum(k0 * k0 + k1 * k1);
        const float qi = rsqrtf(qs + EPSF) * 0.08838834764831845f, ki = rsqrtf(ks + EPSF);
        *qp = pack2(q0 * qi, q1 * qi);
        *kp = pack2(k0 * ki, k1 * ki);
        const float e = ed[i];
        kdT[(lane * 2) * 72 + i] = f2bf(k0 * ki * e);
        kdT[(lane * 2 + 1) * 72 + i] = f2bf(k1 * ki * e);
    } }
    __syncthreads();
    {
        OPQ_TID();
        const int mat = w >> 2, ti = w & 3;
        const bfraw* Ab = mat ? qbuf : kbuf;
        f32x4 acc[4];
#pragma unroll
        for (int j = 0; j < 4; ++j) acc[j] = f32x4{0.f, 0.f, 0.f, 0.f};
#pragma unroll
        for (int ks = 0; ks < 4; ++ks) {
            const bf16x8 a = ld8(&Ab[(ti * 16 + c) * 136 + ks * 32 + g * 8]);
#pragma unroll
            for (int j = 0; j < 4; ++j) acc[j] = mfma16(a, ld8(&kbuf[(j * 16 + c) * 136 + ks * 32 + g * 8]), acc[j]);
        }
#pragma unroll
        for (int j = 0; j < 4; ++j)
#pragma unroll
            for (int r = 0; r < 4; ++r) {
                const int i = ti * 16 + 4 * g + r, jj = j * 16 + c;
                const float dec = __expf(gc[i] - gc[jj]);
                if (mat == 0) Lm[i * 64 + jj] = (i > jj) ? beta[i] * acc[j][r] * dec : 0.f;
                else att[i * 72 + jj] = f2bf((i >= jj) ? acc[j][r] * dec : 0.f);
            }
        const int i = tid >> 3, d0 = (tid & 7) * 16;
        const float e = eg[i];
        bfraw* qe = (bfraw*)(p.ws + O_QEFF) + ((size_t)item * 64 + i) * 128 + d0;
        U4 oa, ob;
#pragma unroll
        for (int q = 0; q < 4; ++q) {
            const uint32_t v = *(const uint32_t*)&qbuf[i * 136 + d0 + 2 * q]; oa.w[q] = pack2(lo2f(v) * e, hi2f(v) * e);
            const uint32_t v2 = *(const uint32_t*)&qbuf[i * 136 + d0 + 8 + 2 * q]; ob.w[q] = pack2(lo2f(v2) * e, hi2f(v2) * e);
        }
        *(uint4*)qe = oa.u; *(uint4*)(qe + 8) = ob.u;
    }
    lds_barrier();
    {
        OPQ_TID();
        for (int ch = tid; ch < 67 * 16; ch += NTHR) {
            const int rr = ch >> 4, cc = (ch & 15) * 8, tt = t0 - 3 + rr;
            uint4 v = make_uint4(0u, 0u, 0u, 0u);
            if (tt >= 0) v = *(const uint4*)(G0 + (size_t)(b * TT + tt) * 1536 + 1024 + h * 128 + cc);
            *(uint4*)&raw[rr * 128 + cc] = v;
        }
    }
    __syncthreads();
    {
        OPQ_TID();
        const int d = tid & 127, qt = tid >> 7, col = 1024 + h * 128 + d, i0 = qt * 16;
        const float w0 = cw[col], w1 = cw[1536 + col], w2 = cw[2 * 1536 + col], w3 = cw[3 * 1536 + col];
        float x3 = bf2f(raw[(i0) * 128 + d]), x2 = bf2f(raw[(i0 + 1) * 128 + d]), x1 = bf2f(raw[(i0 + 2) * 128 + d]);
#pragma unroll 4
        for (int i = i0; i < i0 + 16; ++i) {
            const float x = bf2f(raw[(i + 3) * 128 + d]);
            rhs[i * 264 + d] = f2bf(siluf_(w0 * x3 + w1 * x2 + w2 * x1 + w3 * x) * beta[i]);
            rhs[i * 264 + 128 + d] = f2bf(bf2f(kbuf[i * 136 + d]) * beta[i] * eg[i]);
            x3 = x2; x2 = x1; x1 = x;
        }
    }
    __syncthreads();
    float x[64];
    const int tid = opaque_tid();
    if (tid < 256) {
#pragma unroll
        for (int i = 0; i < 64; ++i) {
            float s = bf2f(rhs[i * 264 + tid]), s2 = 0.f;
            const float4* Lr = (const float4*)&Lm[i * 64];
#pragma unroll
            for (int j4 = 0; j4 < (i + 3) / 4; ++j4) {
                const float4 lv = Lr[j4];
                s -= lv.x * x[j4 * 4];
                if (j4 * 4 + 1 < i) s2 -= lv.y * x[j4 * 4 + 1];
                if (j4 * 4 + 2 < i) s -= lv.z * x[j4 * 4 + 2];
                if (j4 * 4 + 3 < i) s2 -= lv.w * x[j4 * 4 + 3];
            }
            s += s2;
            asm volatile("" : "+v"(s) :: "memory");
            x[i] = s;
        }
    }
    __syncthreads();
    if (tid < 256) {
#pragma unroll
        for (int q = 0; q < 8; ++q) {
            uint4 o; o.x = pack2(x[q * 8 + 0], x[q * 8 + 1]); o.y = pack2(x[q * 8 + 2], x[q * 8 + 3]); o.z = pack2(x[q * 8 + 4], x[q * 8 + 5]); o.w = pack2(x[q * 8 + 6], x[q * 8 + 7]);
            *(uint4*)&XT[tid * 72 + q * 8] = o;
        }
    }
    block_sync_mem();
    {
        OPQ_TID();
        f32x4 a3[4], a4[4];
#pragma unroll
        for (int it = 0; it < 4; ++it) { a3[it] = f32x4{0.f, 0.f, 0.f, 0.f}; a4[it] = f32x4{0.f, 0.f, 0.f, 0.f}; }
#pragma unroll
        for (int ks = 0; ks < 2; ++ks) {
            const bf16x8 aw = ld8(&XT[(128 + w * 16 + c) * 72 + ks * 32 + g * 8]);
            const bf16x8 au = ld8(&XT[(w * 16 + c) * 72 + ks * 32 + g * 8]);
#pragma unroll
            for (int it = 0; it < 4; ++it) {
                const bf16x8 bt = ld8(&att[(it * 16 + c) * 72 + ks * 32 + g * 8]);
                a3[it] = mfma16(aw, bt, a3[it]); a4[it] = mfma16(au, bt, a4[it]);
            }
        }
        bfraw* qe = (bfraw*)(p.ws + O_QEFF) + (size_t)item * 64 * 128;
        bfraw* yc = (bfraw*)(p.ws + O_YCAT);
#pragma unroll
        for (int it = 0; it < 4; ++it) {
            const int i = it * 16 + c, d = w * 16 + 4 * g;
            bfraw* qp = qe + (size_t)i * 128 + d;
            const uint2 qv = *(const uint2*)qp;
            st4bf(qp, lo2f(qv.x) - a3[it][0], hi2f(qv.x) - a3[it][1], lo2f(qv.y) - a3[it][2], hi2f(qv.y) - a3[it][3]);
            st4bf(yc + (size_t)(b * TT + t0 + i) * 1024 + 512 + h * 128 + d, a4[it][0], a4[it][1], a4[it][2], a4[it][3]);
        }
    }
    {
        OPQ_TID();
        const float egl = gc[256];
        bfraw* Mb = (bfraw*)(p.ws + O_MBUF) + (size_t)item * 16384;
        bfraw* Nb = (bfraw*)(p.ws + O_NS) + (size_t)item * 16384;
#pragma unroll 1
        for (int half = 0; half < 2; ++half) {
            f32x4 a5[4], a6[4];
#pragma unroll
            for (int q = 0; q < 4; ++q) { a5[q] = f32x4{0.f, 0.f, 0.f, 0.f}; a6[q] = f32x4{0.f, 0.f, 0.f, 0.f}; }
#pragma unroll
            for (int ks = 0; ks < 2; ++ks) {
                const bf16x8 aw = ld8(&XT[(128 + w * 16 + c) * 72 + ks * 32 + g * 8]);
                const bf16x8 ak = ld8(&kdT[(w * 16 + c) * 72 + ks * 32 + g * 8]);
#pragma unroll
                for (int q = 0; q < 4; ++q) {
                    const int tl = half * 4 + q;
                    a5[q] = mfma16(aw, ld8(&kdT[(tl * 16 + c) * 72 + ks * 32 + g * 8]), a5[q]);
                    a6[q] = mfma16(ak, ld8(&XT[(tl * 16 + c) * 72 + ks * 32 + g * 8]), a6[q]);
                }
            }
#pragma unroll
            for (int q = 0; q < 4; ++q) {
                const int tl = half * 4 + q;
                const int d = tl * 16 + c, dp = w * 16 + 4 * g;
                st4bf(Mb + (size_t)d * 128 + dp, (d == dp ? egl : 0.f) - a5[q][0], (d == dp + 1 ? egl : 0.f) - a5[q][1],
                      (d == dp + 2 ? egl : 0.f) - a5[q][2], (d == dp + 3 ? egl : 0.f) - a5[q][3]);
                const int e = tl * 16 + c, dd = w * 16 + 4 * g;
                st4bf(Nb + (size_t)e * 128 + dd, a6[q][0], a6[q][1], a6[q][2], a6[q][3]);
            }
        }
    }
    lds_barrier();
}

DEV void gdn_scan_item(const Params& p, int bh) {
    const int lane = tidx() & 63, w = tidx() >> 6, c = lane & 15, g = lane >> 4;
    const int e = w * 16 + c;
    f32x4 S[8];
#pragma unroll
    for (int dt = 0; dt < 8; ++dt) S[dt] = f32x4{0.f, 0.f, 0.f, 0.f};
    const bfraw* MB = (const bfraw*)(p.ws + O_MBUF) + (size_t)bh * 256 * 16384;
    bfraw* NB = (bfraw*)(p.ws + O_NS) + (size_t)bh * 256 * 16384;
    for (int n = 0; n < 256; ++n) {
        const bfraw* M = MB + (size_t)n * 16384;
        bfraw* N = NB + (size_t)n * 16384 + (size_t)e * 128 + 4 * g;
        bf16x8 bs[4];
#pragma unroll
        for (int s = 0; s < 4; ++s) bs[s] = pack8(S[2 * s][0], S[2 * s][1], S[2 * s][2], S[2 * s][3], S[2 * s + 1][0], S[2 * s + 1][1], S[2 * s + 1][2], S[2 * s + 1][3]);
        uint2 nf[8];
#pragma unroll
        for (int dt = 0; dt < 8; ++dt) nf[dt] = *(const uint2*)(N + dt * 16);
        asm volatile("s_waitcnt vmcnt(0)" ::: "memory");
#pragma unroll
        for (int dt = 0; dt < 8; ++dt) st4bf(N + dt * 16, S[dt][0], S[dt][1], S[dt][2], S[dt][3]);
#pragma unroll
        for (int dt = 0; dt < 8; ++dt) {
            f32x4 acc = f32x4{lo2f(nf[dt].x), hi2f(nf[dt].x), lo2f(nf[dt].y), hi2f(nf[dt].y)};
#pragma unroll
            for (int s = 0; s < 4; ++s) {
                const bfraw* mp = M + (size_t)(dt * 16 + c) * 128 + 32 * s + 4 * g;
                acc = mfma16(ld4x2(mp, mp + 16), bs[s], acc);
            }
            S[dt] = acc;
        }
    }
}

DEV void gdn_c_witem(const Params& p, int witem, bool dry = false) {
    const int lane = tidx() & 63, c = lane & 15, g = lane >> 4;
    const int item = witem >> 2, it = witem & 3;
    const int bh = item >> 8, n = item & 255, b = bh >> 2, h = bh & 3;
    const bfraw* Sb = (const bfraw*)(p.ws + O_SB) + (size_t)item * 16384;
    const bfraw* Qe = (const bfraw*)(p.ws + O_QEFF) + (size_t)item * 64 * 128;
    f32x4 acc[8];
#pragma unroll
    for (int et = 0; et < 8; ++et) acc[et] = f32x4{0.f, 0.f, 0.f, 0.f};
#pragma unroll
    for (int ks = 0; ks < 4; ++ks) {
        const bf16x8 bq = ld8(Qe + (size_t)(it * 16 + c) * 128 + ks * 32 + g * 8);
#pragma unroll
        for (int et = 0; et < 8; ++et) acc[et] = mfma16(ld8(Sb + (size_t)(et * 16 + c) * 128 + ks * 32 + g * 8), bq, acc[et]);
    }
    const int tok = b * TT + n * 64 + it * 16 + c;
    bfraw* yp = (bfraw*)(p.ws + O_YCAT) + (size_t)tok * 1024 + 512 + h * 128 + 4 * g;
    const bfraw* gz = (const bfraw*)(p.ws + O_GZ) + (size_t)tok * 512 + h * 128 + 4 * g;
    float ss = 0.f;
#pragma unroll
    for (int et = 0; et < 8; ++et) {
        const uint2 o0 = *(const uint2*)(yp + et * 16);
        acc[et][0] += lo2f(o0.x); acc[et][1] += hi2f(o0.x); acc[et][2] += lo2f(o0.y); acc[et][3] += hi2f(o0.y);
        ss += acc[et][0] * acc[et][0] + acc[et][1] * acc[et][1] + acc[et][2] * acc[et][2] + acc[et][3] * acc[et][3];
    }
    ss = grpx_sum(ss);
    const float rs = rsqrtf(ss * (1.f / 128.f) + EPSF);
#pragma unroll
    for (int et = 0; et < 8; ++et) {
        const uint2 zv = *(const uint2*)(gz + et * 16);
        const float4 gn = *(const float4*)(p.in[I_GON] + et * 16 + 4 * g);
        st4bf((dry ? (bfraw*)(p.ws + O_MBUF) + (size_t)tok * 1024 + 4 * g : yp) + et * 16, acc[et][0] * rs * gn.x * siluf_(lo2f(zv.x)), acc[et][1] * rs * gn.y * siluf_(hi2f(zv.x)),
                            acc[et][2] * rs * gn.z * siluf_(lo2f(zv.y)), acc[et][3] * rs * gn.w * siluf_(hi2f(zv.y)));
    }
}
constexpr int TS_K = 0, TS_V = 18432, TS_C = 36864;
template <bool WITHV, bool WITHC, class KEYOF, class BODY>
DEV void tile_stream(char* smem, const bfraw* Kg, const bfraw* Vg, size_t vstride, const float* Cg, int ntiles, KEYOF key_of, BODY body) {
    const int tid = tidx(), srow = tid >> 3, sseg = tid & 7;
    bfraw* Kl = (bfraw*)(smem + TS_K); bfraw* Vl = (bfraw*)(smem + TS_V); float* Cl = (float*)(smem + TS_C);
    if (ntiles <= 0) return;
    uint4 ka, va = make_uint4(0u, 0u, 0u, 0u), kb = make_uint4(0u, 0u, 0u, 0u), vb = make_uint4(0u, 0u, 0u, 0u);
    float4 ca = make_float4(0.f, 0.f, 0.f, 0.f), cb = make_float4(0.f, 0.f, 0.f, 0.f);
    auto ldt = [&](int t, uint4& rk, uint4& rv, float4& rc) {
        const int k0 = key_of(t);
        rk = *(const uint4*)(Kg + (size_t)(k0 + srow) * 64 + sseg * 8);
        if (WITHV) rv = *(const uint4*)(Vg + (size_t)srow * vstride + k0 + sseg * 8);
        if (WITHC) { if (tid < 16) rc = *(const float4*)(Cg + k0 + 4 * tid); }
    };
    auto stt = [&](int buf, const uint4& rk, const uint4& rv, const float4& rc) {
        *(uint4*)&Kl[buf * 64 * 72 + srow * 72 + sseg * 8] = rk;
        if (WITHV) *(uint4*)&Vl[buf * 64 * 72 + srow * 72 + sseg * 8] = rv;
        if (WITHC) { if (tid < 16) *(float4*)&Cl[buf * 64 + 4 * tid] = rc; }
    };
    __syncthreads();
    ldt(0, ka, va, ca);
    if (ntiles > 1) ldt(1, kb, vb, cb);
    stt(0, ka, va, ca);
    lds_barrier();
    for (int t = 0; t < ntiles; t += 2) {
        if (t + 2 < ntiles) ldt(t + 2, ka, va, ca);
        body(t, Kl, Vl, Cl);
        if (t + 1 < ntiles) stt(1, kb, vb, cb);
        lds_barrier();
        if (t + 1 >= ntiles) break;
        if (t + 3 < ntiles) ldt(t + 3, kb, vb, cb);
        body(t + 1, Kl + 64 * 72, Vl + 64 * 72, Cl + 64);
        if (t + 2 < ntiles) stt(0, ka, va, ca);
        lds_barrier();
    }
}

constexpr int TS2_K = 0, TS2_V = 36864, TS2_END = 71680;
template <class KEYOF, class KEYOF2, class BODY>
DEV void tile_stream2(char* smem, const bfraw* Kg, const bfraw* Vg, size_t vstride, int ntiles, KEYOF key_of, KEYOF2 key_of2, BODY body) {
    const int tid = tidx(), srow = tid >> 3, sseg = tid & 7;
    bfraw* Kl = (bfraw*)(smem + TS2_K); bfraw* Vl = (bfraw*)(smem + TS2_V);
    if (ntiles <= 0) return;
    uint4 ka0, ka1, va0, va1, kb0 = make_uint4(0u, 0u, 0u, 0u), kb1 = kb0, vb0 = kb0, vb1 = kb0;
#define TS2_LD(T, K0, K1, V0, V1) { const int a0 = key_of(T), a1 = key_of2(T); K0 = *(const uint4*)(Kg + (size_t)(a0 + srow) * 64 + sseg * 8); K1 = *(const uint4*)(Kg + (size_t)(a1 + srow) * 64 + sseg * 8); \
        V0 = *(const uint4*)(Vg + (size_t)srow * vstride + a0 + sseg * 8); V1 = *(const uint4*)(Vg + (size_t)srow * vstride + a1 + sseg * 8); }
#define TS2_ST(BUF, K0, K1, V0, V1) { bfraw* kp = Kl + (BUF) * 128 * 72 + srow * 72 + sseg * 8; *(uint4*)kp = K0; *(uint4*)(kp + 64 * 72) = K1; \
        bfraw* vp = Vl + (BUF) * 64 * 136 + srow * 136 + sseg * 8; *(uint4*)vp = V0; *(uint4*)(vp + 64) = V1; }
    __syncthreads();
    TS2_LD(0, ka0, ka1, va0, va1)
    if (ntiles > 1) TS2_LD(1, kb0, kb1, vb0, vb1)
    TS2_ST(0, ka0, ka1, va0, va1)
    lds_barrier();
    for (int t = 0; t < ntiles; t += 2) {
        if (t + 2 < ntiles) TS2_LD(t + 2, ka0, ka1, va0, va1)
        body(t, Kl, Vl);
        if (t + 1 < ntiles) TS2_ST(1, kb0, kb1, vb0, vb1)
        lds_barrier();
        if (t + 1 >= ntiles) break;
        if (t + 3 < ntiles) TS2_LD(t + 3, kb0, kb1, vb0, vb1)
        body(t + 1, Kl + 128 * 72, Vl + 64 * 136);
        if (t + 2 < ntiles) TS2_ST(0, ka0, ka1, va0, va1)
        lds_barrier();
    }
#undef TS2_LD
#undef TS2_ST
}

DEV void fox_item2(const Params& p, char* smem, int bh, int qb) {
    const int tid = tidx(), lane = tid & 63, w = tid >> 6, c = lane & 15, g = lane >> 4;
    const int b = bh >> 3, h = bh & 7;
    const bfraw* Q = (const bfraw*)(p.ws + O_QF) + (size_t)bh * TT * 64;
    const bfraw* K = (const bfraw*)(p.ws + O_KF) + (size_t)bh * TT * 64;
    const bfraw* VT = (const bfraw*)(p.ws + O_VFT) + (size_t)bh * 64 * TT;
    const float* cum = (const float*)(p.ws + O_CUMF) + (size_t)bh * TT;
    const float mq = wave_max(fabsf(p.in[I_FOXQN][lane])), mk = wave_max(fabsf(p.in[I_FOXKN][lane]));
    const float Mb2 = 8.f * mq * mk * LOG2E;
    const float thr = -(105.f + 16.f * mq * mk) * LOG2E;
    const int Q0 = qb * 256, q0w = Q0 + w * 32, jw = q0w >> 6, jmax = (Q0 >> 6) + 3;
    int* red = (int*)(smem + TS_C + 1024);
    __syncthreads();
    if (tid == 0) red[0] = 0;
    __syncthreads();
    {
        const float cq0 = cum[Q0];
        bool dead = false;
        if (tid <= jmax && tid < 256) dead = (cq0 - cum[64 * tid + 63] < thr);
        const unsigned long long bm = __ballot(dead);
        if (lane == 0 && bm) atomicMax(red, w * 64 + 64 - __builtin_clzll(bm));
    }
    __syncthreads();
    const int jmin = red[0];
    int tq[2]; float cq[2]; bf16x8 qf[2][2]; f32x4 O[2][4]; float l[2];
#pragma unroll
    for (int cg = 0; cg < 2; ++cg) {
        tq[cg] = q0w + cg * 16 + c; cq[cg] = cum[tq[cg]] - Mb2; l[cg] = 0.f;
#pragma unroll
        for (int ks = 0; ks < 2; ++ks) qf[cg][ks] = ld8(Q + (size_t)tq[cg] * 64 + ks * 32 + g * 8);
#pragma unroll
        for (int dt = 0; dt < 4; ++dt) O[cg][dt] = f32x4{0.f, 0.f, 0.f, 0.f};
    }
    tile_stream<true, true>(smem, K, VT, TT, cum, jmax - jmin + 1, [&](int t) { return (jmax - t) * 64; },
        [&](int t, const bfraw* Kb, const bfraw* Vb, const float* Cb) {
            const int j = jmax - t;
            if (j > jw) return;
            const bool diag = (j == jw);
            bf16x8 pb[2][2];
#pragma unroll
            for (int kt = 0; kt < 4; ++kt) {
                const bf16x8 k0 = ld8(&Kb[(kt * 16 + c) * 72 + g * 8]), k1 = ld8(&Kb[(kt * 16 + c) * 72 + 32 + g * 8]);
                const float4 ck = *(const float4*)&Cb[kt * 16 + 4 * g];
#pragma unroll
                for (int cg = 0; cg < 2; ++cg) {
                    f32x4 S = f32x4{cq[cg] - ck.x, cq[cg] - ck.y, cq[cg] - ck.z, cq[cg] - ck.w};
                    S = mfma16(k0, qf[cg][0], S);
                    S = mfma16(k1, qf[cg][1], S);
                    float e[4];
#pragma unroll
                    for (int r = 0; r < 4; ++r) {
                        e[r] = ex2(S[r]);
                        if (diag && (64 * j + kt * 16 + 4 * g + r > tq[cg])) e[r] = 0.f;
                        l[cg] += e[r];
                    }
                    U4 tt;
                    if (kt & 1) { tt.v = pb[cg][kt >> 1]; tt.w[2] = pack2(e[0], e[1]); tt.w[3] = pack2(e[2], e[3]); }
                    else { tt.w[0] = pack2(e[0], e[1]); tt.w[1] = pack2(e[2], e[3]); tt.w[2] = 0u; tt.w[3] = 0u; }
                    pb[cg][kt >> 1] = tt.v;
                }
            }
#pragma unroll
            for (int dt = 0; dt < 4; ++dt) {
                const bfraw* vp = &Vb[(dt * 16 + c) * 72 + 4 * g];
                const bf16x8 v0 = ld4x2(vp, vp + 16), v1 = ld4x2(vp + 32, vp + 48);
#pragma unroll
                for (int cg = 0; cg < 2; ++cg) { O[cg][dt] = mfma16(v0, pb[cg][0], O[cg][dt]); O[cg][dt] = mfma16(v1, pb[cg][1], O[cg][dt]); }
            }
        });
    bfraw* yc = (bfraw*)(p.ws + O_YCAT);
#pragma unroll
    for (int cg = 0; cg < 2; ++cg) {
        const float inv = 1.f / grpx_sum(l[cg]);
        bfraw* d = yc + (size_t)(b * TT + tq[cg]) * 1024 + h * 64 + 4 * g;
#pragma unroll
        for (int dt = 0; dt < 4; ++dt) st4bf(d + dt * 16, O[cg][dt][0] * inv, O[cg][dt][1] * inv, O[cg][dt][2] * inv, O[cg][dt][3] * inv);
    }
    __syncthreads();
}

constexpr int GS_STAGE = 34816 + 4352;
DEV void gdn_scan_item2(const Params& p, char* smem, int item) {
    const int tid = tidx(), lane = tid & 63, w = tid >> 6, c = lane & 15, g = lane >> 4;
    const int bh = item & 7, e0 = (item >> 3) * 16;
    const bfraw* MB = (const bfraw*)(p.ws + O_MBUF) + (size_t)bh * 256 * 16384;
    const bfraw* NB = (const bfraw*)(p.ws + O_NS) + (size_t)bh * 256 * 16384 + (size_t)e0 * 128;
    bfraw* SB = (bfraw*)(p.ws + O_SB) + (size_t)bh * 256 * 16384 + (size_t)e0 * 128;
    __syncthreads();
    if (w >= 4) {
        const int lt = tid - 256, lrow = lt >> 4, lcol = (lt & 15) * 8;
#define GS_LDR(N, R) { const bfraw* Mn = MB + (size_t)(N) * 16384 + (size_t)lrow * 128 + lcol; \
            R##m0 = *(const uint4*)(Mn + 0 * 128); R##m1 = *(const uint4*)(Mn + 16 * 128); R##m2 = *(const uint4*)(Mn + 32 * 128); R##m3 = *(const uint4*)(Mn + 48 * 128); R##m4 = *(const uint4*)(Mn + 64 * 128); R##m5 = *(const uint4*)(Mn + 80 * 128); R##m6 = *(const uint4*)(Mn + 96 * 128); R##m7 = *(const uint4*)(Mn + 112 * 128); \
            R##n = *(const uint4*)(NB + (size_t)(N) * 16384 + (size_t)lrow * 128 + lcol); }
#define GS_STR(STAGE, R) { bfraw* Mw = (bfraw*)(smem + (STAGE) * GS_STAGE) + lrow * 136 + lcol; \
            *(uint4*)(Mw + 0 * 136) = R##m0; *(uint4*)(Mw + 16 * 136) = R##m1; *(uint4*)(Mw + 32 * 136) = R##m2; *(uint4*)(Mw + 48 * 136) = R##m3; *(uint4*)(Mw + 64 * 136) = R##m4; *(uint4*)(Mw + 80 * 136) = R##m5; *(uint4*)(Mw + 96 * 136) = R##m6; *(uint4*)(Mw + 112 * 136) = R##m7; \
            *(uint4*)(Mw + 128 * 136) = R##n; }
        uint4 ram0, ram1, ram2, ram3, ram4, ram5, ram6, ram7, rbm0, rbm1, rbm2, rbm3, rbm4, rbm5, rbm6, rbm7, rcm0, rcm1, rcm2, rcm3, rcm4, rcm5, rcm6, rcm7, ran, rbn, rcn;
        GS_LDR(0, ra) GS_LDR(1, rb) GS_LDR(2, rc)
        GS_STR(0, ra)
        lds_barrier();
#define GS_IT(N, RCUR, RNEXT, STG) { const int n_ = (N); if (n_ < 256) { if (n_ + 3 < 256) GS_LDR(n_ + 3, RCUR) if (n_ + 1 < 256) GS_STR((STG) ^ 1, RNEXT) lds_barrier(); } }
        for (int n = 0; n < 256; n += 6) {
            GS_IT(n + 0, ra, rb, 0) GS_IT(n + 1, rb, rc, 1) GS_IT(n + 2, rc, ra, 0)
            GS_IT(n + 3, ra, rb, 1) GS_IT(n + 4, rb, rc, 0) GS_IT(n + 5, rc, ra, 1)
        }
#undef GS_IT
#undef GS_LDR
#undef GS_STR
    } else if (w == 0) {
        f32x4 S[8];
#pragma unroll
        for (int dt = 0; dt < 8; ++dt) S[dt] = f32x4{0.f, 0.f, 0.f, 0.f};
        lds_barrier();
        for (int n = 0; n < 256; ++n) {
            const bfraw* Mb = (const bfraw*)(smem + (n & 1) * GS_STAGE);
            const bfraw* Nl = Mb + 128 * 136;
            bfraw* Sn = SB + (size_t)n * 16384 + (size_t)c * 128 + 4 * g;
            bf16x8 bs[4];
#pragma unroll
            for (int s = 0; s < 4; ++s)
                bs[s] = pack8(S[2 * s][0], S[2 * s][1], S[2 * s][2], S[2 * s][3], S[2 * s + 1][0], S[2 * s + 1][1], S[2 * s + 1][2], S[2 * s + 1][3]);
#pragma unroll
            for (int dt = 0; dt < 8; ++dt) st4bf(Sn + dt * 16, S[dt][0], S[dt][1], S[dt][2], S[dt][3]);
#pragma unroll
            for (int dt = 0; dt < 8; ++dt) {
                const uint2 n0 = *(const uint2*)&Nl[c * 136 + dt * 16 + 4 * g];
                f32x4 a0 = f32x4{lo2f(n0.x), hi2f(n0.x), lo2f(n0.y), hi2f(n0.y)};
#pragma unroll
                for (int s = 0; s < 4; ++s) {
                    const bfraw* mp = &Mb[(dt * 16 + c) * 136 + 32 * s + 4 * g];
                    a0 = mfma16(ld4x2(mp, mp + 16), bs[s], a0);
                }
                S[dt] = a0;
            }
            lds_barrier();
        }
    } else {
        lds_barrier();
        for (int n = 0; n < 256; ++n) lds_barrier();
    }
}
DEV void phase_outproj(const Params& p, char* smem, int layer, unsigned* xq) {
    const bfraw* A = (const bfraw*)(p.ws + O_YCAT);
    const bfraw* Bt = (const bfraw*)(p.ws + (layer ? O_WOUT1 : O_WOUT0));
    const float* xin = layer ? p.out : p.in[I_X];
    for (int rr = 0;; ++rr) {
        int mt, nt;
        if (!xs_tile(4, rr, mt, nt)) break;
        const int m0 = mt * 256, n0 = nt * 256;
        gemm_tile2(smem, 16, 64,
            [&](int r) { return A + (size_t)(m0 + r) * 1024; },
            [&](int r) { return Bt + (size_t)(n0 + r) * 1024; },
            [&](const f32x4 (&acc)[8][4], int rb, int cbk, int lane) {
                const int c = lane & 15, g = lane >> 4, tok0 = m0 + rb, b = tok0 >> 14;
                const float* g1 = modp(p, layer, b, 2) + n0 + cbk + 4 * g;
#pragma unroll
                for (int j = 0; j < 4; ++j) {
                    const float4 gv = *(const float4*)(g1 + j * 16);
#pragma unroll
                    for (int i = 0; i < 8; ++i) {
                        const size_t o = (size_t)(tok0 + i * 16 + c) * 1024 + n0 + cbk + j * 16 + 4 * g;
                        const float4 xv = *(const float4*)(xin + o);
                        *(float4*)(p.out + o) = make_float4(xv.x + gv.x * acc[i][j][0], xv.y + gv.y * acc[i][j][1], xv.z + gv.z * acc[i][j][2], xv.w + gv.w * acc[i][j][3]);
                    }
                }
            });
    }
}

constexpr int RT_LG = 55296;
DEV void phase_router(const Params& p, char* smem, int layer, bool dry = false) {
    const int tid = tidx(), lane = tid & 63, w = tid >> 6;
    bfraw* hb = (bfraw*)(p.ws + O_HBUF);
    const bfraw* Wr = (const bfraw*)(p.ws + O_WRT) + (size_t)layer * 128 * 1024;
    float* lg = (float*)(smem + RT_LG);
    unsigned* cnts = (unsigned*)(p.ws + O_CNT) + 16 + layer * 128;
    float* pairw = (float*)(p.ws + O_PAIRW);
    int* plist = (int*)(p.ws + O_PLIST);
    for (int item = blockIdx.x; item < 256; item += gridDim.x) {
        const int m0 = item * 128, b = m0 >> 14;
        for (int rr = 0; rr < 16; ++rr) {
            const int row = m0 + w * 16 + rr;
            norm_row(p.out + (size_t)row * 1024, p.in[I_NFFN] + layer * 1024, modp(p, layer, b, 4), modp(p, layer, b, 3), hb + (size_t)row * 1024, lane);
        }
        block_sync_mem();
        gemm_tile(smem, 16, 64,
            [&](int r) { return hb + (size_t)(m0 + (r & 127)) * 1024; },
            [&](int r) { return Wr + (size_t)r * 1024; },
            [&](const f32x4 (&acc)[4][4], int rb, int cbk, int ln) {
                if (cbk == 0 && rb < 128) {
                    const int c = ln & 15, g = ln >> 4;
#pragma unroll
                    for (int i = 0; i < 4; ++i)
#pragma unroll
                        for (int j = 0; j < 4; ++j)
#pragma unroll
                            for (int r = 0; r < 4; ++r) lg[(rb + i * 16 + 4 * g + r) * 64 + j * 16 + c] = acc[i][j][r];
                }
            });
        __syncthreads();
        const float eb = p.in[I_MBIAS][layer * 64 + lane];
        const int grp = lane >> 3;
        for (int rr = 0; rr < 16; ++rr) {
            const int row = w * 16 + rr, tok = m0 + row;
            const float score = sigmoidf_(lg[row * 64 + lane]);
            const float biased = score + eb;
            float m1 = biased;
            m1 = fmaxf(m1, __shfl_xor(m1, 1)); m1 = fmaxf(m1, __shfl_xor(m1, 2)); m1 = fmaxf(m1, __shfl_xor(m1, 4));
            const unsigned long long eq = __ballot(biased == m1);
            const unsigned gm = (unsigned)(eq >> (grp * 8)) & 0xffu;
            const int first = __builtin_ctz(gm);
            float m2 = ((lane & 7) == first) ? -INFINITY : biased;
            m2 = fmaxf(m2, __shfl_xor(m2, 1)); m2 = fmaxf(m2, __shfl_xor(m2, 2)); m2 = fmaxf(m2, __shfl_xor(m2, 4));
            const float gs = m1 + m2;
            int grank = 0;
#pragma unroll
            for (int j = 0; j < 8; ++j) { const float gj = __shfl(gs, j * 8); grank += (gj > gs || (gj == gs && j < grp)) ? 1 : 0; }
            const bool gsel = grank < 4;
            const float v = gsel ? biased : -INFINITY;
            int er = 0;
#pragma unroll 8
            for (int j = 0; j < 64; ++j) { const float vj = __shfl(v, j); er += (vj > v || (vj == v && j < lane)) ? 1 : 0; }
            const bool sel = gsel && er < 6;
            const float ssum = wave_sum(sel ? score : 0.f);
            if (sel && !dry) {
                pairw[(size_t)tok * 6 + er] = score / ssum * 2.5f;
                const unsigned pos = atomicAdd(&cnts[b * 64 + lane], 1u);
                plist[(size_t)(b * 64 + lane) * 16384 + pos] = tok * 8 + er;
            }
        }
        __syncthreads();
    }
}

DEV void moe_tiles(const Params& p, char* smem, int layer, int hb, int* ts  ) {
    const unsigned* cnts = (const unsigned*)(p.ws + O_CNT) + 16 + layer * 128 + hb * 64;
    __syncthreads();
    if (tidx() == 0) {
        int a = 0;
        for (int e = 0; e < 64; ++e) { ts[e] = a; a += ((int)cnts[e] + 255) >> 8; }
        ts[64] = a; a += 64; ts[65] = a;
    }
    __syncthreads();
}
DEV int moe_find(const int* ts, int mt) { int e = 0; while (e < 64 && ts[e + 1] <= mt) ++e; return e; }
constexpr int MOE_TS = 147456;

DEV void phase_moe1(const Params& p, char* smem, int layer, int hb) {
    int* ts = (int*)(smem + MOE_TS);
    moe_tiles(p, smem, layer, hb, ts);
    const unsigned* cnts = (const unsigned*)(p.ws + O_CNT) + 16 + layer * 128 + hb * 64;
    const int* plist = (const int*)(p.ws + O_PLIST);
    const bfraw* hbuf = (const bfraw*)(p.ws + O_HBUF);
    const bfraw* wgu = (const bfraw*)(p.ws + O_WGU);
    bfraw* H = (bfraw*)(p.ws + O_H);
    const int total = ts[65];
    for (int item = blockIdx.x; item < total * 2; item += gridDim.x) {
        const int mt = item >> 1, nt = item & 1;
        const int e = moe_find(ts, mt), idx0 = (mt - ts[e]) * 256;
        const int cnt = e < 64 ? (int)cnts[e] : 16384;
        gemm_tile2<false>(smem, 16, 64,
            [&](int r) {
                const int idx = idx0 + r;
                int tok;
                if (e < 64) tok = idx < cnt ? (plist[(size_t)(hb * 64 + e) * 16384 + idx] >> 3) : 0;
                else tok = hb * 16384 + idx;
                return hbuf + (size_t)tok * 1024;
            },
            [&](int r) {
                const int hidden = nt * 128 + (r >> 6) * 32 + ((r >> 4) & 1) * 16 + (r & 15);
                return wgu + ((size_t)e * 512 + ((r >> 5) & 1) * 256 + hidden) * 1024;
            },
            [&](const f32x4 (&acc)[8][4], int rb, int cbk, int lane) {
                const int c = lane & 15, g = lane >> 4;
#pragma unroll
                for (int i = 0; i < 8; ++i) {
                    bfraw* hrow = H + (size_t)(mt * 256 + rb + i * 16 + c) * 256 + nt * 128 + (cbk >> 6) * 32 + 4 * g;
#pragma unroll
                    for (int jj = 0; jj < 2; ++jj)
                        st4bf(hrow + jj * 16, siluf_(acc[i][jj][0]) * acc[i][jj + 2][0], siluf_(acc[i][jj][1]) * acc[i][jj + 2][1],
                              siluf_(acc[i][jj][2]) * acc[i][jj + 2][2], siluf_(acc[i][jj][3]) * acc[i][jj + 2][3]);
                }
            });
    }
}

DEV void phase_moe2(const Params& p, char* smem, int layer, int hb) {
    int* ts = (int*)(smem + MOE_TS);
    moe_tiles(p, smem, layer, hb, ts);
    const unsigned* cnts = (const unsigned*)(p.ws + O_CNT) + 16 + layer * 128 + hb * 64;
    const int* plist = (const int*)(p.ws + O_PLIST);
    const float* pairw = (const float*)(p.ws + O_PAIRW);
    const bfraw* wd = (const bfraw*)(p.ws + O_WD);
    const bfraw* H = (const bfraw*)(p.ws + O_H);
    bfraw* Y = (bfraw*)(p.ws + O_Y);
    const int total = ts[65];
    for (int item = blockIdx.x; item < total * 4; item += gridDim.x) {
        const int mt = item >> 2, nt = item & 3;
        const int e = moe_find(ts, mt), idx0 = (mt - ts[e]) * 256;
        const int cnt = e < 64 ? (int)cnts[e] : 16384;
        gemm_tile2(smem, 4, 64,
            [&](int r) { return H + (size_t)(mt * 256 + r) * 256; },
            [&](int r) { return wd + ((size_t)e * 1024 + nt * 256 + r) * 256; },
            [&](const f32x4 (&acc)[8][4], int rb, int cbk, int lane) {
                const int c = lane & 15, g = lane >> 4;
                int yrow[8]; float wg[8];
                if (e < 64) {
                    const int* pl = plist + (size_t)(hb * 64 + e) * 16384;
                    int pr[8];
#pragma unroll
                    for (int i = 0; i < 8; ++i) pr[i] = pl[min(idx0 + rb + i * 16 + c, cnt - 1)];
#pragma unroll
                    for (int i = 0; i < 8; ++i) {
                        const int tok = pr[i] >> 3, j = pr[i] & 7;
                        wg[i] = pairw[(size_t)tok * 6 + j]; yrow[i] = (tok - hb * 16384) * 7 + j;
                    }
                } else {
#pragma unroll
                    for (int i = 0; i < 8; ++i) { wg[i] = 1.f; yrow[i] = (idx0 + rb + i * 16 + c) * 7 + 6; }
                }
#pragma unroll
                for (int i = 0; i < 8; ++i) {
                    const int idx = idx0 + rb + i * 16 + c;
                    if (idx < cnt) {
                        bfraw* yp = Y + (size_t)yrow[i] * 1024 + nt * 256 + cbk + 4 * g;
                        const float wgi = wg[i];
#pragma unroll
                        for (int j = 0; j < 4; ++j) st4bf(yp + j * 16, wgi * acc[i][j][0], wgi * acc[i][j][1], wgi * acc[i][j][2], wgi * acc[i][j][3]);
                    }
                }
            });
    }
}

DEV void phase_combine(const Params& p, int layer, int hb, bool next_norm, bool dry = false) {
    const int lane = tidx() & 63, w = tidx() >> 6;
    const bfraw* Y = (const bfraw*)(p.ws + O_Y);
    bfraw* hbuf = (bfraw*)(p.ws + O_HBUF);
    const float* g2 = modp(p, layer, hb, 5);
    for (int tl = blockIdx.x * 8 + w; tl < 16384; tl += gridDim.x * 8) {
        const int tok = hb * 16384 + tl;
        float* xr = p.out + (size_t)tok * 1024;
        float4 v[4]; float ss = 0.f;
#pragma unroll
        for (int i = 0; i < 4; ++i) {
            const int cix = lane * 4 + 256 * i;
            float s0 = 0.f, s1 = 0.f, s2 = 0.f, s3 = 0.f;
#pragma unroll
            for (int j = 0; j < 7; ++j) {
                const uint2 y = *(const uint2*)(Y + ((size_t)tl * 7 + j) * 1024 + cix);
                s0 += lo2f(y.x); s1 += hi2f(y.x); s2 += lo2f(y.y); s3 += hi2f(y.y);
            }
            const float4 x = *(const float4*)(xr + cix), gg = *(const float4*)(g2 + cix);
            v[i].x = x.x + gg.x * s0; v[i].y = x.y + gg.y * s1; v[i].z = x.z + gg.z * s2; v[i].w = x.w + gg.w * s3;
            *(float4*)(dry ? (float*)(p.ws + O_YCAT) + (size_t)(tl & 8191) * 1024 + cix : xr + cix) = v[i];
            ss += v[i].x * v[i].x + v[i].y * v[i].y + v[i].z * v[i].z + v[i].w * v[i].w;
        }
        if (next_norm) {
            ss = wave_sum(ss);
            const float rs = rsqrtf(ss * (1.f / 1024.f) + EPSF);
            const float* gain = p.in[I_NMIX] + (layer + 1) * 1024;
            const float* sc = modp(p, layer + 1, hb, 1); const float* sh = modp(p, layer + 1, hb, 0);
#pragma unroll
            for (int i = 0; i < 4; ++i) {
                const int cix = lane * 4 + 256 * i;
                const float4 gn = *(const float4*)(gain + cix), s1 = *(const float4*)(sc + cix), s0 = *(const float4*)(sh + cix);
                st4bf((dry ? (bfraw*)(p.ws + O_YCAT) : hbuf) + (size_t)tok * 1024 + cix, v[i].x * rs * gn.x * (1.f + s1.x) + s0.x, v[i].y * rs * gn.y * (1.f + s1.y) + s0.y,
                      v[i].z * rs * gn.z * (1.f + s1.z) + s0.z, v[i].w * rs * gn.w * (1.f + s1.w) + s0.w);
            }
        }
    }
}
#define HAVE_L1 1
DEV void phase_inproj1(const Params& p, char* smem, unsigned* xq) {
    const bfraw* A = (const bfraw*)(p.ws + O_HBUF);
    const bfraw* Bt = (const bfraw*)(p.ws + O_WIN1);
    constexpr int NTL = NIN1 / 256;
    for (int rr = 0;; ++rr) {
        int mt, nt;
        if (!xs_tile(NTL, rr, mt, nt)) break;
        const int m0 = __builtin_amdgcn_readfirstlane(mt * 256), n0 = __builtin_amdgcn_readfirstlane(nt * 256);
        gemm_tile2(smem, 16, 64,
            [&](int r) { return A + (size_t)(m0 + r) * 1024; },
            [&](int r) { return Bt + (size_t)(n0 + r) * 1024; },
            [&](const f32x4 (&acc)[8][4], int rb, int cbk, int lane) {
                const int cb = n0 + cbk, tok0 = m0 + rb, b = tok0 >> 14, t0 = tok0 & (TT - 1);
                if (cb < 512) {
                    epi2_headnorm<8>(acc, lane, p.in[I_NSAQN], 0.125f * LOG2E, (bfraw*)(p.ws + O_QN) + ((size_t)(b * 8 + (cb >> 6)) * TT + t0) * 64, 64);
                } else if (cb < 640) {
                    epi2_store_bf16<8>(acc, lane, (bfraw*)(p.ws + O_KCR) + (size_t)tok0 * 128 + (cb - 512), 128);
                } else if (cb < 768) {
                    epi2_store_bf16<8>(acc, lane, (bfraw*)(p.ws + O_VCR) + (size_t)tok0 * 128 + (cb - 640), 128);
                } else if (cb < 896) {
                    epi2_headnorm<8>(acc, lane, p.in[I_NSAKN], 1.f, (bfraw*)(p.ws + O_KS) + ((size_t)(b * 2 + ((cb - 768) >> 6)) * TT + t0) * 64, 64);
                } else if (cb < 1024) {
                    epi2_store_T<8>(acc, lane, (bfraw*)(p.ws + O_VST) + (size_t)(b * 2 + ((cb - 896) >> 6)) * 64 * TT + t0, TT);
                } else if (cb < 1152) {
                    epi2_headnorm<8>(acc, lane, p.in[I_NSAKN], 1.f, (bfraw*)(p.ws + O_KW) + ((size_t)(b * 2 + ((cb - 1024) >> 6)) * TT + t0) * 64, 64);
                } else if (cb < 1280) {
                    epi2_store_T<8>(acc, lane, (bfraw*)(p.ws + O_VWT) + (size_t)(b * 2 + ((cb - 1152) >> 6)) * 64 * TT + t0, TT);
                } else if (cb < 1536) {
                    epi2_store_bf16<8>(acc, lane, (bfraw*)(p.ws + O_LQ) + (size_t)tok0 * 256 + (cb - 1280), 256);
                } else if (cb < 1792) {
                    epi2_store_bf16<8>(acc, lane, (bfraw*)(p.ws + O_LK) + (size_t)tok0 * 256 + (cb - 1536), 256);
                } else if (cb < 2304) {
                    epi2_store_bf16<8>(acc, lane, (bfraw*)(p.ws + O_LV) + (size_t)tok0 * 512 + (cb - 1792), 512);
                } else if (cb < 2816) {
                    epi2_store_bf16<8>(acc, lane, (bfraw*)(p.ws + O_LR) + (size_t)tok0 * 512 + (cb - 2304), 512);
                } else if (cb == 2816) {
                    const int c = lane & 15, g = lane >> 4;
                    float* sm = (float*)(p.ws + O_SM1);
#pragma unroll
                    for (int j = 0; j < 3; ++j)
                        if (j * 16 + 4 * g < 40) {
#pragma unroll
                            for (int i = 0; i < 8; ++i) *(float4*)&sm[(size_t)(tok0 + i * 16 + c) * 40 + j * 16 + 4 * g] = make_float4(acc[i][j][0], acc[i][j][1], acc[i][j][2], acc[i][j][3]);
                        }
                }
            });
    }
}

constexpr int NC_H1 = 0;
DEV void nsa_compress_item(const Params& p, char* smem, int item) {
    const int tid = tidx(), lane = tid & 63, w = tid >> 6, c = lane & 15, g = lane >> 4;
    const int wh = item >> 6, rt = item & 63;
    const int R0 = rt * 64, bk = R0 >> 10, b = bk >> 1, kvh = bk & 1, nb0 = R0 & 1023;
    const bfraw* raw = (const bfraw*)(p.ws + (wh ? O_VCR : O_KCR));
    const bfraw* W1 = (const bfraw*)(p.ws + O_W1T) + (size_t)wh * 256 * 2048;
    const bfraw* W2 = (const bfraw*)(p.ws + O_W2T) + (size_t)wh * 64 * 256;
    bfraw* H1 = (bfraw*)(smem + NC_H1);
    __syncthreads();
    {
        const int wm = w & 3, wn = w >> 2;
        int n = nb0 + wm * 16 + c; if (n > 1022) n = 1022;
        const bfraw* arow = raw + ((size_t)b * TT + 16 * n) * 128 + kvh * 64 + 8 * g;
        const bfraw* brow = W1 + (size_t)(wn * 128 + c) * 2048 + 8 * g;
        f32x4 acc[8];
#pragma unroll
        for (int j = 0; j < 8; ++j) acc[j] = f32x4{0.f, 0.f, 0.f, 0.f};
#pragma unroll 2
        for (int ks = 0; ks < 64; ++ks) {
            const bf16x8 a = ld8(arow + (size_t)(ks >> 1) * 128 + (ks & 1) * 32);
#pragma unroll
            for (int j = 0; j < 8; ++j) acc[j] = mfma16(a, ld8(brow + (size_t)j * 16 * 2048 + ks * 32), acc[j]);
        }
        const float* b1 = (const float*)(p.ws + O_BIAS1) + wh * 256;
#pragma unroll
        for (int j = 0; j < 8; ++j) {
            const int col = wn * 128 + j * 16 + c;
            const float bb = b1[col];
#pragma unroll
            for (int r = 0; r < 4; ++r) H1[(wm * 16 + 4 * g + r) * 264 + col] = f2bf(siluf_(acc[j][r] + bb));
        }
    }
    __syncthreads();
    if (w < 4) {
        f32x4 acc[4];
#pragma unroll
        for (int j = 0; j < 4; ++j) acc[j] = f32x4{0.f, 0.f, 0.f, 0.f};
#pragma unroll
        for (int ks = 0; ks < 8; ++ks) {
            const bf16x8 a = ld8(&H1[(w * 16 + c) * 264 + ks * 32 + 8 * g]);
#pragma unroll
            for (int j = 0; j < 4; ++j) acc[j] = mfma16(a, ld8(W2 + (size_t)(j * 16 + c) * 256 + ks * 32 + 8 * g), acc[j]);
        }
        const int nrow = nb0 + w * 16 + 4 * g;
        if (wh == 0) {
            bfraw* kc = (bfraw*)(p.ws + O_KCMP) + (size_t)bk * 1024 * 64;
#pragma unroll
            for (int r = 0; r < 4; ++r) {
                float ss = 0.f;
#pragma unroll
                for (int j = 0; j < 4; ++j) ss += acc[j][r] * acc[j][r];
                ss = grp16_sum(ss);
                const float rs = (nrow + r < 1023) ? rsqrtf(ss * (1.f / 64.f) + EPSF) : 0.f;
#pragma unroll
                for (int j = 0; j < 4; ++j) kc[(size_t)(nrow + r) * 64 + j * 16 + c] = f2bf(acc[j][r] * rs * p.in[I_NSAKN][j * 16 + c]);
            }
        } else {
            bfraw* vc = (bfraw*)(p.ws + O_VCMPT) + (size_t)bk * 64 * 1024;
#pragma unroll
            for (int j = 0; j < 4; ++j)
                st4bf(vc + (size_t)(j * 16 + c) * 1024 + nrow, acc[j][0], acc[j][1], acc[j][2], (nrow + 3 < 1023) ? acc[j][3] : 0.f);
        }
    }
    __syncthreads();
}

constexpr int GL_G = 0, GL_QD = 16384, GL_KN = 25600, GL_AT = 34816, GL_VT = 44032, GL_KDT = 62464, GL_TOT = 71680;
DEV void gla_a_item(const Params& p, char* smem, int item) {
    const int bh = item >> 8, n = item & 255, b = bh >> 2, h = bh & 3, tok0 = b * TT + n * 64;
    float* G = (float*)(smem + GL_G);
    bfraw* qd = (bfraw*)(smem + GL_QD);
    bfraw* kn = (bfraw*)(smem + GL_KN);
    bfraw* at = (bfraw*)(smem + GL_AT);
    bfraw* vT = (bfraw*)(smem + GL_VT);
    bfraw* kdT = (bfraw*)(smem + GL_KDT);
    float* tot = (float*)(smem + GL_TOT);
    const float* sm1 = (const float*)(p.ws + O_SM1);
    __syncthreads();
    {
        OPQ_TID();
        const int d = tid & 63, ig = tid >> 6;
        float wu[16];
#pragma unroll
        for (int r = 0; r < 16; ++r) wu[r] = p.in[I_GLAWG][r * 256 + h * 64 + d];
        const float bg = p.in[I_GLABG][h * 64 + d];
        float run = 0.f;
#pragma unroll 1
        for (int ii = 0; ii < 8; ++ii) {
            const int i = ig * 8 + ii;
            const float* lg = sm1 + (size_t)(tok0 + i) * 40 + 24;
            float z = bg;
#pragma unroll
            for (int r = 0; r < 16; ++r) z += lg[r] * wu[r];
            run += logsigmoidf_(z) * (1.f / 16.f);
            G[i * 64 + d] = run;
        }
        tot[ig * 64 + d] = run;
    }
    __syncthreads();
    {
        OPQ_TID();
        const int d = tid & 63, ig = tid >> 6;
        float off = 0.f;
        for (int q = 0; q < ig; ++q) off += tot[q * 64 + d];
#pragma unroll 1
        for (int ii = 0; ii < 8; ++ii) G[(ig * 8 + ii) * 64 + d] += off;
    }
    __syncthreads();
    {
        OPQ_TID();
        const int i = tid >> 3, d0 = (tid & 7) * 8, e0 = (tid & 7) * 16;
        U4 qv, kv;
        qv.u = *(const uint4*)((const bfraw*)(p.ws + O_LQ) + (size_t)(tok0 + i) * 256 + h * 64 + d0);
        kv.u = *(const uint4*)((const bfraw*)(p.ws + O_LK) + (size_t)(tok0 + i) * 256 + h * 64 + d0);
        U4 qo, ko;
#pragma unroll
        for (int q = 0; q < 4; ++q) {
            const float g0 = G[i * 64 + d0 + 2 * q], g1 = G[i * 64 + d0 + 2 * q + 1];
            const float gl0 = G[63 * 64 + d0 + 2 * q], gl1 = G[63 * 64 + d0 + 2 * q + 1];
            const float q0 = lo2f(qv.w[q]), q1 = hi2f(qv.w[q]), k0 = lo2f(kv.w[q]), k1 = hi2f(kv.w[q]);
            qo.w[q] = pack2(q0 * 0.125f * __expf(g0), q1 * 0.125f * __expf(g1));
            ko.w[q] = pack2(k0 * __expf(-g0), k1 * __expf(-g1));
            kdT[(d0 + 2 * q) * 72 + i] = f2bf(k0 * __expf(gl0 - g0));
            kdT[(d0 + 2 * q + 1) * 72 + i] = f2bf(k1 * __expf(gl1 - g1));
        }
        *(uint4*)&qd[i * 72 + d0] = qo.u;
        *(uint4*)&kn[i * 72 + d0] = ko.u;
        *(uint4*)((bfraw*)(p.ws + O_QD) + ((size_t)item * 64 + i) * 64 + d0) = qo.u;
        const bfraw* vp = (const bfraw*)(p.ws + O_LV) + (size_t)(tok0 + i) * 512 + h * 128 + e0;
        U4 v0, v1; v0.u = *(const uint4*)vp; v1.u = *(const uint4*)(vp + 8);
#pragma unroll
        for (int q = 0; q < 4; ++q) {
            vT[(e0 + 2 * q) * 72 + i] = (bfraw)(v0.w[q] & 0xffffu); vT[(e0 + 2 * q + 1) * 72 + i] = (bfraw)(v0.w[q] >> 16);
            vT[(e0 + 8 + 2 * q) * 72 + i] = (bfraw)(v1.w[q] & 0xffffu); vT[(e0 + 8 + 2 * q + 1) * 72 + i] = (bfraw)(v1.w[q] >> 16);
        }
        if (tid < 64) ((float*)(p.ws + O_AN))[(size_t)item * 64 + tid] = __expf(G[63 * 64 + tid]);
    }
    __syncthreads();
    {
        OPQ_TID();
        const int ti = w >> 1, tj0 = (w & 1) * 2;
        f32x4 acc[2];
        acc[0] = f32x4{0.f, 0.f, 0.f, 0.f}; acc[1] = f32x4{0.f, 0.f, 0.f, 0.f};
#pragma unroll
        for (int ks = 0; ks < 2; ++ks) {
            const bf16x8 a = ld8(&qd[(ti * 16 + c) * 72 + ks * 32 + 8 * g]);
#pragma unroll
            for (int jt = 0; jt < 2; ++jt) acc[jt] = mfma16(a, ld8(&kn[((tj0 + jt) * 16 + c) * 72 + ks * 32 + 8 * g]), acc[jt]);
        }
#pragma unroll
        for (int jt = 0; jt < 2; ++jt)
#pragma unroll
            for (int r = 0; r < 4; ++r) {
                const int i = ti * 16 + 4 * g + r, j = (tj0 + jt) * 16 + c;
                at[i * 72 + j] = f2bf(i >= j ? acc[jt][r] : 0.f);
            }
    }
    __syncthreads();
    {
        OPQ_TID();
        f32x4 ao[4], ab[4];
#pragma unroll
        for (int q = 0; q < 4; ++q) { ao[q] = f32x4{0.f, 0.f, 0.f, 0.f}; ab[q] = f32x4{0.f, 0.f, 0.f, 0.f}; }
#pragma unroll
        for (int ks = 0; ks < 2; ++ks) {
            const bf16x8 ve = ld8(&vT[(w * 16 + c) * 72 + ks * 32 + 8 * g]);
#pragma unroll
            for (int q = 0; q < 4; ++q) {
                ao[q] = mfma16(ve, ld8(&at[(q * 16 + c) * 72 + ks * 32 + 8 * g]), ao[q]);
                ab[q] = mfma16(ld8(&kdT[(q * 16 + c) * 72 + ks * 32 + 8 * g]), ve, ab[q]);
            }
        }
        bfraw* yc = (bfraw*)(p.ws + O_YCAT);
        float* st = (float*)(p.ws + O_ST) + (size_t)item * 8192;
#pragma unroll
        for (int q = 0; q < 4; ++q) {
            st4bf(yc + (size_t)(tok0 + q * 16 + c) * 1024 + 512 + h * 128 + w * 16 + 4 * g, ao[q][0], ao[q][1], ao[q][2], ao[q][3]);
            *(float4*)(st + (size_t)(w * 16 + c) * 64 + q * 16 + 4 * g) = make_float4(ab[q][0], ab[q][1], ab[q][2], ab[q][3]);
        }
    }
    lds_barrier();
}

DEV void gla_scan_item(const Params& p, int item) {
    const int id = item * 512 + tidx(), bh = id >> 13, rem = id & 8191, d = rem & 63;
    float* st = (float*)(p.ws + O_ST) + (size_t)bh * 256 * 8192 + rem;
    const float* an = (const float*)(p.ws + O_AN) + (size_t)bh * 256 * 64 + d;
    float S = 0.f;
    for (int n0 = 0; n0 < 256; n0 += 8) {
        float bv[8], av[8];
#pragma unroll
        for (int q = 0; q < 8; ++q) { bv[q] = st[(size_t)(n0 + q) * 8192]; av[q] = an[(size_t)(n0 + q) * 64]; }
#pragma unroll
        for (int q = 0; q < 8; ++q) { st[(size_t)(n0 + q) * 8192] = S; S = av[q] * S + bv[q]; }
    }
}

DEV void gla_c_witem(const Params& p, int witem, bool dry = false) {
    const int lane = tidx() & 63, c = lane & 15, g = lane >> 4;
    const int item = witem >> 2, it = witem & 3;
    const int bh = item >> 8, n = item & 255, b = bh >> 2, h = bh & 3;
    const float* st = (const float*)(p.ws + O_ST) + (size_t)item * 8192;
    const bfraw* qd = (const bfraw*)(p.ws + O_QD) + (size_t)item * 4096;
    f32x4 acc[8];
#pragma unroll
    for (int et = 0; et < 8; ++et) acc[et] = f32x4{0.f, 0.f, 0.f, 0.f};
#pragma unroll
    for (int ks = 0; ks < 2; ++ks) {
        const bf16x8 bq = ld8(qd + (size_t)(it * 16 + c) * 64 + ks * 32 + 8 * g);
#pragma unroll
        for (int et = 0; et < 8; ++et) {
            const float* sp = st + (size_t)(et * 16 + c) * 64 + ks * 32 + 8 * g;
            const float4 s0 = *(const float4*)sp, s1 = *(const float4*)(sp + 4);
            acc[et] = mfma16(pack8(s0.x, s0.y, s0.z, s0.w, s1.x, s1.y, s1.z, s1.w), bq, acc[et]);
        }
    }
    const int tok = b * TT + n * 64 + it * 16 + c;
    bfraw* yp = (bfraw*)(p.ws + O_YCAT) + (size_t)tok * 1024 + 512 + h * 128 + 4 * g;
    const bfraw* lr = (const bfraw*)(p.ws + O_LR) + (size_t)tok * 512 + h * 128 + 4 * g;
    float ss = 0.f;
#pragma unroll
    for (int et = 0; et < 8; ++et) {
        const uint2 o0 = *(const uint2*)(yp + et * 16);
        acc[et][0] += lo2f(o0.x); acc[et][1] += hi2f(o0.x); acc[et][2] += lo2f(o0.y); acc[et][3] += hi2f(o0.y);
        ss += acc[et][0] * acc[et][0] + acc[et][1] * acc[et][1] + acc[et][2] * acc[et][2] + acc[et][3] * acc[et][3];
    }
    ss = grpx_sum(ss);
    const float rs = rsqrtf(ss * (1.f / 128.f) + EPSF);
#pragma unroll
    for (int et = 0; et < 8; ++et) {
        const uint2 zv = *(const uint2*)(lr + et * 16);
        const float4 gn = *(const float4*)(p.in[I_GLAON] + et * 16 + 4 * g);
        st4bf((dry ? (bfraw*)(p.ws + O_KS) + (size_t)tok * 128 + 4 * g : yp) + et * 16, acc[et][0] * rs * gn.x * siluf_(lo2f(zv.x)), acc[et][1] * rs * gn.y * siluf_(hi2f(zv.x)),
                            acc[et][2] * rs * gn.z * siluf_(lo2f(zv.y)), acc[et][3] * rs * gn.w * siluf_(hi2f(zv.y)));
    }
}
constexpr int NS_IMP = 0;
constexpr int NS_IMPW = 16448;
constexpr int NS_LINV = 131584;
constexpr int NS_BTAB = 132096;
constexpr int NS_SELW = 134400;
DEV int t5_bucket(int n) {
    if (n < 16) return n;
    int v = 16 + (int)(__logf((float)n * (1.f / 16.f)) / 2.0794415416798357f * 16.f);
    return v < 31 ? v : 31;
}
template <int MODE>
DEV void nsa_step(const bfraw* Kb, const bfraw* VTb, size_t vstride, int kb, const bf16x8 (&qf)[2], int tpos, int lim, bool colsel, const float* bt, float Mb2,
                  f32x4 (&O)[4], float& l, float* impU, int c, int g) {
    bf16x8 kf[2][2];
#pragma unroll
    for (int kt = 0; kt < 2; ++kt)
#pragma unroll
        for (int ks = 0; ks < 2; ++ks) kf[kt][ks] = ld8(Kb + (size_t)(kb + kt * 16 + c) * 64 + ks * 32 + 8 * g);
    bf16x8 vf[4];
#pragma unroll
    for (int dt = 0; dt < 4; ++dt) { const bfraw* vp = VTb + (size_t)(dt * 16 + c) * vstride + kb + 4 * g; vf[dt] = ld4x2(vp, vp + 16); }
    float pr[2][4];
#pragma unroll
    for (int kt = 0; kt < 2; ++kt) {
        f32x4 S = mfma16(kf[kt][0], qf[0], f32x4{0.f, 0.f, 0.f, 0.f});
        S = mfma16(kf[kt][1], qf[1], S);
#pragma unroll
        for (int r = 0; r < 4; ++r) {
            const int key = kb + kt * 16 + 4 * g + r;
            int dist; bool valid;
            if (MODE == 0) { dist = tpos - 16 * key - 31; valid = key < lim; }
            else if (MODE == 1) { dist = tpos - key; valid = colsel && dist >= 0; }
            else { dist = tpos - key; valid = dist >= 0 && dist < 512; }
            const int bi = dist < 0 ? 0 : (dist > 128 ? 128 : dist);
            const float e = valid ? ex2(S[r] + bt[bi] - Mb2) : 0.f;
            pr[kt][r] = e; l += e;
        }
        if (MODE == 0) {
            const int blk = ((kb + kt * 16) >> 2) + g;
            atomicAdd(&impU[blk * 16 + c], pr[kt][0] + pr[kt][1] + pr[kt][2] + pr[kt][3]);
            atomicAdd(&impU[(blk + 1) * 16 + c], pr[kt][3]);
        }
    }
    const bf16x8 pb = pack8(pr[0][0], pr[0][1], pr[0][2], pr[0][3], pr[1][0], pr[1][1], pr[1][2], pr[1][3]);
#pragma unroll
    for (int dt = 0; dt < 4; ++dt) O[dt] = mfma16(vf[dt], pb, O[dt]);
}

DEV void nsa_item(const Params& p, char* smem, int item) {
    const int tid = tidx(), lane = tid & 63, w = tid >> 6, c = lane & 15, g = lane >> 4;
    const int bk = item >> 9, tq0 = (item & 511) * 32, b = bk >> 1, kvh = bk & 1;
    const int qi = c >> 2, hg = c & 3, h = kvh * 4 + hg;
    const int tw0 = tq0 + 4 * w, tpos = tw0 + qi;
    float* impU = (float*)(smem + NS_IMP + w * NS_IMPW);
    float* linv = (float*)(smem + NS_LINV) + w * 16;
    float* btab = (float*)(smem + NS_BTAB);
    unsigned long long* selw = (unsigned long long*)(smem + NS_SELW) + w * 20;
    __syncthreads();
    for (int idx = tid; idx < 4 * 129; idx += NTHR) {
        const int hh = idx / 129, dd = idx % 129;
        btab[idx] = p.in[I_RELB][(dd < 128 ? t5_bucket(dd) : 31) * 8 + kvh * 4 + hh] * LOG2E;
    }
    for (int idx = lane; idx < 257 * 16; idx += 64) impU[idx] = 0.f;
    const float mq = wave_max(fabsf(p.in[I_NSAQN][lane])), mk = wave_max(fabsf(p.in[I_NSAKN][lane]));
    const float mb = wave_max(fmaxf(fmaxf(fabsf(p.in[I_RELB][lane]), fabsf(p.in[I_RELB][64 + lane])), fmaxf(fabsf(p.in[I_RELB][128 + lane]), fabsf(p.in[I_RELB][192 + lane]))));
    const float Mb2 = (8.f * mq * mk + mb) * LOG2E;
    __syncthreads();
    const float* bt = btab + hg * 129;
    bf16x8 qf[2];
    {
        const bfraw* qp = (const bfraw*)(p.ws + O_QN) + ((size_t)(b * 8 + h) * TT + tpos) * 64 + 8 * g;
        qf[0] = ld8(qp); qf[1] = ld8(qp + 32);
    }
    const float* gp = (const float*)(p.ws + O_SM1) + (size_t)(b * TT + tpos) * 40 + h * 3;
    const float gt0 = sigmoidf_(gp[0]), gt1 = sigmoidf_(gp[1]), gt2 = sigmoidf_(gp[2]);
    f32x4 ot[4];
#pragma unroll
    for (int dt = 0; dt < 4; ++dt) ot[dt] = f32x4{0.f, 0.f, 0.f, 0.f};
    {
        const int ncnt = tpos >= 31 ? ((tpos - 31) >> 4) + 1 : 0;
        const int tmax = tw0 + 3;
        const int ncw = tmax >= 31 ? ((tmax - 31) >> 4) + 1 : 0;
        const bfraw* Kb = (const bfraw*)(p.ws + O_KCMP) + (size_t)bk * 1024 * 64;
        const bfraw* Vb = (const bfraw*)(p.ws + O_VCMPT) + (size_t)bk * 64 * 1024;
        f32x4 O[4]; float l = 0.f;
#pragma unroll
        for (int dt = 0; dt < 4; ++dt) O[dt] = f32x4{0.f, 0.f, 0.f, 0.f};
        for (int kb = 0; kb < ncw; kb += 32) nsa_step<0>(Kb, Vb, 1024, kb, qf, tpos, ncnt, true, bt, Mb2, O, l, impU, c, g);
        const float lt = grpx_sum(l);
        const float inv = lt > 0.f ? 1.f / lt : 0.f;
        if (g == 0) linv[c] = inv;
#pragma unroll
        for (int dt = 0; dt < 4; ++dt) ot[dt] += O[dt] * (gt0 * inv);
    }
    const int cur = tw0 >> 6;
    {
        unsigned long long un[4] = {0ull, 0ull, 0ull, 0ull};
#pragma unroll 1
        for (int q = 0; q < 4; ++q) {
            float v[4]; bool sel[4];
#pragma unroll
            for (int m = 0; m < 4; ++m) {
                const int s = lane + 64 * m;
                float a = -1.f;
                if (s <= cur) {
                    a = 0.f;
#pragma unroll
                    for (int hh = 0; hh < 4; ++hh) a += impU[s * 16 + q * 4 + hh] * linv[q * 4 + hh];
                }
                const bool forced = (s <= cur) && (s == 0 || s == cur || s == cur - 1);
                sel[m] = forced; v[m] = forced ? -1.f : a;
            }
            const int nforced = cur == 0 ? 1 : (cur == 1 ? 2 : 3);
            const int need = (cur + 1 < 16 ? cur + 1 : 16) - nforced;
            for (int itn = 0; itn < need; ++itn) {
                const float vmax = wave_max(fmaxf(fmaxf(v[0], v[1]), fmaxf(v[2], v[3])));
                if (!(vmax >= 0.f)) break;
                bool done = false;
#pragma unroll
                for (int m = 0; m < 4; ++m) {
                    const unsigned long long mk2 = __ballot(v[m] == vmax);
                    if (!done && mk2 != 0ull) {
                        const int ln = __builtin_ctzll(mk2);
                        if (lane == ln) { sel[m] = true; v[m] = -1.f; }
                        done = true;
                    }
                }
            }
#pragma unroll
            for (int m = 0; m < 4; ++m) {
                const unsigned long long bm = __ballot(sel[m]);
                if (lane == 0) selw[q * 4 + m] = bm;
                un[m] |= bm;
            }
        }
        if (lane == 0) {
#pragma unroll
            for (int m = 0; m < 4; ++m) selw[16 + m] = un[m];
        }
    }
    {
        const bfraw* Kb = (const bfraw*)(p.ws + O_KS) + (size_t)bk * TT * 64;
        const bfraw* Vb = (const bfraw*)(p.ws + O_VST) + (size_t)bk * 64 * TT;
        f32x4 O[4]; float l = 0.f;
#pragma unroll
        for (int dt = 0; dt < 4; ++dt) O[dt] = f32x4{0.f, 0.f, 0.f, 0.f};
#pragma unroll 1
        for (int m = 0; m < 4; ++m) {
            unsigned long long um = selw[16 + m];
            const unsigned long long mine = selw[qi * 4 + m];
            while (um) {
                const int bit = __builtin_ctzll(um);
                um &= um - 1ull;
                const bool colsel = (mine >> bit) & 1ull;
                const int k0 = (64 * m + bit) * 64;
                nsa_step<1>(Kb, Vb, TT, k0, qf, tpos, 0, colsel, bt, Mb2, O, l, impU, c, g);
                nsa_step<1>(Kb, Vb, TT, k0 + 32, qf, tpos, 0, colsel, bt, Mb2, O, l, impU, c, g);
            }
        }
        const float lt = grpx_sum(l);
        const float inv = lt > 0.f ? 1.f / lt : 0.f;
#pragma unroll
        for (int dt = 0; dt < 4; ++dt) ot[dt] += O[dt] * (gt1 * inv);
    }
    {
        const bfraw* Kb = (const bfraw*)(p.ws + O_KW) + (size_t)bk * TT * 64;
        const bfraw* Vb = (const bfraw*)(p.ws + O_VWT) + (size_t)bk * 64 * TT;
        f32x4 O[4]; float l = 0.f;
#pragma unroll
        for (int dt = 0; dt < 4; ++dt) O[dt] = f32x4{0.f, 0.f, 0.f, 0.f};
        int ks0 = tw0 - 511; if (ks0 < 0) ks0 = 0; ks0 &= ~31;
        for (int kb = ks0; kb <= tw0 + 3; kb += 32) nsa_step<2>(Kb, Vb, TT, kb, qf, tpos, 0, true, bt, Mb2, O, l, impU, c, g);
        const float lt = grpx_sum(l);
        const float inv = lt > 0.f ? 1.f / lt : 0.f;
#pragma unroll
        for (int dt = 0; dt < 4; ++dt) ot[dt] += O[dt] * (gt2 * inv);
    }
    bfraw* yp = (bfraw*)(p.ws + O_YCAT) + (size_t)(b * TT + tpos) * 1024 + h * 64 + 4 * g;
#pragma unroll
    for (int dt = 0; dt < 4; ++dt) st4bf(yp + dt * 16, ot[dt][0], ot[dt][1], ot[dt][2], ot[dt][3]);
    __syncthreads();
}
constexpr int N2_IMP = 71680, N2_BTAB = 138240, N2_SELW = 140320;
constexpr int N2_IMPW = 8 * 260;

template <int MODE>
DEV void nsa_tile(const bfraw* Kb, const bfraw* Vb, int key0, const bf16x8 (&qf)[2][2], const int (&tpos)[2], const int (&lim)[2], const bool (&colsel)[2],
                  const bool (&act)[2], const float* bt, bool far, float Mb2, const float (&pscale)[2], f32x4 (&O)[2][4], float (&l)[2], float* impq, int c, int g, int vld = 72, float* carry = nullptr) {
    bf16x8 pb[2][2];
    const float bfar = bt[128] - Mb2;
#pragma unroll
    for (int kt = 0; kt < 4; ++kt) {
        const bf16x8 k0 = ld8(&Kb[(kt * 16 + c) * 72 + g * 8]), k1 = ld8(&Kb[(kt * 16 + c) * 72 + 32 + g * 8]);
#pragma unroll
        for (int cg = 0; cg < 2; ++cg) {
            if (!act[cg]) continue;
            float e[4];
            if (far) {
                const float bi = (MODE == 2 && !colsel[cg]) ? -INFINITY : bfar;
                f32x4 S = mfma16(k0, qf[cg][0], f32x4{bi, bi, bi, bi});
                S = mfma16(k1, qf[cg][1], S);
#pragma unroll
                for (int r = 0; r < 4; ++r) { e[r] = ex2(S[r]); if (MODE == 1) e[r] *= pscale[cg]; l[cg] += e[r]; }
            } else {
                f32x4 S = mfma16(k0, qf[cg][0], f32x4{0.f, 0.f, 0.f, 0.f});
                S = mfma16(k1, qf[cg][1], S);
#pragma unroll
                for (int r = 0; r < 4; ++r) {
                    const int key = key0 + kt * 16 + 4 * g + r;
                    bool valid; int dist;
                    if (MODE <= 1) { dist = tpos[cg] - 16 * key - 31; valid = key < lim[cg]; }
                    else { dist = tpos[cg] - key; valid = (MODE == 2) ? (colsel[cg] && dist >= 0) : (dist >= 0 && dist < 512); }
                    const float bias = bt[dist < 0 ? 0 : (dist > 128 ? 128 : dist)] - Mb2;
                    e[r] = valid ? ex2(S[r] + bias) : 0.f;
                    if (MODE == 1) e[r] *= pscale[cg];
                    l[cg] += e[r];
                }
            }
            if (MODE == 1) {
                float a = (e[0] + e[1]) + (e[2] + e[3]), a3 = e[3];
                a += __shfl_xor(a, 1); a3 += __shfl_xor(a3, 1);
                a += __shfl_xor(a, 2); a3 += __shfl_xor(a3, 2);
                const float pu = __shfl_up(a3, 16), pw = __shfl(carry[cg], (c + 48) & 63);
                a += (g == 0) ? pw : pu;
                carry[cg] = a3;
                if ((c & 3) == 0) impq[(cg * 4 + (c >> 2)) * 260 + ((key0 + kt * 16) >> 2) + g] = a;
            }
            if (MODE != 0) {
                U4 t;
                if (kt & 1) { t.v = pb[cg][kt >> 1]; t.w[2] = pack2(e[0], e[1]); t.w[3] = pack2(e[2], e[3]); }
                else { t.w[0] = pack2(e[0], e[1]); t.w[1] = pack2(e[2], e[3]); t.w[2] = 0u; t.w[3] = 0u; }
                pb[cg][kt >> 1] = t.v;
            }
        }
    }
    if (MODE != 0) {
#pragma unroll
        for (int dt = 0; dt < 4; ++dt) {
            const bfraw* vp = &Vb[(dt * 16 + c) * vld + 4 * g];
            const bf16x8 v0 = ld4x2(vp, vp + 16), v1 = ld4x2(vp + 32, vp + 48);
#pragma unroll
            for (int cg = 0; cg < 2; ++cg) if (act[cg]) { O[cg][dt] = mfma16(v0, pb[cg][0], O[cg][dt]); O[cg][dt] = mfma16(v1, pb[cg][1], O[cg][dt]); }
        }
    }
}

DEV void nsa_item2(const Params& p, char* smem, int item) {
    const int tid = tidx(), lane = tid & 63, w = tid >> 6, c = lane & 15, g = lane >> 4;
    const int bk = item >> 8, cur = item & 255, Q0 = cur * 64, b = bk >> 1, kvh = bk & 1;
    const int hg = c & 3, h = kvh * 4 + hg;
    float* impq = (float*)(smem + N2_IMP) + w * N2_IMPW;
    float* btab = (float*)(smem + N2_BTAB);
    unsigned long long* selw = (unsigned long long*)(smem + N2_SELW) + w * 36;
    __syncthreads();
    for (int idx = tid; idx < 4 * 129; idx += NTHR) {
        const int hh = idx / 129, dd = idx % 129;
        btab[idx] = p.in[I_RELB][(dd < 128 ? t5_bucket(dd) : 31) * 8 + kvh * 4 + hh] * LOG2E;
    }
    for (int idx = lane; idx < N2_IMPW; idx += 64) impq[idx] = 0.f;
    const float mq = wave_max(fabsf(p.in[I_NSAQN][lane])), mk = wave_max(fabsf(p.in[I_NSAKN][lane]));
    const float mb = wave_max(fmaxf(fmaxf(fabsf(p.in[I_RELB][lane]), fabsf(p.in[I_RELB][64 + lane])), fmaxf(fabsf(p.in[I_RELB][128 + lane]), fabsf(p.in[I_RELB][192 + lane]))));
    const float Mb2 = (8.f * mq * mk + mb) * LOG2E;
    const float* bt = btab + hg * 129;
    int tpos[2]; bf16x8 qf[2][2];
    float* otl = impq;
#pragma unroll
    for (int cg = 0; cg < 2; ++cg) {
        tpos[cg] = Q0 + 8 * w + 4 * cg + (c >> 2);
        const bfraw* qp = (const bfraw*)(p.ws + O_QN) + ((size_t)(b * 8 + h) * TT + tpos[cg]) * 64 + 8 * g;
        qf[cg][0] = ld8(qp); qf[cg][1] = ld8(qp + 32);
    }
    const float* gbase = (const float*)(p.ws + O_SM1) + (size_t)b * TT * 40 + h * 3;
    const bool csel1[2] = {true, true};
    const float one2[2] = {1.f, 1.f};
    f32x4 Oc[2][4];
    {
        int lim[2];
#pragma unroll
        for (int cg = 0; cg < 2; ++cg) lim[cg] = tpos[cg] >= 31 ? ((tpos[cg] - 31) >> 4) + 1 : 0;
        const int ncb = ((Q0 + 32) >> 4) + 1, nct = (ncb + 63) >> 6;
        const bfraw* Kg = (const bfraw*)(p.ws + O_KCMP) + (size_t)bk * 1024 * 64;
        const bfraw* Vg = (const bfraw*)(p.ws + O_VCMPT) + (size_t)bk * 64 * 1024;
        float l[2] = {0.f, 0.f};
#pragma unroll
        for (int cg = 0; cg < 2; ++cg)
#pragma unroll
            for (int dt = 0; dt < 4; ++dt) Oc[cg][dt] = f32x4{0.f, 0.f, 0.f, 0.f};
        tile_stream<false, false>(smem, Kg, Vg, 1024, nullptr, nct, [](int t) { return t * 64; },
            [&](int t, const bfraw* Kb, const bfraw* Vb, const float*) { nsa_tile<0>(Kb, Vb, t * 64, qf, tpos, lim, csel1, csel1, bt, 1024 * t + 1039 + 128 <= Q0, Mb2, one2, Oc, l, impq, c, g); });
        float linv[2];
#pragma unroll
        for (int cg = 0; cg < 2; ++cg) { const float lt = grpx_sum(l[cg]); linv[cg] = lt > 0.f ? 1.f / lt : 0.f; l[cg] = 0.f; }
        float carry[2] = {0.f, 0.f};
        tile_stream<true, false>(smem, Kg, Vg, 1024, nullptr, nct, [](int t) { return t * 64; },
            [&](int t, const bfraw* Kb, const bfraw* Vb, const float*) { nsa_tile<1>(Kb, Vb, t * 64, qf, tpos, lim, csel1, csel1, bt, 1024 * t + 1039 + 128 <= Q0, Mb2, linv, Oc, l, impq, c, g, 72, carry); });
    }
    {
        unsigned long long un[4] = {0ull, 0ull, 0ull, 0ull};
        const int nforced = cur == 0 ? 1 : (cur == 1 ? 2 : 3);
        const int need = (cur + 1 < 16 ? cur + 1 : 16) - nforced;
#pragma unroll 1
        for (int q = 0; q < 8; ++q) {
            float v[4]; bool sel[4];
#pragma unroll
            for (int m = 0; m < 4; ++m) {
                const int s = lane + 64 * m;
                const bool inr = s <= cur;
                const bool forced = inr && (s == 0 || s == cur || s == cur - 1);
                sel[m] = forced; v[m] = (inr && !forced) ? impq[q * 260 + s] : -1.f;
            }
            for (int itn = 0; itn < need; ++itn) {
                const float vmax = wave_max(fmaxf(fmaxf(v[0], v[1]), fmaxf(v[2], v[3])));
                if (!(vmax >= 0.f)) break;
                bool done = false;
#pragma unroll
                for (int m = 0; m < 4; ++m) {
                    const unsigned long long mk2 = __ballot(v[m] == vmax);
                    if (!done && mk2 != 0ull) {
                        const int ln = __builtin_ctzll(mk2);
                        if (lane == ln) { sel[m] = true; v[m] = -1.f; }
                        done = true;
                    }
                }
            }
#pragma unroll
            for (int m = 0; m < 4; ++m) {
                const unsigned long long bm = __ballot(sel[m]);
                if (lane == 0) selw[q * 4 + m] = bm;
                un[m] |= bm;
            }
        }
        if (lane == 0) {
#pragma unroll
            for (int m = 0; m < 4; ++m) selw[32 + m] = un[m];
        }
    }
#pragma unroll
    for (int cg = 0; cg < 2; ++cg) {
        const float g0 = sigmoidf_(gbase[(size_t)tpos[cg] * 40 + 0]);
#pragma unroll
        for (int dt = 0; dt < 4; ++dt)
#pragma unroll
            for (int r = 0; r < 4; ++r) otl[((cg * 4 + dt) * 4 + r) * 64 + lane] = Oc[cg][dt][r] * g0;
    }
    {
        const bfraw* Kg = (const bfraw*)(p.ws + O_KS) + (size_t)bk * TT * 64;
        const bfraw* Vg = (const bfraw*)(p.ws + O_VST) + (size_t)bk * 64 * TT;
        f32x4 O[2][4]; float l[2] = {0.f, 0.f};
        const int lim0[2] = {0, 0};
#pragma unroll
        for (int cg = 0; cg < 2; ++cg)
#pragma unroll
            for (int dt = 0; dt < 4; ++dt) O[cg][dt] = f32x4{0.f, 0.f, 0.f, 0.f};
        tile_stream2(smem, Kg, Vg, TT, (cur + 2) >> 1, [](int t) { return t * 128; }, [&](int t) { return (2 * t + 1 <= cur ? 2 * t + 1 : cur) * 64; },
            [&](int t, const bfraw* Kb, const bfraw* Vb) {
#pragma unroll
                for (int u = 0; u < 2; ++u) {
                    const int s = 2 * t + u;
                    if (s > cur) continue;
                    const int m = s >> 6, bit = s & 63;
                    if ((selw[32 + m] >> bit) & 1ull) {
                        bool cs[2], ac[2];
                        cs[0] = (selw[(c >> 2) * 4 + m] >> bit) & 1ull;
                        cs[1] = (selw[(4 + (c >> 2)) * 4 + m] >> bit) & 1ull;
                        ac[0] = ((selw[0 + m] | selw[4 + m] | selw[8 + m] | selw[12 + m]) >> bit) & 1ull;
                        ac[1] = ((selw[16 + m] | selw[20 + m] | selw[24 + m] | selw[28 + m]) >> bit) & 1ull;
                        nsa_tile<2>(Kb + u * 64 * 72, Vb + u * 64, s * 64, qf, tpos, lim0, cs, ac, bt, cur - s >= 3, Mb2, one2, O, l, impq, c, g, 136);
                    }
                }
            });
#pragma unroll
        for (int cg = 0; cg < 2; ++cg) {
            const float lt = grpx_sum(l[cg]);
            const float sc = (lt > 0.f ? 1.f / lt : 0.f) * sigmoidf_(gbase[(size_t)tpos[cg] * 40 + 1]);
#pragma unroll
            for (int dt = 0; dt < 4; ++dt)
#pragma unroll
                for (int r = 0; r < 4; ++r) otl[((cg * 4 + dt) * 4 + r) * 64 + lane] += O[cg][dt][r] * sc;
        }
    }
    {
        const bfraw* Kg = (const bfraw*)(p.ws + O_KW) + (size_t)bk * TT * 64;
        const bfraw* Vg = (const bfraw*)(p.ws + O_VWT) + (size_t)bk * 64 * TT;
        f32x4 O[2][4]; float l[2] = {0.f, 0.f};
        const int lim0[2] = {0, 0};
#pragma unroll
        for (int cg = 0; cg < 2; ++cg)
#pragma unroll
            for (int dt = 0; dt < 4; ++dt) O[cg][dt] = f32x4{0.f, 0.f, 0.f, 0.f};
        const int j0 = cur >= 8 ? cur - 8 : 0;
        tile_stream<true, false>(smem, Kg, Vg, TT, nullptr, cur - j0 + 1, [&](int t) { return (j0 + t) * 64; },
            [&](int t, const bfraw* Kb, const bfraw* Vb, const float*) {
                const int j = j0 + t;
                nsa_tile<3>(Kb, Vb, j * 64, qf, tpos, lim0, csel1, csel1, bt, (cur - j >= 3) && (cur - j <= 6), Mb2, one2, O, l, impq, c, g);
            });
#pragma unroll
        for (int cg = 0; cg < 2; ++cg) {
            const float lt = grpx_sum(l[cg]);
            const float sc = (lt > 0.f ? 1.f / lt : 0.f) * sigmoidf_(gbase[(size_t)tpos[cg] * 40 + 2]);
            bfraw* yp = (bfraw*)(p.ws + O_YCAT) + (size_t)(b * TT + tpos[cg]) * 1024 + h * 64 + 4 * g;
#pragma unroll
            for (int dt = 0; dt < 4; ++dt) {
                const float* op = &otl[((cg * 4 + dt) * 4) * 64 + lane];
                st4bf(yp + dt * 16, op[0] + O[cg][dt][0] * sc, op[64] + O[cg][dt][1] * sc, op[128] + O[cg][dt][2] * sc, op[192] + O[cg][dt][3] * sc);
            }
        }
    }
    __syncthreads();
}
constexpr int SM_QSLOT = 148000, SM_BARW = 148016;
DEV int q_pop(unsigned* ctr, char* smem) {
    int* slot = (int*)(smem + SM_QSLOT);
    __syncthreads();
    if (tidx() == 0) *slot = (int)atomicAdd(ctr, 1u);
    __syncthreads();
    return *slot;
}

template <int P, int REP = 0> DEV void run_phase(const Params& p, char* smem) {
    unsigned* ctrs = (unsigned*)(p.ws + O_CNT);
    if constexpr (P == 0) {
        phase_prologue(p, smem);
    } else if constexpr (P == 1) {
        phase_norm1(p, p.in[I_X], 0);
    } else if constexpr (P == 2) {
        phase_inproj0(p, smem, ctrs + 512 + (2 * 3 + REP) * 8);
    } else if constexpr (P == 3) {
#ifdef DBG_NO_GDN
        for (int it = blockIdx.x; it < 16; it += gridDim.x) fox_cumsum_item(p, smem, it);
#else
        for (int it = blockIdx.x; it < 16 + 2048; it += gridDim.x) { if (it < 16) fox_cumsum_item(p, smem, it); else gdn_a_item(p, smem, it - 16); }
#endif
    } else if constexpr (P == 4) {
#if !defined(DBG_NO_GDN) && !defined(DBG_NO_SCAN)
        if (REP != 2 && blockIdx.x < 64) gdn_scan_item2(p, smem, blockIdx.x);
#endif
        for (;;) {
            const int it = q_pop(&ctrs[REP ? 4 + REP : 0], smem);
            if (it >= 1024) break;
            fox_item2(p, smem, it & 15, 63 - (it >> 4));
        }
    } else if constexpr (P == 5) {
        const int w = tidx() >> 6;
#ifdef DBG_NO_GDN
        for (size_t i = (size_t)blockIdx.x * NTHR + tidx(); i < (size_t)NT * 512; i += (size_t)gridDim.x * NTHR) ((bfraw*)(p.ws + O_YCAT))[(i >> 9) * 1024 + 512 + (i & 511)] = 0;
#elif defined(DBG_NO_GDNC)
#else
        for (int wi = blockIdx.x * 8 + w; wi < 8192; wi += gridDim.x * 8) gdn_c_witem(p, wi, REP != 0);
#endif
#ifdef DBG_NO_FOX
        for (size_t i = (size_t)blockIdx.x * NTHR + tidx(); i < (size_t)NT * 512; i += (size_t)gridDim.x * NTHR) ((bfraw*)(p.ws + O_YCAT))[(i >> 9) * 1024 + (i & 511)] = 0;
#endif
    } else if constexpr (P == 6 || P == 18) {
        constexpr int L = (P == 6) ? 0 : 1;
        phase_outproj(p, smem, L, ctrs + 512 + ((P == 6 ? 6 : 7) * 3 + REP) * 8);
        if (L == 0) phase_moe_convert(p, smem, L);
    } else if constexpr (P == 7 || P == 19) {
        phase_router(p, smem, (P == 7) ? 0 : 1, REP != 0);
    } else if constexpr (P == 8 || P == 11 || P == 20 || P == 23) {
        phase_moe1(p, smem, P >= 20 ? 1 : 0, (P == 8 || P == 20) ? 0 : 1);
        if constexpr (P == 11 || P == 23) { if (REP == 0) phase_combine(p, P >= 20 ? 1 : 0, 0, P < 20, false); }
    } else if constexpr (P == 9 || P == 12 || P == 21 || P == 24) {
        phase_moe2(p, smem, P >= 20 ? 1 : 0, (P == 9 || P == 21) ? 0 : 1);
    } else if constexpr (P == 10 || P == 13 || P == 22 || P == 25) {
        if constexpr (P == 13 || P == 25) phase_combine(p, P >= 20 ? 1 : 0, 1, P < 20, REP != 0);
    }
#ifdef HAVE_L1
    else if constexpr (P == 14) {
        phase_inproj1(p, smem, ctrs + 512 + (14 * 3 + REP) * 8);
    } else if constexpr (P == 15) {
        if (gridDim.x == 256) {
            const int b = blockIdx.x;
            if (b < 128) { nsa_compress_item(p, smem, b); for (int k = 0; k < 5; ++k) gla_a_item(p, smem, b * 5 + k); }
            else { for (int k = 0; k < 11; ++k) gla_a_item(p, smem, 640 + (b - 128) * 11 + k); }
        } else
        for (int it = blockIdx.x; it < 128 + 2048; it += gridDim.x) { if (it < 128) nsa_compress_item(p, smem, it); else gla_a_item(p, smem, it - 128); }
    } else if constexpr (P == 16) {
        for (;;) {
            const int it = q_pop(&ctrs[REP ? 8 + REP : 1], smem);
            constexpr int CVB = (MOECVT_ITEMS + 15) / 16;
            if (it >= 128 + 1024 + (REP ? 0 : CVB)) break;
            if (it >= 128 + 1024) {
                const int w = tidx() >> 6;
                float* tl = (float*)smem + w * (64 * 68);
#pragma unroll 1
                for (int u = 0; u < 2; ++u) { const int wi = (it - 1152) * 16 + u * 8 + w; if (wi < MOECVT_ITEMS) moe_convert_witem(p, tl, 1, wi); }
                continue;
            }
            if (REP && it < 128) continue;
            if (it < 128) gla_scan_item(p, it);
            else { const int f = it - 128; nsa_item2(p, smem, (f & 3) * 256 + 255 - (f >> 2)); }
        }
    } else if constexpr (P == 17) {
        const int w = tidx() >> 6;
        for (int wi = blockIdx.x * 8 + w; wi < 8192; wi += gridDim.x * 8) gla_c_witem(p, wi, REP != 0);
    }
#endif
}

template <int P, int PEND> DEV void run_range(const Params& p, char* smem, const XcdBarrier& bar) {
    constexpr bool kEmpty = (P == 10 || P == 22);
    if constexpr (!kEmpty) run_phase<P>(p, smem);
#ifdef REP_PHASE
    if constexpr (P == REP_PHASE) { xcd_barrier(bar); run_phase<P, 1>(p, smem); xcd_barrier(bar); run_phase<P, 2>(p, smem); }
#endif
    if constexpr (P + 1 < PEND) { if constexpr (!kEmpty) xcd_barrier(bar); run_range<P + 1, PEND>(p, smem, bar); }
}

#ifndef NPHASE
#define NPHASE 14
#endif

template <int P0, int P1>
__global__ void __launch_bounds__(512, 2) mk_kernel(Params p) {
    extern __shared__ __attribute__((aligned(16))) char smem[];
    if (tidx() == 0) *(uint4*)(smem + SM_BARW) = make_uint4(0u, 0u, 0u, 0u);
    __syncthreads();
    XcdBarrier bar = xcd_barrier_post((unsigned*)(p.ws + O_BAR), (volatile LAS unsigned*)(smem + SM_BARW));
    run_range<P0, P1>(p, smem, bar);
}

#ifdef DBG_SANITIZE
__global__ void k_sanitize(float* o, size_t n) { for (size_t i = (size_t)blockIdx.x * blockDim.x + tidx(); i < n; i += (size_t)gridDim.x * blockDim.x) { const float v = o[i]; if (!(fabsf(v) < 1e30f)) o[i] = 0.f; } }
#endif
template <int P> static void launch_one(const Params& p, int grid, hipStream_t stream) {
    hipFuncSetAttribute((const void*)mk_kernel<P, P + 1>, hipFuncAttributeMaxDynamicSharedMemorySize, SMEM_BYTES);
    mk_kernel<P, P + 1><<<grid, NTHR, SMEM_BYTES, stream>>>(p);
}
template <int P, int PEND> static void launch_seq(const Params& p, int grid, hipStream_t stream) {
    launch_one<P>(p, grid, stream);
    if constexpr (P + 1 < PEND) launch_seq<P + 1, PEND>(p, grid, stream);
}

extern "C" void kernel_launch(void* const* d_in, const int* in_sizes, int n_in, void* d_out, int out_size, void* d_ws, size_t ws_size, hipStream_t stream) {
    if (ws_size < WS_NEED || n_in < N_IN) return;
    Params p{};
    for (int i = 0; i < N_IN; ++i) p.in[i] = (const float*)d_in[i];
    p.out = (float*)d_out;
    p.ws = (char*)d_ws;
    hipMemsetAsync(d_ws, 0, ZERO_BYTES, stream);
#ifdef MULTI_LAUNCH
    launch_seq<0, NPHASE>(p, 256, stream);
#ifdef DBG_SANITIZE
    k_sanitize<<<1024, 256, 0, stream>>>(p.out, (size_t)NT * 1024);
#endif
#else
    static int grid = 0;
    if (!grid) {
        hipFuncSetAttribute((const void*)mk_kernel<0, NPHASE>, hipFuncAttributeMaxDynamicSharedMemorySize, SMEM_BYTES);
        int dev = 0, cus = 0, per_cu = 0;
        hipGetDevice(&dev);
        hipDeviceGetAttribute(&cus, hipDeviceAttributeMultiprocessorCount, dev);
        hipOccupancyMaxActiveBlocksPerMultiprocessor(&per_cu, (const void*)mk_kernel<0, NPHASE>, NTHR, SMEM_BYTES);
        grid = per_cu >= 1 ? cus : 0;
    }
    if (grid) mk_kernel<0, NPHASE><<<grid, NTHR, SMEM_BYTES, stream>>>(p);
#endif
}
```
